# Optimizing an MI355X kernel written in HIP

```python
import jax
import jax.numpy as jnp
from jax import lax
import numpy as np

D_MODEL = 1024
BATCH = 4
SEQ = 4096
DEPTH = 1

ATTN_GROUPS = 3
ATTN_HEADS_PER_GROUP = 4
ATTN_HEADS = ATTN_GROUPS * ATTN_HEADS_PER_GROUP
ATTN_HEAD_DIM = 128
ATTN_WIDTH = ATTN_HEADS * ATTN_HEAD_DIM
ATTN_OUT_WIDTH = ATTN_HEADS_PER_GROUP * ATTN_HEAD_DIM
ATTN_PATTERNS = ((128, 1), (512, 4), (2048, 16))
ALIBI_MAX_EXP = 8.0
NEG_INF = -1e30
RET_QK_DIM = 256
RET_HEADS = D_MODEL // RET_QK_DIM
RET_V_DIM = 2 * RET_QK_DIM
RET_QK_WIDTH = RET_HEADS * RET_QK_DIM
RET_V_WIDTH = RET_HEADS * RET_V_DIM
RET_CHUNK = 128
IN_SIZES = (ATTN_WIDTH, ATTN_WIDTH, ATTN_WIDTH, RET_QK_WIDTH, RET_QK_WIDTH,
            RET_V_WIDTH, RET_V_WIDTH, D_MODEL, D_MODEL)
N_GROUPS = 4
EXPERTS_PER_GROUP = 8
N_EXPERTS = N_GROUPS * EXPERTS_PER_GROUP
TOP_K_FINE = 2
EXPERT_FF = D_MODEL // 2
MOE_BLOCK = 128
DEEPNORM_ALPHA = (2.0 * DEPTH) ** 0.25
DEEPNORM_BETA = (8.0 * DEPTH) ** -0.25
LN_EPS = 1e-5
ADA_STD = 0.5

kernel_name = 'hybrid_dilated_retention_hmoe_block'


def _layer_norm(x):
    xf = x.astype(jnp.float32)
    mu = jnp.mean(xf, axis=-1, keepdims=True)
    var = jnp.mean(jnp.square(xf - mu), axis=-1, keepdims=True)
    return ((xf - mu) * lax.rsqrt(var + LN_EPS)).astype(x.dtype)


def _layer_norm_affine(x, gain, bias):
    return _layer_norm(x) * gain + bias


def _split_columns(proj, sizes):
    out, start = [], 0
    for n in sizes:
        out.append(proj[..., start:start + n])
        start += n
    return out


def _alibi_slopes(n_heads):
    return jnp.exp2(-ALIBI_MAX_EXP * jnp.arange(1, n_heads + 1, dtype=jnp.float32) / n_heads)


def _dilated_window_attention(q, k, v, slopes, window, dilation):
    b, s, h, dh = q.shape
    half = window // (2 * dilation)
    blk = half
    n_sub = s // dilation
    nb = -(-n_sub // blk)
    n_pad = nb * blk

    def to_sub(t):
        t = t.reshape(b, n_sub, dilation, h, dh).transpose(0, 2, 3, 1, 4)
        return jnp.pad(t, ((0, 0), (0, 0), (0, 0), (0, n_pad - n_sub), (0, 0)))

    def to_band(t):
        tp = jnp.pad(to_sub(t), ((0, 0), (0, 0), (0, 0), (blk, blk), (0, 0)))
        tp = tp.reshape(b, dilation, h, nb + 2, blk, dh)
        return jnp.concatenate([tp[:, :, :, :nb], tp[:, :, :, 1:nb + 1], tp[:, :, :, 2:]], axis=4)

    qb = to_sub(q).reshape(b, dilation, h, nb, blk, dh)
    kb, vb = to_band(k), to_band(v)
    q_idx = jnp.arange(nb)[:, None] * blk + jnp.arange(blk)[None, :]
    k_idx = (jnp.arange(nb)[:, None] - 1) * blk + jnp.arange(3 * blk)[None, :]
    delta = k_idx[:, None, :] - q_idx[:, :, None]
    valid = (jnp.abs(delta) <= half) & (k_idx[:, None, :] >= 0) & (k_idx[:, None, :] < n_sub)
    dist = (dilation * jnp.abs(delta)).astype(jnp.float32)
    bias = -slopes[:, None, None, None] * dist[None]
    scores = jnp.einsum('brhnqd,brhnkd->brhnqk', qb, kb).astype(jnp.float32) * (dh ** -0.5)
    scores = jnp.where(valid, scores + bias, NEG_INF)
    m = jnp.max(scores, axis=-1, keepdims=True)
    lse = m + jnp.log(jnp.sum(jnp.exp(scores - m), axis=-1, keepdims=True))
    probs = jnp.exp(scores - lse)
    out = jnp.einsum('brhnqk,brhnkd->brhnqd', probs.astype(v.dtype), vb)
    out = out.reshape(b, dilation, h, n_pad, dh)[:, :, :, :n_sub]
    out = out.transpose(0, 3, 1, 2, 4).reshape(b, s, h, dh)
    lse = lse[..., 0].reshape(b, dilation, h, n_pad)[..., :n_sub]
    lse = lse.transpose(0, 3, 1, 2).reshape(b, s, h)
    return out, lse


def _retention_one_direction(q, k, v, log_gamma, include_diag):
    b, h, s, dk = q.shape
    dv = v.shape[-1]
    c = RET_CHUNK
    nc = s // c

    def chunks(t):
        return t.reshape(b, h, nc, c, t.shape[-1]).transpose(2, 0, 1, 3, 4)

    pos = jnp.arange(c, dtype=jnp.float32)
    delta = pos[:, None] - pos[None, :]
    lower = delta >= 0 if include_diag else delta > 0
    lg = log_gamma[:, None, None]
    decay_mat = jnp.where(lower[None], jnp.exp(lg * jnp.maximum(delta, 0.0)[None]), 0.0)
    key_decay = jnp.exp(log_gamma[:, None] * (c - 1 - pos)[None])[None, :, :, None]
    query_decay = jnp.exp(log_gamma[:, None] * (pos + 1)[None])[None, :, :, None]
    chunk_decay = jnp.exp(log_gamma * c)[None, :, None, None]

    def step(state, inp):
        qi, ki, vi = inp
        inner = jnp.einsum('bhnd,bhmd->bhnm', qi, ki) * decay_mat
        y = jnp.einsum('bhnm,bhme->bhne', inner, vi)
        y = y + jnp.einsum('bhnd,bhde->bhne', qi, state) * query_decay
        state = state * chunk_decay + jnp.einsum('bhmd,bhme->bhde', ki * key_decay, vi)
        return state, y

    state0 = jnp.zeros((b, h, dk, dv), jnp.float32)
    _, ys = lax.scan(step, state0, (chunks(q), chunks(k), chunks(v)))
    return ys.transpose(1, 2, 0, 3, 4).reshape(b, h, s, dv)


def _bidirectional_retention(q, k, v, logit_fwd, logit_bwd):
    q, k, v = q.astype(jnp.float32), k.astype(jnp.float32), v.astype(jnp.float32)
    lg_f = jax.nn.log_sigmoid(logit_fwd.astype(jnp.float32))
    lg_b = jax.nn.log_sigmoid(logit_bwd.astype(jnp.float32))
    fwd = _retention_one_direction(q, k, v, lg_f, True)
    flip = lambda t: jnp.flip(t, axis=2)
    bwd = flip(_retention_one_direction(flip(q), flip(k), flip(v), lg_b, False))
    return fwd + bwd


def _token_mixing(u, w_in, w_attn_out, ret_decay_fwd, ret_decay_bwd, ret_gn_gain, w_ret_out, w_out):
    b, s, _ = u.shape
    proj = u @ w_in
    aq, ak, av, rq, rk, rv, rg, gate_a, gate_r = _split_columns(proj, IN_SIZES)

    heads = lambda t: t.reshape(b, s, ATTN_HEADS, ATTN_HEAD_DIM)
    aq, ak, av = heads(aq), heads(ak), heads(av)
    slopes = _alibi_slopes(ATTN_HEADS)
    outs, lses = [], []
    for g, (window, dilation) in enumerate(ATTN_PATTERNS):
        sl = slice(g * ATTN_HEADS_PER_GROUP, (g + 1) * ATTN_HEADS_PER_GROUP)
        o, l = _dilated_window_attention(aq[:, :, sl], ak[:, :, sl], av[:, :, sl], slopes[sl], window, dilation)
        outs.append(o)
        lses.append(l)
    dil_w = jax.nn.softmax(jnp.stack(lses), axis=0)
    attn = jnp.einsum('gbsh,gbshd->bshd', dil_w.astype(u.dtype), jnp.stack(outs))
    branch_a = attn.reshape(b, s, ATTN_OUT_WIDTH) @ w_attn_out

    rheads = lambda t, d: t.reshape(b, s, RET_HEADS, d).transpose(0, 2, 1, 3)
    ret = _bidirectional_retention(rheads(rq, RET_QK_DIM), rheads(rk, RET_QK_DIM) * (RET_QK_DIM ** -0.5),
                                   rheads(rv, RET_V_DIM), ret_decay_fwd, ret_decay_bwd)
    ret = _layer_norm(ret).transpose(0, 2, 1, 3).reshape(b, s, RET_V_WIDTH).astype(u.dtype) * ret_gn_gain
    branch_r = (jax.nn.silu(rg) * ret) @ w_ret_out

    merged = jax.nn.sigmoid(gate_a) * branch_a + jax.nn.sigmoid(gate_r) * branch_r
    return merged @ w_out


def _hierarchical_moe(u, w_coarse, b_coarse, w_fine, b_fine, w1, w3, w2):
    b, s, d = u.shape
    t = b * s
    xt = u.reshape(t, d)
    tok = jnp.arange(t)
    coarse = (xt @ w_coarse).astype(jnp.float32) + b_coarse
    p_coarse = jax.nn.softmax(coarse, axis=-1)
    _, g_top = lax.top_k(coarse, 1)
    g_sel = g_top[:, 0]
    p_group = p_coarse[tok, g_sel]
    fine_all = jnp.einsum('td,gde->tge', xt, w_fine).astype(jnp.float32) + b_fine
    fine = fine_all[tok, g_sel]
    f_val, f_idx = lax.top_k(fine, TOP_K_FINE)
    gate = p_group[:, None] * jax.nn.softmax(f_val, axis=-1)
    expert = g_sel[:, None] * EXPERTS_PER_GROUP + f_idx
    n_assign = t * TOP_K_FINE
    e_flat = expert.reshape(n_assign)
    order = jnp.argsort(e_flat)
    e_sorted = e_flat[order]
    tok_sorted = jnp.repeat(tok, TOP_K_FINE)[order]
    gate_sorted = gate.reshape(n_assign)[order]
    counts = jnp.bincount(e_flat, length=N_EXPERTS)
    padded = (counts + MOE_BLOCK - 1) // MOE_BLOCK * MOE_BLOCK
    start = jnp.cumsum(counts) - counts
    end_p = jnp.cumsum(padded)
    start_p = end_p - padded
    dest = start_p[e_sorted] + jnp.arange(n_assign) - start[e_sorted]
    n_rows = (-(-n_assign // MOE_BLOCK) + N_EXPERTS) * MOE_BLOCK
    n_blocks = n_rows // MOE_BLOCK
    rows = jnp.zeros((n_rows, d), u.dtype).at[dest].set(xt[tok_sorted])
    block_expert = jnp.minimum(
        jnp.searchsorted(end_p, jnp.arange(n_blocks) * MOE_BLOCK, side='right'), N_EXPERTS - 1)

    def expert_block(args):
        xb, e = args
        hdn = jax.nn.silu(xb @ w1[e]) * (xb @ w3[e])
        return hdn @ w2[e]

    y_rows = lax.map(expert_block, (rows.reshape(n_blocks, MOE_BLOCK, d), block_expert)).reshape(n_rows, d)
    y_assign = y_rows[dest] * gate_sorted[:, None].astype(u.dtype)
    out = jnp.zeros((t, d), u.dtype).at[tok_sorted].add(y_assign)
    return out.reshape(b, s, d)


def setup_inputs(seed: int = 0) -> dict:
    key = jax.random.key(seed)
    ks = jax.random.split(key, 32)
    f32 = jnp.float32
    beta = DEEPNORM_BETA

    def nrm(k, shape, scale):
        return jax.random.normal(k, shape, f32) * scale

    x = nrm(ks[0], (BATCH, SEQ, D_MODEL), 1.0)
    c = nrm(ks[1], (BATCH, D_MODEL), 1.0)
    w_ada = nrm(ks[2], (DEPTH, D_MODEL, 6 * D_MODEL), ADA_STD * D_MODEL ** -0.5)
    b_ada = nrm(ks[3], (DEPTH, 6 * D_MODEL), 0.01)
    in_scales = (1.0, 1.0, beta, 1.0, 1.0, beta, 1.0, 1.0, 1.0)
    w_in = jnp.concatenate(
        [nrm(ks[4 + i], (DEPTH, D_MODEL, n), sc * D_MODEL ** -0.5)
         for i, (n, sc) in enumerate(zip(IN_SIZES, in_scales))], axis=-1)
    w_attn_out = nrm(ks[13], (DEPTH, ATTN_OUT_WIDTH, D_MODEL), beta * ATTN_OUT_WIDTH ** -0.5)
    gamma0 = 1.0 - jnp.exp2(-5.0 - jnp.arange(RET_HEADS, dtype=f32))
    base_logit = jnp.log(gamma0) - jnp.log1p(-gamma0)
    ret_decay_fwd = base_logit + nrm(ks[14], (DEPTH, RET_HEADS), 0.05)
    ret_decay_bwd = base_logit + nrm(ks[15], (DEPTH, RET_HEADS), 0.05)
    ret_gn_gain = 1.0 + nrm(ks[16], (DEPTH, RET_V_WIDTH), 0.05)
    w_ret_out = nrm(ks[17], (DEPTH, RET_V_WIDTH, D_MODEL), beta * RET_V_WIDTH ** -0.5)
    w_out = nrm(ks[18], (DEPTH, D_MODEL, D_MODEL), beta * D_MODEL ** -0.5)
    ln1_gain = 1.0 + nrm(ks[19], (DEPTH, D_MODEL), 0.05)
    ln1_bias = nrm(ks[20], (DEPTH, D_MODEL), 0.01)
    w_coarse = nrm(ks[21], (DEPTH, D_MODEL, N_GROUPS), D_MODEL ** -0.5)
    b_coarse = nrm(ks[22], (DEPTH, N_GROUPS), 0.01)
    w_fine = nrm(ks[23], (DEPTH, N_GROUPS, D_MODEL, EXPERTS_PER_GROUP), D_MODEL ** -0.5)
    b_fine = nrm(ks[24], (DEPTH, N_GROUPS, EXPERTS_PER_GROUP), 0.01)
    w1 = nrm(ks[25], (DEPTH, N_EXPERTS, D_MODEL, EXPERT_FF), beta * D_MODEL ** -0.5)
    w3 = nrm(ks[26], (DEPTH, N_EXPERTS, D_MODEL, EXPERT_FF), beta * D_MODEL ** -0.5)
    w2 = nrm(ks[27], (DEPTH, N_EXPERTS, EXPERT_FF, D_MODEL), beta * EXPERT_FF ** -0.5)
    ln2_gain = 1.0 + nrm(ks[28], (DEPTH, D_MODEL), 0.05)
    ln2_bias = nrm(ks[29], (DEPTH, D_MODEL), 0.01)
    return {'x': x, 'c': c, 'w_ada': w_ada, 'b_ada': b_ada, 'w_in': w_in, 'w_attn_out': w_attn_out,
            'ret_decay_fwd': ret_decay_fwd, 'ret_decay_bwd': ret_decay_bwd, 'ret_gn_gain': ret_gn_gain,
            'w_ret_out': w_ret_out, 'w_out': w_out, 'ln1_gain': ln1_gain, 'ln1_bias': ln1_bias,
            'w_coarse': w_coarse, 'b_coarse': b_coarse, 'w_fine': w_fine, 'b_fine': b_fine,
            'w1': w1, 'w3': w3, 'w2': w2, 'ln2_gain': ln2_gain, 'ln2_bias': ln2_bias}


def reference(x, c, w_ada, b_ada, w_in, w_attn_out, ret_decay_fwd, ret_decay_bwd, ret_gn_gain,
              w_ret_out, w_out, ln1_gain, ln1_bias, w_coarse, b_coarse, w_fine, b_fine,
              w1, w3, w2, ln2_gain, ln2_bias):
    h = x
    for layer in range(DEPTH):
        mod = c @ w_ada[layer] + b_ada[layer]
        shift1, scale1, gate1, shift2, scale2, gate2 = [m[:, None, :] for m in jnp.split(mod, 6, axis=-1)]
        u = _layer_norm(h) * (1.0 + scale1) + shift1
        y = _token_mixing(u, w_in[layer], w_attn_out[layer], ret_decay_fwd[layer], ret_decay_bwd[layer],
                          ret_gn_gain[layer], w_ret_out[layer], w_out[layer])
        h = _layer_norm_affine(DEEPNORM_ALPHA * h + gate1 * y, ln1_gain[layer], ln1_bias[layer])
        u = _layer_norm(h) * (1.0 + scale2) + shift2
        y = _hierarchical_moe(u, w_coarse[layer], b_coarse[layer], w_fine[layer], b_fine[layer],
                              w1[layer], w3[layer], w2[layer])
        h = _layer_norm_affine(DEEPNORM_ALPHA * h + gate2 * y, ln2_gain[layer], ln2_bias[layer])
    return h
```

```cpp
#include <hip/hip_runtime.h>
#include <cstdio>
#include <cstdint>

#define GAS __attribute__((address_space(1)))
#define LAS __attribute__((address_space(3)))
#define DI __device__ __forceinline__
typedef unsigned short bf16;
typedef float f32x4 __attribute__((ext_vector_type(4)));
typedef float f32x16 __attribute__((ext_vector_type(16)));
typedef float f32x2 __attribute__((ext_vector_type(2)));
typedef short bf16x8 __attribute__((ext_vector_type(8)));
typedef short s16x4 __attribute__((ext_vector_type(4)));
typedef __bf16 bf16x2_t __attribute__((ext_vector_type(2)));
typedef unsigned u32x4 __attribute__((ext_vector_type(4)));
typedef unsigned u32x2 __attribute__((ext_vector_type(2)));

constexpr int NT = 16384, DM = 1024, SEQ = 4096, NB = 4;
constexpr int NWAVES = 8, NTHREADS = 512;
constexpr int LDS_BYTES = 147456, RING_BYTES = 131072, LDSX_OFF = RING_BYTES;
constexpr int MISC_OFF = LDSX_OFF + 320;
constexpr int TEXP_OFF = LDSX_OFF + 1024;
constexpr float LN_EPS = 1e-5f;
constexpr float ALPHA = 1.189207115002721f;

constexpr size_t MiB = 1u << 20;
constexpr size_t WS_CTL = 0, CTL_ZERO_BYTES = 1 * MiB;
constexpr size_t WS_MOD = 1 * MiB;
constexpr size_t WS_DEC = 1 * MiB + 112 * 1024;
constexpr size_t WS_WROUT = 1 * MiB + 128 * 1024;
constexpr size_t WS_WAT = 2 * MiB, WS_WRT = 3 * MiB, WS_WOT = 7 * MiB;
constexpr size_t WS_LSE = 9 * MiB;
constexpr size_t WS_ROUTE = 10 * MiB;
constexpr size_t WS_RQ = 12 * MiB, WS_RK = 44 * MiB, WS_RG = 76 * MiB, WS_RVT = 140 * MiB, WS_KFT = 204 * MiB, WS_KBT = 236 * MiB, WS_Y = 268 * MiB;
constexpr size_t WS_AQ = 12 * MiB, WS_O0 = 60 * MiB, WS_AK = 140 * MiB, WS_AVT = 188 * MiB, WS_GA = 236 * MiB, WS_GR = 268 * MiB, WS_O1 = 300 * MiB, WS_O2 = 316 * MiB;
constexpr size_t WS_ATTMIX = 12 * MiB, WS_MERGED = 28 * MiB, WS_W13T = 140 * MiB, WS_W2T = 204 * MiB;
constexpr size_t WS_U2 = 236 * MiB, WS_XG = 12 * MiB, WS_HDN = 92 * MiB, WS_YROWS = 236 * MiB;
constexpr size_t WS_END = 332 * MiB;
constexpr size_t OUT_U = 0, OUT_WINT = 32 * MiB;
constexpr int CW_BAR = 4096;
constexpr int CW_CNT = 16384;

constexpr int C_AQ = 0, C_AK = 1536, C_AV = 3072, C_RQ = 4608, C_RK = 5632, C_RV = 6656, C_RGT = 8704, C_GA = 10752, C_GR = 11776, C_END = 12800;

#define LDS_WAIT() asm volatile("s_waitcnt lgkmcnt(0)" ::: "memory")
#define VM_WAIT() asm volatile("s_waitcnt vmcnt(0)" ::: "memory")
DI unsigned pk2(float lo, float hi) { f32x2 v = {lo, hi}; bf16x2_t r = __builtin_convertvector(v, bf16x2_t); return __builtin_bit_cast(unsigned, r); }
DI float bf2f(unsigned short b) { return __builtin_bit_cast(float, (unsigned)b << 16); }
DI float bflo(unsigned w) { return __builtin_bit_cast(float, w << 16); }
DI float bfhi(unsigned w) { return __builtin_bit_cast(float, w & 0xffff0000u); }
DI float wave_sum(float v) {
#pragma unroll
    for (int o = 1; o < 64; o <<= 1) v += __shfl_xor(v, o);
    return v;
}
DI float sigmoidf_(float x) { return 1.f / (1.f + __expf(-x)); }
DI float log2_sigmoid(float x) { return -log1pf(expf(-x)) * 1.4426950408889634f; }
#define MFMA32(a, b, c) __builtin_amdgcn_mfma_f32_32x32x16_bf16((a), (b), (c), 0, 0, 0)
DI int crow(int reg, int h) { return (reg & 3) + 8 * (reg >> 2) + 4 * h; }
DI bf16x8 pack_step(const f32x16& x, int s) {
    u32x4 p; p[0] = pk2(x[8 * s], x[8 * s + 1]); p[1] = pk2(x[8 * s + 2], x[8 * s + 3]); p[2] = pk2(x[8 * s + 4], x[8 * s + 5]); p[3] = pk2(x[8 * s + 6], x[8 * s + 7]);
    return __builtin_bit_cast(bf16x8, p);
}
DI bf16x8 ld16(const bf16* p) { return *(const bf16x8*)p; }
DI bf16x8 ld8x2(const bf16* p0, const bf16* p1) { const s16x4 a = *(const s16x4*)p0, b = *(const s16x4*)p1; return __builtin_shufflevector(a, b, 0, 1, 2, 3, 4, 5, 6, 7); }
DI f32x16 zero16() { f32x16 z; for (int i = 0; i < 16; ++i) z[i] = 0.f; return z; }

#define XB_TMO      128
#define XB_XCNT(j)  (256  + 64 * (j))
#define XB_XSUB(j)  (1280 + 64 * (j))
#define XB_XGEN(j)  (2304 + 64 * (j))
#define XB_TOP      3328
#define XB_TOPGEN   3392
#define XCD_BAR_WORDS 3456
#define XB_SPIN_CAP (1u << 18)
DI unsigned xb_ld(unsigned* p)              { return __hip_atomic_load(p, __ATOMIC_RELAXED, __HIP_MEMORY_SCOPE_AGENT); }
DI unsigned xb_add(unsigned* p, unsigned v) { return __hip_atomic_fetch_add(p, v, __ATOMIC_RELAXED, __HIP_MEMORY_SCOPE_AGENT); }
DI unsigned xb_xcc_id() { return (unsigned)__builtin_amdgcn_s_getreg((3 << 11) | 20) & 0xFu; }
#define XB_SPIN(cond, bar) do { unsigned _sp = 0; while (cond) { __builtin_amdgcn_s_sleep(1); \
    if ((++_sp & 255u) == 0u) { if (xb_ld(&(bar)[XB_TMO])) break; if (_sp > XB_SPIN_CAP) { atomicAdd(&(bar)[XB_TMO], 1u); break; } } } } while (0)
struct XcdBarrier { unsigned* bar; unsigned x; volatile LAS unsigned* st; };
DI XcdBarrier xcd_barrier_post(unsigned* bar, volatile LAS unsigned* st) {
    XcdBarrier b; b.bar = bar; b.x = xb_xcc_id(); b.st = st;
    if (threadIdx.x == 0) (void)xb_add(&bar[XB_XCNT(b.x)], 1u);
    return b;
}
DI void xcd_barrier_complete(unsigned* bar, unsigned x, unsigned& nloc, unsigned& nx) {
    const unsigned G = gridDim.x * gridDim.y * gridDim.z;
    unsigned sum, cnt, mine, sp = 0u;
    for (;;) {
        sum = 0u; cnt = 0u; mine = 0u;
#pragma unroll
        for (unsigned j = 0; j < 16; ++j) { const unsigned c = xb_ld(&bar[XB_XCNT(j)]); sum += c; cnt += (c > 0u) ? 1u : 0u; mine = (j == x) ? c : mine; }
        if (sum == G) break;
        __builtin_amdgcn_s_sleep(1);
        if ((++sp & 255u) == 0u) { if (xb_ld(&bar[XB_TMO])) break; if (sp > XB_SPIN_CAP) { atomicAdd(&bar[XB_TMO], 1u); break; } }
    }
    nloc = mine > 0u ? mine : 1u; nx = cnt > 0u ? cnt : 1u;
}
DI void xcd_barrier(const XcdBarrier& b) {
    asm volatile("s_waitcnt vmcnt(0)" ::: "memory");
    __syncthreads();
    if (threadIdx.x == 0) {
        unsigned* bar = b.bar;
        __builtin_amdgcn_s_waitcnt(0);
        unsigned nloc = b.st[0], nx = b.st[1];
        if (nloc == 0u) { xcd_barrier_complete(bar, b.x, nloc, nx); b.st[0] = nloc; b.st[1] = nx; }
        const unsigned old = xb_add(&bar[XB_XSUB(b.x)], 1u);
        const unsigned gen = old / nloc;
        if (old + 1u == (gen + 1u) * nloc) {
            __builtin_amdgcn_fence(__ATOMIC_RELEASE, "agent");
            asm volatile("s_waitcnt vmcnt(0)" ::: "memory");
            const unsigned og = xb_add(&bar[XB_TOP], 1u);
            const unsigned tg = og / nx;
            if (og + 1u == (tg + 1u) * nx) xb_add(&bar[XB_TOPGEN], 1u);
            else XB_SPIN(xb_ld(&bar[XB_TOPGEN]) == tg, bar);
            __builtin_amdgcn_fence(__ATOMIC_ACQUIRE, "agent");
            xb_add(&bar[XB_XGEN(b.x)], 1u);
            asm volatile("s_waitcnt vmcnt(0)" ::: "memory");
        } else {
            XB_SPIN(xb_ld(&bar[XB_XGEN(b.x)]) == gen, bar);
            __builtin_amdgcn_fence(__ATOMIC_ACQUIRE, "agent");
            asm volatile("s_waitcnt vmcnt(0)" ::: "memory");
        }
    }
    __syncthreads();
}

namespace pg8 {
#define PG8_LAS __attribute__((address_space(3)))
constexpr int BM = 256, BK = 64, HALF = 128, HTB = HALF * BK * 2, STAGE_BYTES = 8 * HTB, NXCD = 8, WGM = 8;
__host__ __device__ __forceinline__ int lds_byte(int r, int c) { const int st = (r >> 4) * 2 + (c >> 5), rr = r & 15, cc = c & 31, ob = rr * 64 + cc * 2; return st * 1024 + (ob ^ (((ob >> 9) & 1) << 5)); }
__host__ __device__ __forceinline__ void stage_rc(int b, int& R, int& C) { const int st = b / 1024, sb = b % 1024, swz = sb ^ (((sb >> 9) & 1) << 5); R = (st >> 1) * 16 + swz / 64; C = (st & 1) * 32 + (swz % 64) / 2; }
__host__ __device__ __forceinline__ int perm32(int rho) { const int n = rho >> 4, i = rho & 15; return 8 * (i >> 2) + 4 * n + (i & 3); }
struct Unit { int pm, pn; };
struct StaticOrder {
    int nM, nN, nwg, G, c;
    __host__ __device__ void init(int nM_, int nN_, int G_, int c_) { nM = nM_; nN = nN_; nwg = nM * nN; G = G_; c = c_; }
    __host__ __device__ bool next(int i, Unit& u) const {
        const long L = (long)i * G + c; if (c < 0 || L >= nwg) return false;
        int wgid = (int)L; { const int q = nwg / NXCD, r = nwg % NXCD, xcd = wgid % NXCD, off = wgid / NXCD; wgid = (xcd < r ? xcd * (q + 1) : r * (q + 1) + (xcd - r) * q) + off; }
        const int nig = WGM * nN, gid = wgid / nig, fm = gid * WGM, gsz = (nM - fm) < WGM ? (nM - fm) : WGM;
        u.pm = fm + ((wgid % nig) % gsz); u.pn = (wgid % nig) / gsz; return true;
    }
};
template <class F> struct EpiV {
    F f;
    __device__ __forceinline__ void operator()(const f32x4 (&acc)[2][2][4][2], const Unit& u, int wr, int wc, int fr, int fq) const {
        const int row0 = u.pm * BM + wr * 64 + fr, col0 = u.pn * BM + wc * 32 + 8 * fq;
#pragma unroll
        for (int ai = 0; ai < 2; ++ai)
#pragma unroll
            for (int m = 0; m < 4; ++m)
#pragma unroll
                for (int bj = 0; bj < 2; ++bj) f(row0 + ai * HALF + m * 16, col0 + bj * HALF, acc[ai][bj][m][0], acc[ai][bj][m][1]);
    }
};
template <class Epi, class Sched, bool ALIGN_EPI = false>
__device__ __forceinline__ void gemm_phase(PG8_LAS unsigned char* lds, const int K, const int lda, const int ldb, const Sched& S, const Epi& E) {
    const int tid = threadIdx.x, wid = __builtin_amdgcn_readfirstlane(tid >> 6), lane = tid & 63, wr = wid >> 2, wc = wid & 3, fr = lane & 15, fq = lane >> 4;
    const int nt = K / BK;
    unsigned voffA[2], voffB[2];
#pragma unroll
    for (int i = 0; i < 2; ++i) { int R, C; stage_rc(tid * 16 + i * 8192, R, C); const int Rb = (R & ~31) + perm32(R & 31);
        voffA[i] = (unsigned)(R * lda + C) * 2u; voffB[i] = (unsigned)(Rb * ldb + C) * 2u; }
    const size_t kstep = (size_t)(BK * 2);
    const size_t hstepA = (size_t)HALF * lda * 2, hstepB = (size_t)HALF * ldb * 2;
    const unsigned ldsw = (unsigned)wid * 1024u;
    const int aoff = lds_byte(wr * 64 + fr, fq * 8), boff = lds_byte(wc * 32 + fr, fq * 8);
#define PG8_SA(b, h) (((b) * 2 + (h)) * HTB)
#define PG8_SB(b, h) ((4 + (b) * 2 + (h)) * HTB)
#define PG8_STAGE(bufoff, gbase, voff) do { _Pragma("unroll") for (int _i = 0; _i < 2; ++_i) \
        __builtin_amdgcn_global_load_lds((const unsigned*)((const char*)(gbase) + (voff)[_i]), (PG8_LAS unsigned*)(lds + (bufoff) + ldsw + _i * 8192), 16, 0, 0); } while (0)
#define PG8_LDA(dst, b, h) do { _Pragma("unroll") for (int m = 0; m < 4; ++m) _Pragma("unroll") for (int k = 0; k < 2; ++k) dst[m][k] = *(const PG8_LAS bf16x8*)(lds + PG8_SA(b, h) + aoff + m * 2048 + k * 1024); } while (0)
#define PG8_LDB(dst, b, h) do { _Pragma("unroll") for (int n = 0; n < 2; ++n) _Pragma("unroll") for (int k = 0; k < 2; ++k) dst[n][k] = *(const PG8_LAS bf16x8*)(lds + PG8_SB(b, h) + boff + n * 2048 + k * 1024); } while (0)
#define PG8_MMA(ai, bj, At, Bt) do { __builtin_amdgcn_s_setprio(1); _Pragma("unroll") for (int m = 0; m < 4; ++m) _Pragma("unroll") for (int n = 0; n < 2; ++n) _Pragma("unroll") for (int k = 0; k < 2; ++k) \
        acc[ai][bj][m][n] = __builtin_amdgcn_mfma_f32_16x16x32_bf16(Bt[n][k], At[m][k], acc[ai][bj][m][n], 0, 0, 0); __builtin_amdgcn_s_setprio(0); } while (0)
#define PG8_WAIT_V(n) asm volatile("s_waitcnt vmcnt(" #n ")" ::: "memory")
#define PG8_WAIT_L(n) asm volatile("s_waitcnt lgkmcnt(" #n ")" ::: "memory")
#define PG8_BAR __builtin_amdgcn_s_barrier()
#define PG8_SCHED __builtin_amdgcn_sched_barrier(0)
    Unit cur, nxt; int ui = 0;
    if (!S.next(0, cur)) return;
    f32x4 acc[2][2][4][2];
#pragma unroll
    for (int a = 0; a < 2; ++a)
#pragma unroll
        for (int b = 0; b < 2; ++b)
#pragma unroll
            for (int m = 0; m < 4; ++m)
#pragma unroll
                for (int n = 0; n < 2; ++n) acc[a][b][m][n] = (f32x4){0.f, 0.f, 0.f, 0.f};
    bf16x8 At[4][2], B0[2][2], B1[2][2];
    const char* cA = S.a_base(cur); const char* cB = S.b_base(cur);
    PG8_STAGE(PG8_SB(0, 0), cB, voffB); PG8_STAGE(PG8_SB(0, 1), cB + hstepB, voffB); PG8_STAGE(PG8_SA(0, 0), cA, voffA); PG8_STAGE(PG8_SA(0, 1), cA + hstepA, voffA);
    if (wr == 1) PG8_BAR;
    PG8_WAIT_V(2); PG8_BAR;
    PG8_STAGE(PG8_SB(1, 0), cB + kstep, voffB); PG8_STAGE(PG8_SA(1, 0), cA + kstep, voffA); PG8_STAGE(PG8_SB(1, 1), cB + hstepB + kstep, voffB);
    PG8_WAIT_V(6); PG8_BAR;
    for (;;) {
        const bool has_next = S.next(ui + 1, nxt);
        const char* nA = has_next ? S.a_base(nxt) : cA; const char* nB = has_next ? S.b_base(nxt) : cB;
        for (int t = 0; t < nt; t += 2) {
            const bool last = (t == nt - 2);
            const char* a1 = cA + (size_t)(t + 1) * kstep;
            const char* a2 = last ? nA : cA + (size_t)(t + 2) * kstep; const char* b2 = last ? nB : cB + (size_t)(t + 2) * kstep;
            const char* a3 = a2 + kstep; const char* b3 = b2 + kstep;
            PG8_LDB(B0, 0, 0); PG8_LDB(B1, 0, 1); PG8_SCHED; PG8_LDA(At, 0, 0); PG8_STAGE(PG8_SA(1, 1), a1 + hstepA, voffA);
            PG8_WAIT_V(8); PG8_WAIT_L(0); PG8_BAR; PG8_MMA(0, 0, At, B0); PG8_MMA(0, 1, At, B1); PG8_BAR; PG8_SCHED;
            PG8_LDA(At, 0, 1); PG8_STAGE(PG8_SB(0, 0), b2, voffB); PG8_STAGE(PG8_SB(0, 1), b2 + hstepB, voffB); PG8_STAGE(PG8_SA(0, 0), a2, voffA);
            PG8_WAIT_V(8); PG8_WAIT_L(0); PG8_BAR; PG8_MMA(1, 0, At, B0); PG8_MMA(1, 1, At, B1); PG8_BAR; PG8_SCHED;
            PG8_LDB(B0, 1, 0); PG8_LDB(B1, 1, 1); PG8_SCHED; PG8_LDA(At, 1, 0); PG8_STAGE(PG8_SA(0, 1), a2 + hstepA, voffA);
            PG8_WAIT_V(8); PG8_WAIT_L(0); PG8_BAR; PG8_MMA(0, 0, At, B0); PG8_MMA(0, 1, At, B1); PG8_BAR; PG8_SCHED;
            PG8_LDA(At, 1, 1); PG8_STAGE(PG8_SB(1, 0), b3, voffB); PG8_STAGE(PG8_SB(1, 1), b3 + hstepB, voffB); PG8_STAGE(PG8_SA(1, 0), a3, voffA);
            PG8_WAIT_V(8); PG8_WAIT_L(0); PG8_BAR; PG8_MMA(1, 0, At, B0); PG8_MMA(1, 1, At, B1); PG8_BAR; PG8_SCHED;
        }
        if constexpr (ALIGN_EPI) { if (wr == 0) PG8_BAR; }
        E(acc, cur, wr, wc, fr, fq);
        if (!has_next) break;
#pragma unroll
        for (int a = 0; a < 2; ++a)
#pragma unroll
            for (int b = 0; b < 2; ++b)
#pragma unroll
                for (int m = 0; m < 4; ++m)
#pragma unroll
                    for (int n = 0; n < 2; ++n) acc[a][b][m][n] = (f32x4){0.f, 0.f, 0.f, 0.f};
        cur = nxt; cA = nA; cB = nB; ++ui;
        if constexpr (ALIGN_EPI) { if (wr == 1) PG8_BAR; }
    }
    PG8_WAIT_V(0);
    if constexpr (!ALIGN_EPI) { if (wr == 0) PG8_BAR; }
    PG8_BAR;
#undef PG8_SA
#undef PG8_SB
#undef PG8_STAGE
#undef PG8_LDA
#undef PG8_LDB
#undef PG8_MMA
#undef PG8_WAIT_V
#undef PG8_WAIT_L
#undef PG8_BAR
#undef PG8_SCHED
}
}

struct Frame {
    LAS unsigned char* lds;
    int tid, lane, wave, G, vcu, bx;
    unsigned char* ws; unsigned char* outb;
    const float* in[22];
};
struct Args { const float* in[22]; float* out; unsigned char* ws; };

template <class RowMap>
DI void transpose_item(const float* W, int K, int N, bf16* WT, RowMap orow, LAS float* scr, int item, int lane) {
    const int nblk = N / 32, kb = item / nblk, nb = item % nblk, k0 = 64 * kb, n0 = 32 * nb;
#pragma unroll 8
    for (int i = 0; i < 32; ++i) { const int kk = 2 * i + (lane >> 5); scr[kk * 33 + (lane & 31)] = W[(size_t)(k0 + kk) * N + n0 + (lane & 31)]; }
    LDS_WAIT(); asm volatile("" ::: "memory");
    const int c = lane & 7;
#pragma unroll
    for (int j = 0; j < 4; ++j) { const int n = (lane >> 3) + 8 * j; const LAS float* s = scr + (8 * c) * 33 + n;
        u32x4 o; o.x = pk2(s[0 * 33], s[1 * 33]); o.y = pk2(s[2 * 33], s[3 * 33]); o.z = pk2(s[4 * 33], s[5 * 33]); o.w = pk2(s[6 * 33], s[7 * 33]);
        *(u32x4*)(WT + (size_t)orow(n0 + n) * K + k0 + 8 * c) = o; }
    LDS_WAIT(); asm volatile("" ::: "memory");
}
struct RowId { int off; DI int operator()(int n) const { return off + n; } };
struct RowW13 { int add; DI int operator()(int n) const { return ((n >> 2) << 3) + (n & 3) + add; } };

DI void phase0(Frame& F) {
    const float* c = F.in[1]; const float* w_ada = F.in[2]; const float* b_ada = F.in[3];
    float* MOD = (float*)(F.ws + WS_MOD);
    if (F.bx < 96) {
        const int j = F.bx * 64 + F.lane;
        float a0 = 0.f, a1 = 0.f, a2 = 0.f, a3 = 0.f;
        const int k0 = F.wave * 128;
#pragma unroll 8
        for (int k = k0; k < k0 + 128; ++k) { const float w = w_ada[(size_t)k * 6144 + j]; a0 += c[k] * w; a1 += c[1024 + k] * w; a2 += c[2048 + k] * w; a3 += c[3072 + k] * w; }
        LAS float* red = (LAS float*)F.lds;
        red[(F.wave * 4 + 0) * 64 + F.lane] = a0; red[(F.wave * 4 + 1) * 64 + F.lane] = a1; red[(F.wave * 4 + 2) * 64 + F.lane] = a2; red[(F.wave * 4 + 3) * 64 + F.lane] = a3;
        __syncthreads();
        if (F.tid < 256) { const int b = F.tid >> 6, l = F.tid & 63; float s = b_ada[F.bx * 64 + l];
#pragma unroll
            for (int w = 0; w < 8; ++w) s += red[(w * 4 + b) * 64 + l];
            MOD[b * 6144 + F.bx * 64 + l] = s; }
        __syncthreads();
    }
    if (F.bx == 0 && F.tid < 8) ((float*)(F.ws + WS_DEC))[F.tid] = log2_sigmoid(F.tid < 4 ? F.in[6][F.tid] : F.in[7][F.tid - 4]);
    { const int gid = F.bx * NTHREADS + F.tid;
      if (gid < 36 * 1024) { const int o = gid >> 10, k = gid & 1023; float v;
          if (o < 4) v = F.in[13][k * 4 + o]; else { const int g = (o - 4) >> 3, e = (o - 4) & 7; v = F.in[15][((size_t)g * 1024 + k) * 8 + e]; }
          ((float*)(F.ws + WS_WROUT))[gid] = v; } }
    LAS float* scr = (LAS float*)(F.lds + 16384 + F.wave * 12288);
    const int gw = F.bx * NWAVES + F.wave, NGW = F.G * NWAVES;
    constexpr int I_IN = 16 * 400, I_A = 8 * 32, I_R = 32 * 32, I_O = 16 * 32;
    for (int it = gw; it < I_IN + I_A + I_R + I_O; it += NGW) {
        int r = it;
        if (r < I_IN) { transpose_item(F.in[4], 1024, C_END, (bf16*)(F.outb + OUT_WINT), RowId{0}, scr, r, F.lane); continue; } r -= I_IN;
        if (r < I_A) { transpose_item(F.in[5], 512, 1024, (bf16*)(F.ws + WS_WAT), RowId{0}, scr, r, F.lane); continue; } r -= I_A;
        if (r < I_R) { transpose_item(F.in[9], 2048, 1024, (bf16*)(F.ws + WS_WRT), RowId{0}, scr, r, F.lane); continue; } r -= I_R;
        transpose_item(F.in[10], 1024, 1024, (bf16*)(F.ws + WS_WOT), RowId{0}, scr, r, F.lane);
    }
}
DI void moe_weight_transposes(Frame& F) {
    LAS float* scr = (LAS float*)(F.lds + 16384 + F.wave * 12288);
    const int gw = F.bx * NWAVES + F.wave, NGW = F.G * NWAVES;
    bf16* W13T = (bf16*)(F.ws + WS_W13T); bf16* W2T = (bf16*)(F.ws + WS_W2T);
    for (int it = gw; it < 3 * 8192; it += NGW) {
        const int which = it >> 13, r = it & 8191, e = r >> 8, item = r & 255;
        if (which == 0) transpose_item(F.in[17] + (size_t)e * 1024 * 512, 1024, 512, W13T + (size_t)e * 1024 * 1024, RowW13{0}, scr, item, F.lane);
        else if (which == 1) transpose_item(F.in[18] + (size_t)e * 1024 * 512, 1024, 512, W13T + (size_t)e * 1024 * 1024, RowW13{4}, scr, item, F.lane);
        else transpose_item(F.in[19] + (size_t)e * 512 * 1024, 512, 1024, W2T + (size_t)e * 1024 * 512, RowId{0}, scr, item, F.lane);
    }
}

DI void phase1(Frame& F) {
    const float* x = F.in[0]; const float* MOD = (const float*)(F.ws + WS_MOD); bf16* U = (bf16*)(F.outb + OUT_U);
    const int gw = F.bx * NWAVES + F.wave, NGW = F.G * NWAVES;
    for (int m = gw; m < NT; m += NGW) {
        const f32x4* xr = (const f32x4*)(x + (size_t)m * DM) + F.lane; const int b = m >> 12;
        f32x4 v[4]; float s = 0.f;
#pragma unroll
        for (int j = 0; j < 4; ++j) { v[j] = xr[64 * j]; s += (v[j].x + v[j].y) + (v[j].z + v[j].w); }
        const float mean = wave_sum(s) * (1.f / DM); float s2 = 0.f;
#pragma unroll
        for (int j = 0; j < 4; ++j) { v[j] = v[j] - mean; s2 += (v[j].x * v[j].x + v[j].y * v[j].y) + (v[j].z * v[j].z + v[j].w * v[j].w); }
        const float rstd = 1.f / sqrtf(wave_sum(s2) * (1.f / DM) + LN_EPS);
        u32x2* o8 = (u32x2*)(U + (size_t)m * DM) + F.lane;
#pragma unroll
        for (int j = 0; j < 4; ++j) { const int col = 256 * j + 4 * F.lane;
            const f32x4 sh = *(const f32x4*)(MOD + b * 6144 + col), sc = *(const f32x4*)(MOD + b * 6144 + 1024 + col);
            const f32x4 u = v[j] * rstd * (sc + 1.f) + sh;
            u32x2 w; w.x = pk2(u.x, u.y); w.y = pk2(u.z, u.w); o8[64 * j] = w; }
    }
}

DI u32x4 pack8(f32x4 v0, f32x4 v1) { u32x4 w; w.x = pk2(v0[0], v0[1]); w.y = pk2(v0[2], v0[3]); w.z = pk2(v1[0], v1[1]); w.w = pk2(v1[2], v1[3]); return w; }

struct SchedR1 : pg8::StaticOrder { const char* U; const char* W;
    DI const char* a_base(const pg8::Unit& u) const { return U + (size_t)u.pm * 256 * 2048; }
    DI const char* b_base(const pg8::Unit& u) const { const int r = u.pn < 8 ? C_RQ + 256 * u.pn : C_RGT + 256 * (u.pn - 8); return W + (size_t)r * 2048; } };
struct EpiR1 { bf16 *RQ, *RK, *RG;
    DI void operator()(int row, int col, f32x4 v0, f32x4 v1) const {
        if (col < 1024) *(u32x4*)(RQ + (size_t)row * 1024 + col) = pack8(v0, v1);
        else if (col < 2048) *(u32x4*)(RK + (size_t)row * 1024 + col - 1024) = pack8(v0 * 0.0625f, v1 * 0.0625f);
        else *(u32x4*)(RG + (size_t)row * 2048 + col - 2048) = pack8(v0, v1); } };
struct SchedR2 : pg8::StaticOrder { const char* U; const char* W;
    DI const char* a_base(const pg8::Unit& u) const { const int r = u.pm < 8 ? C_RV + 256 * u.pm : C_RK + 256 * (u.pm - 8); return W + (size_t)r * 2048; }
    DI const char* b_base(const pg8::Unit& u) const { return U + (size_t)u.pn * 256 * 2048; } };
struct EpiR2 { bf16 *RVT, *KFT, *KBT; const float* DEC;
    DI void operator()(int row, int col, f32x4 v0, f32x4 v1) const {
        if (row < 2048) { *(u32x4*)(RVT + (size_t)row * NT + col) = pack8(v0, v1); return; }
        const int f = row - 2048, h = f >> 8; const float p0 = (float)(col & 127);
        const float a = DEC[h], b = DEC[4 + h];
        f32x4 kf0, kf1, kb0, kb1;
#pragma unroll
        for (int e = 0; e < 4; ++e) {
            const float pa = p0 + (float)e, pb = p0 + (float)(e + 4);
            kf0[e] = v0[e] * 0.0625f * __builtin_amdgcn_exp2f(a * (127.f - pa)); kf1[e] = v1[e] * 0.0625f * __builtin_amdgcn_exp2f(a * (127.f - pb));
            kb0[e] = v0[e] * 0.0625f * __builtin_amdgcn_exp2f(b * pa);           kb1[e] = v1[e] * 0.0625f * __builtin_amdgcn_exp2f(b * pb); }
        *(u32x4*)(KFT + (size_t)f * NT + col) = pack8(kf0, kf1);
        *(u32x4*)(KBT + (size_t)f * NT + col) = pack8(kb0, kb1); } };
struct SchedA1 : pg8::StaticOrder { const char* U; const char* W;
    DI const char* a_base(const pg8::Unit& u) const { return U + (size_t)u.pm * 256 * 2048; }
    DI const char* b_base(const pg8::Unit& u) const { const int r = u.pn < 12 ? 256 * u.pn : C_GA + 256 * (u.pn - 12); return W + (size_t)r * 2048; } };
struct EpiA1 { bf16 *AQ, *AK, *GA, *GR;
    DI void operator()(int row, int col, f32x4 v0, f32x4 v1) const {
        if (col < 1536) *(u32x4*)(AQ + (size_t)row * 1536 + col) = pack8(v0, v1);
        else if (col < 3072) *(u32x4*)(AK + (size_t)row * 1536 + col - 1536) = pack8(v0, v1);
        else { f32x4 s0, s1;
#pragma unroll
            for (int e = 0; e < 4; ++e) { s0[e] = sigmoidf_(v0[e]); s1[e] = sigmoidf_(v1[e]); }
            bf16* dst = col < 4096 ? GA + (size_t)row * 1024 + col - 3072 : GR + (size_t)row * 1024 + col - 4096;
            *(u32x4*)dst = pack8(s0, s1); } } };
struct SchedA2 : pg8::StaticOrder { const char* U; const char* W; int g, r, nsub;
    DI const char* a_base(const pg8::Unit& u) const { return W + (size_t)(C_AV + 512 * g + 256 * u.pm) * 2048; }
    DI const char* b_base(const pg8::Unit& u) const { const int b = u.pn >> 4, v0 = (u.pn & 15) * 256, rho = v0 / nsub, i0 = v0 % nsub; return U + (size_t)(b * SEQ + rho + r * i0) * 2048; } };
struct EpiA2 { bf16* AVT;
    DI void operator()(int row, int col, f32x4 v0, f32x4 v1) const { *(u32x4*)(AVT + (size_t)row * NT + col) = pack8(v0, v1); } };
struct SchedG : pg8::StaticOrder { const char* A; const char* B; size_t abytes, bbytes;
    DI const char* a_base(const pg8::Unit& u) const { return A + (size_t)u.pm * abytes; }
    DI const char* b_base(const pg8::Unit& u) const { return B + (size_t)u.pn * bbytes; } };
struct EpiG1 { const bf16* GA; float* P1;
    DI void operator()(int row, int col, f32x4 v0, f32x4 v1) const {
        const u32x4 g = *(const u32x4*)(GA + (size_t)row * 1024 + col);
        f32x4 o0 = {v0[0] * bflo(g.x), v0[1] * bfhi(g.x), v0[2] * bflo(g.y), v0[3] * bfhi(g.y)}, o1 = {v1[0] * bflo(g.z), v1[1] * bfhi(g.z), v1[2] * bflo(g.w), v1[3] * bfhi(g.w)};
        *(f32x4*)(P1 + (size_t)row * 1024 + col) = o0; *(f32x4*)(P1 + (size_t)row * 1024 + col + 4) = o1; } };
struct EpiG2 { const bf16* GR; const float* P1; bf16* MERGED;
    DI void operator()(int row, int col, f32x4 v0, f32x4 v1) const {
        const u32x4 g = *(const u32x4*)(GR + (size_t)row * 1024 + col);
        const f32x4 p0 = *(const f32x4*)(P1 + (size_t)row * 1024 + col), p1 = *(const f32x4*)(P1 + (size_t)row * 1024 + col + 4);
        f32x4 o0 = {p0[0] + v0[0] * bflo(g.x), p0[1] + v0[1] * bfhi(g.x), p0[2] + v0[2] * bflo(g.y), p0[3] + v0[3] * bfhi(g.y)};
        f32x4 o1 = {p1[0] + v1[0] * bflo(g.z), p1[1] + v1[1] * bfhi(g.z), p1[2] + v1[2] * bflo(g.w), p1[3] + v1[3] * bfhi(g.w)};
        *(u32x4*)(MERGED + (size_t)row * 1024 + col) = pack8(o0, o1); } };
struct EpiG3 { const float* x; const float* MOD; float* H;
    DI void operator()(int row, int col, f32x4 v0, f32x4 v1) const {
        const int b = row >> 12; const float* gp = MOD + b * 6144 + 2048 + col; const float* xp = x + (size_t)row * 1024 + col;
        const f32x4 g0 = *(const f32x4*)gp, g1 = *(const f32x4*)(gp + 4), x0 = *(const f32x4*)xp, x1 = *(const f32x4*)(xp + 4);
        *(f32x4*)(H + (size_t)row * 1024 + col) = x0 * ALPHA + g0 * v0; *(f32x4*)(H + (size_t)row * 1024 + col + 4) = x1 * ALPHA + g1 * v1; } };
struct SchedM : pg8::StaticOrder { const char* A; const char* B; size_t abytes, ebytes, bbytes; const LAS int* texp;
    DI const char* a_base(const pg8::Unit& u) const { return A + (size_t)u.pm * abytes; }
    DI const char* b_base(const pg8::Unit& u) const { return B + (size_t)texp[u.pm] * ebytes + (size_t)u.pn * bbytes; } };
struct EpiM3 { bf16* HDN;
    DI void operator()(int row, int col, f32x4 a, f32x4 b) const {
        f32x4 o;
#pragma unroll
        for (int e = 0; e < 4; ++e) o[e] = a[e] * sigmoidf_(a[e]) * b[e];
        u32x2 w; w.x = pk2(o[0], o[1]); w.y = pk2(o[2], o[3]);
        *(u32x2*)(HDN + (size_t)row * 512 + (col >> 1)) = w; } };
struct EpiM4 { bf16* Y;
    DI void operator()(int row, int col, f32x4 v0, f32x4 v1) const { *(u32x4*)(Y + (size_t)row * 1024 + col) = pack8(v0, v1); } };

DI void ret_intra(Frame& F) {
    const bf16* RQ = (const bf16*)(F.ws + WS_RQ); const bf16* RK = (const bf16*)(F.ws + WS_RK); const bf16* RVT = (const bf16*)(F.ws + WS_RVT); bf16* Y = (bf16*)(F.ws + WS_Y);
    const float* DEC = (const float*)(F.ws + WS_DEC);
    const int r = F.lane & 31, h = F.lane >> 5;
    const int gw = F.vcu * NWAVES + F.wave, NGW = F.G * NWAVES;
    for (int it = gw; it < 4096; it += NGW) {
        const int dh = it & 1, ntl = (it >> 1) & 3, ch = (it >> 3) & 31, hd = (it >> 8) & 3, b = it >> 10;
        const int tok0 = b * SEQ + ch * 128;
        const float lf = DEC[hd], lb = DEC[4 + hd];
        f32x16 pT[4]; for (int i = 0; i < 4; ++i) pT[i] = zero16();
        const bf16* qp = RQ + (size_t)(tok0 + 32 * ntl + r) * 1024 + hd * 256 + 8 * h;
        const bf16* kp = RK + (size_t)(tok0 + r) * 1024 + hd * 256 + 8 * h;
#pragma unroll 4
        for (int ks = 0; ks < 16; ++ks) {
            const bf16x8 bq = ld16(qp + 16 * ks);
#pragma unroll
            for (int mt = 0; mt < 4; ++mt) { const bf16x8 ak = ld16(kp + (size_t)mt * 32 * 1024 + 16 * ks); pT[mt] = MFMA32(ak, bq, pT[mt]); }
        }
        bf16x8 pb[4][2];
        const int n = 32 * ntl + r;
#pragma unroll
        for (int mt = 0; mt < 4; ++mt) {
#pragma unroll
            for (int i = 0; i < 16; ++i) { const int m = 32 * mt + crow(i, h); const int d = n - m;
                const float w = d >= 0 ? __builtin_amdgcn_exp2f(lf * (float)d) : __builtin_amdgcn_exp2f(lb * (float)(-d));
                pT[mt][i] *= w; }
            pb[mt][0] = pack_step(pT[mt], 0); pb[mt][1] = pack_step(pT[mt], 1);
        }
        for (int dt = 0; dt < 8; ++dt) {
            const int dv0 = hd * 512 + dh * 256 + dt * 32;
            const bf16* vp = RVT + (size_t)(dv0 + r) * NT + tok0 + 4 * h;
            f32x16 acc = zero16();
#pragma unroll
            for (int mt = 0; mt < 4; ++mt)
#pragma unroll
                for (int s = 0; s < 2; ++s) { const bf16x8 av = ld8x2(vp + 32 * mt + 16 * s, vp + 32 * mt + 16 * s + 8); acc = MFMA32(av, pb[mt][s], acc); }
            bf16* yp = Y + (size_t)(tok0 + n) * 2048 + dv0 + 4 * h;
#pragma unroll
            for (int g = 0; g < 4; ++g) { u32x2 w; w.x = pk2(acc[4 * g], acc[4 * g + 1]); w.y = pk2(acc[4 * g + 2], acc[4 * g + 3]); *(u32x2*)(yp + 8 * g) = w; }
        }
    }
}
constexpr int ST_PITCH = 264;
DI void ret_scan(Frame& F) {
    const bf16* RQ = (const bf16*)(F.ws + WS_RQ); const bf16* RVT = (const bf16*)(F.ws + WS_RVT); bf16* Y = (bf16*)(F.ws + WS_Y);
    const int r = F.lane & 31, h = F.lane >> 5, dir = F.wave >> 2, wg = F.wave & 3;
    const bf16* KT = (const bf16*)(F.ws + (dir ? WS_KBT : WS_KFT));
    LAS bf16* ST = (LAS bf16*)F.lds + dir * (2 * 32 * ST_PITCH);
    for (int unit = F.vcu; unit < 256; unit += F.G) {
        const int sl = unit & 15, hd = (unit >> 4) & 3, b = unit >> 6;
        const float lg = ((const float*)(F.ws + WS_DEC))[4 * dir + hd];
        const float cd = __builtin_amdgcn_exp2f(lg * 128.f);
        const float p = (float)(32 * wg + r);
        const float qd = dir ? __builtin_amdgcn_exp2f(lg * (128.f - p)) : __builtin_amdgcn_exp2f(lg * (p + 1.f));
        f32x16 S0 = zero16(), S1 = zero16();
        for (int step = 0; step < 32; ++step) {
            const int ch = dir ? 31 - step : step;
            const int tok0 = b * SEQ + ch * 128;
            const int cur = step & 1;
            if (step > 0) {
                const LAS bf16* sp = ST + cur * (32 * ST_PITCH) + r * ST_PITCH + 8 * h;
                const bf16* qp = RQ + (size_t)(tok0 + 32 * wg + r) * 1024 + hd * 256 + 8 * h;
                f32x16 acc = zero16();
#pragma unroll 4
                for (int ks = 0; ks < 16; ++ks) { const bf16x8 as = *(const LAS bf16x8*)(sp + 16 * ks); const bf16x8 bq = ld16(qp + 16 * ks); acc = MFMA32(as, bq, acc); }
                bf16* yp = Y + (size_t)(tok0 + 32 * wg + r) * 2048 + hd * 512 + sl * 32 + 4 * h;
#pragma unroll
                for (int g = 0; g < 4; ++g) { const unsigned long long o64 = __hip_atomic_load((const unsigned long long*)(yp + 8 * g), __ATOMIC_RELAXED, __HIP_MEMORY_SCOPE_AGENT); u32x2 o; o.x = (unsigned)o64; o.y = (unsigned)(o64 >> 32);
                    u32x2 w; w.x = pk2(bflo(o.x) + acc[4 * g] * qd, bfhi(o.x) + acc[4 * g + 1] * qd); w.y = pk2(bflo(o.y) + acc[4 * g + 2] * qd, bfhi(o.y) + acc[4 * g + 3] * qd);
                    *(u32x2*)(yp + 8 * g) = w; }
            }
            if (step < 31) {
#pragma unroll
                for (int i = 0; i < 16; ++i) { S0[i] *= cd; S1[i] *= cd; }
                const bf16* kp = KT + (size_t)(hd * 256 + 64 * wg + r) * NT + tok0 + 8 * h;
                const bf16* vp = RVT + (size_t)(hd * 512 + sl * 32 + r) * NT + tok0 + 8 * h;
#pragma unroll 4
                for (int ks = 0; ks < 8; ++ks) { const bf16x8 bv = ld16(vp + 16 * ks); const bf16x8 a0 = ld16(kp + 16 * ks), a1 = ld16(kp + (size_t)32 * NT + 16 * ks);
                    S0 = MFMA32(a0, bv, S0); S1 = MFMA32(a1, bv, S1); }
                LAS bf16* wp = ST + (cur ^ 1) * (32 * ST_PITCH) + r * ST_PITCH + 64 * wg + 4 * h;
#pragma unroll
                for (int g = 0; g < 4; ++g) {
                    u32x2 w0; w0.x = pk2(S0[4 * g], S0[4 * g + 1]); w0.y = pk2(S0[4 * g + 2], S0[4 * g + 3]); *(LAS u32x2*)(wp + 8 * g) = w0;
                    u32x2 w1; w1.x = pk2(S1[4 * g], S1[4 * g + 1]); w1.y = pk2(S1[4 * g + 2], S1[4 * g + 3]); *(LAS u32x2*)(wp + 32 + 8 * g) = w1; }
            }
            __syncthreads();
        }
    }
}
DI void ret_norm(Frame& F) {
    const bf16* Y = (const bf16*)(F.ws + WS_Y); bf16* RG = (bf16*)(F.ws + WS_RG); const float* gain = F.in[8];
    const int gw = F.bx * NWAVES + F.wave, NGW = F.G * NWAVES;
    for (int m = gw; m < NT; m += NGW) {
#pragma unroll
        for (int j = 0; j < 4; ++j) {
            const size_t off = (size_t)m * 2048 + 512 * j + 8 * F.lane;
            const u32x4 yw = *(const u32x4*)(Y + off), gwv = *(const u32x4*)(RG + off);
            float v[8] = {bflo(yw.x), bfhi(yw.x), bflo(yw.y), bfhi(yw.y), bflo(yw.z), bfhi(yw.z), bflo(yw.w), bfhi(yw.w)};
            float g[8] = {bflo(gwv.x), bfhi(gwv.x), bflo(gwv.y), bfhi(gwv.y), bflo(gwv.z), bfhi(gwv.z), bflo(gwv.w), bfhi(gwv.w)};
            float s = 0.f;
#pragma unroll
            for (int e = 0; e < 8; ++e) s += v[e];
            const float mean = wave_sum(s) * (1.f / 512.f); float s2 = 0.f;
#pragma unroll
            for (int e = 0; e < 8; ++e) { v[e] -= mean; s2 += v[e] * v[e]; }
            const float rstd = 1.f / sqrtf(wave_sum(s2) * (1.f / 512.f) + LN_EPS);
            const f32x4 ga = *(const f32x4*)(gain + 512 * j + 8 * F.lane), gb = *(const f32x4*)(gain + 512 * j + 8 * F.lane + 4);
            float o[8];
#pragma unroll
            for (int e = 0; e < 8; ++e) { const float gn = e < 4 ? ga[e] : gb[e - 4]; o[e] = g[e] * sigmoidf_(g[e]) * (v[e] * rstd) * gn; }
            u32x4 w; w.x = pk2(o[0], o[1]); w.y = pk2(o[2], o[3]); w.z = pk2(o[4], o[5]); w.w = pk2(o[6], o[7]);
            *(u32x4*)(RG + off) = w;
        }
    }
}

DI void attn_phase(Frame& F) {
    const bf16* AQ = (const bf16*)(F.ws + WS_AQ); const bf16* AK = (const bf16*)(F.ws + WS_AK);
    float* LSE = (float*)(F.ws + WS_LSE);
    const int r = F.lane & 31, h = F.lane >> 5;
    const int gw = F.vcu * NWAVES + F.wave, NGW = F.G * NWAVES;
    for (int it = gw; it < 6144; it += NGW) {
        const int g = it >> 11, rem = it & 2047;
        const int dil = g == 0 ? 1 : (g == 1 ? 4 : 16), nsub = SEQ / dil, nqt = nsub >> 5;
        const int qt = rem % nqt; const int rem2 = rem / nqt; const int rho = rem2 % dil; const int bh = rem2 / dil; const int hg = bh & 3, b = bh >> 2;
        const int head = 4 * g + hg;
        const float slope = __builtin_amdgcn_exp2f(-8.f * (float)(head + 1) * (1.f / 12.f)) * (float)dil;
        const bf16* AVT = (const bf16*)(F.ws + WS_AVT + (size_t)g * 16 * MiB);
        bf16* OG = (bf16*)(F.ws + (g == 0 ? WS_O0 : (g == 1 ? WS_O1 : WS_O2)));
        const int i0 = 32 * qt;
        const size_t tokbase = (size_t)b * SEQ + rho;
        bf16x8 bq[8];
        { const bf16* qp = AQ + (tokbase + (size_t)dil * (i0 + r)) * 1536 + head * 128 + 8 * h;
#pragma unroll
          for (int ks = 0; ks < 8; ++ks) bq[ks] = ld16(qp + 16 * ks); }
        f32x16 sT[5];
#pragma unroll
        for (int kt = 0; kt < 5; ++kt) {
            int ik = i0 - 64 + 32 * kt + r; ik = ik < 0 ? 0 : (ik >= nsub ? nsub - 1 : ik);
            const bf16* kp = AK + (tokbase + (size_t)dil * ik) * 1536 + head * 128 + 8 * h;
            f32x16 acc = zero16();
#pragma unroll
            for (int ks = 0; ks < 8; ++ks) acc = MFMA32(ld16(kp + 16 * ks), bq[ks], acc);
            sT[kt] = acc;
        }
        const int iq = i0 + r;
        float mx = -3.0e38f;
#pragma unroll
        for (int kt = 0; kt < 5; ++kt)
#pragma unroll
            for (int i = 0; i < 16; ++i) { const int ik = i0 - 64 + 32 * kt + crow(i, h); const int d = ik - iq; const int ad = d < 0 ? -d : d;
                const bool valid = (ad <= 64) && (ik >= 0) && (ik < nsub);
                const float sc = valid ? sT[kt][i] * 0.08838834764831845f - slope * (float)ad : -1e30f;
                sT[kt][i] = sc; mx = fmaxf(mx, sc); }
        mx = fmaxf(mx, __shfl_xor(mx, 32));
        float sum = 0.f;
#pragma unroll
        for (int kt = 0; kt < 5; ++kt)
#pragma unroll
            for (int i = 0; i < 16; ++i) { const float p = __expf(sT[kt][i] - mx); sT[kt][i] = p; sum += p; }
        sum += __shfl_xor(sum, 32);
        const float inv = 1.f / sum;
        if (h == 0) LSE[((size_t)g * NT + tokbase + (size_t)dil * iq) * 4 + hg] = mx + __logf(sum);
        bf16x8 pb[5][2];
#pragma unroll
        for (int kt = 0; kt < 5; ++kt) { pb[kt][0] = pack_step(sT[kt], 0); pb[kt][1] = pack_step(sT[kt], 1); }
        const size_t vcol0 = (size_t)b * SEQ + (size_t)rho * nsub;
        bf16* op = OG + (tokbase + (size_t)dil * iq) * 512 + hg * 128 + 4 * h;
#pragma unroll
        for (int dt = 0; dt < 4; ++dt) {
            const bf16* vp = AVT + (size_t)(hg * 128 + 32 * dt + r) * NT + vcol0;
            f32x16 acc = zero16();
#pragma unroll
            for (int kt = 0; kt < 5; ++kt)
#pragma unroll
                for (int s = 0; s < 2; ++s) {
                    int k0 = i0 - 64 + 32 * kt + 16 * s + 4 * h, k1 = k0 + 8;
                    k0 = k0 < 0 ? 0 : (k0 > nsub - 4 ? nsub - 4 : k0); k1 = k1 < 0 ? 0 : (k1 > nsub - 4 ? nsub - 4 : k1);
                    acc = MFMA32(ld8x2(vp + k0, vp + k1), pb[kt][s], acc); }
#pragma unroll
            for (int q = 0; q < 4; ++q) { u32x2 w; w.x = pk2(acc[4 * q] * inv, acc[4 * q + 1] * inv); w.y = pk2(acc[4 * q + 2] * inv, acc[4 * q + 3] * inv); *(u32x2*)(op + 32 * dt + 8 * q) = w; }
        }
    }
}
DI void attn_mix(Frame& F) {
    const bf16* O0 = (const bf16*)(F.ws + WS_O0); const bf16* O1 = (const bf16*)(F.ws + WS_O1); const bf16* O2 = (const bf16*)(F.ws + WS_O2);
    const float* LSE = (const float*)(F.ws + WS_LSE); bf16* MIX = (bf16*)(F.ws + WS_ATTMIX);
    const int gw = F.bx * NWAVES + F.wave, NGW = F.G * NWAVES;
    for (int m = gw; m < NT; m += NGW) {
        const int hg = F.lane >> 4;
        const float l0 = LSE[((size_t)0 * NT + m) * 4 + hg], l1 = LSE[((size_t)1 * NT + m) * 4 + hg], l2 = LSE[((size_t)2 * NT + m) * 4 + hg];
        const float mx = fmaxf(l0, fmaxf(l1, l2)); const float e0 = __expf(l0 - mx), e1 = __expf(l1 - mx), e2 = __expf(l2 - mx); const float inv = 1.f / (e0 + e1 + e2);
        const float w0 = e0 * inv, w1 = e1 * inv, w2 = e2 * inv;
        const size_t off = (size_t)m * 512 + 8 * F.lane;
        const u32x4 a = *(const u32x4*)(O0 + off), b = *(const u32x4*)(O1 + off), c = *(const u32x4*)(O2 + off);
        u32x4 o;
        o.x = pk2(w0 * bflo(a.x) + w1 * bflo(b.x) + w2 * bflo(c.x), w0 * bfhi(a.x) + w1 * bfhi(b.x) + w2 * bfhi(c.x));
        o.y = pk2(w0 * bflo(a.y) + w1 * bflo(b.y) + w2 * bflo(c.y), w0 * bfhi(a.y) + w1 * bfhi(b.y) + w2 * bfhi(c.y));
        o.z = pk2(w0 * bflo(a.z) + w1 * bflo(b.z) + w2 * bflo(c.z), w0 * bfhi(a.z) + w1 * bfhi(b.z) + w2 * bfhi(c.z));
        o.w = pk2(w0 * bflo(a.w) + w1 * bflo(b.w) + w2 * bflo(c.w), w0 * bfhi(a.w) + w1 * bfhi(b.w) + w2 * bfhi(c.w));
        *(u32x4*)(MIX + off) = o;
    }
}

DI void moe_route(Frame& F) {
    float* H = (float*)F.outb; const float* MOD = (const float*)(F.ws + WS_MOD); const float* WR = (const float*)(F.ws + WS_WROUT);
    bf16* U2 = (bf16*)(F.ws + WS_U2); unsigned* ROUTE = (unsigned*)(F.ws + WS_ROUTE); unsigned* CNT = (unsigned*)(F.ws + WS_CTL) + CW_CNT;
    const float* g1 = F.in[11]; const float* b1 = F.in[12]; const float* bco = F.in[14]; const float* bfi = F.in[16];
    LAS float* lg = (LAS float*)F.lds + F.wave * 256;
    const int gw = F.bx * NWAVES + F.wave, NGW = F.G * NWAVES;
    for (int m0 = gw * 4; m0 < NT; m0 += NGW * 4) {
        f32x4 u[4][4];
#pragma unroll
        for (int t = 0; t < 4; ++t) {
            const int m = m0 + t; const int b = m >> 12;
            f32x4* hr = (f32x4*)(H + (size_t)m * DM) + F.lane;
            f32x4 v[4]; float s = 0.f;
#pragma unroll
            for (int j = 0; j < 4; ++j) { v[j] = hr[64 * j]; s += (v[j].x + v[j].y) + (v[j].z + v[j].w); }
            float mean = wave_sum(s) * (1.f / DM); float s2 = 0.f;
#pragma unroll
            for (int j = 0; j < 4; ++j) { v[j] = v[j] - mean; s2 += (v[j].x * v[j].x + v[j].y * v[j].y) + (v[j].z * v[j].z + v[j].w * v[j].w); }
            float rstd = 1.f / sqrtf(wave_sum(s2) * (1.f / DM) + LN_EPS);
            s = 0.f;
#pragma unroll
            for (int j = 0; j < 4; ++j) { const int col = 256 * j + 4 * F.lane; const f32x4 gg = *(const f32x4*)(g1 + col), bb = *(const f32x4*)(b1 + col);
                v[j] = v[j] * rstd * gg + bb; hr[64 * j] = v[j]; s += (v[j].x + v[j].y) + (v[j].z + v[j].w); }
            mean = wave_sum(s) * (1.f / DM); s2 = 0.f;
#pragma unroll
            for (int j = 0; j < 4; ++j) { v[j] = v[j] - mean; s2 += (v[j].x * v[j].x + v[j].y * v[j].y) + (v[j].z * v[j].z + v[j].w * v[j].w); }
            rstd = 1.f / sqrtf(wave_sum(s2) * (1.f / DM) + LN_EPS);
            u32x2* o8 = (u32x2*)(U2 + (size_t)m * DM) + F.lane;
#pragma unroll
            for (int j = 0; j < 4; ++j) { const int col = 256 * j + 4 * F.lane;
                const f32x4 sh = *(const f32x4*)(MOD + b * 6144 + 3072 + col), sc = *(const f32x4*)(MOD + b * 6144 + 4096 + col);
                u[t][j] = v[j] * rstd * (sc + 1.f) + sh;
                u32x2 w; w.x = pk2(u[t][j].x, u[t][j].y); w.y = pk2(u[t][j].z, u[t][j].w); o8[64 * j] = w; }
        }
        for (int o = 0; o < 36; ++o) {
            const f32x4* wr = (const f32x4*)(WR + o * 1024) + F.lane;
            f32x4 w[4];
#pragma unroll
            for (int j = 0; j < 4; ++j) w[j] = wr[64 * j];
#pragma unroll
            for (int t = 0; t < 4; ++t) { float a = 0.f;
#pragma unroll
                for (int j = 0; j < 4; ++j) a += (u[t][j].x * w[j].x + u[t][j].y * w[j].y) + (u[t][j].z * w[j].z + u[t][j].w * w[j].w);
                a = wave_sum(a);
                if (F.lane == 0) lg[t * 64 + o] = a; }
        }
        LDS_WAIT(); asm volatile("" ::: "memory");
        if (F.lane < 4) {
            const int t = F.lane, m = m0 + t; const LAS float* L = lg + t * 64;
            float c[4]; int gs = 0; float cm = -3.0e38f;
#pragma unroll
            for (int j = 0; j < 4; ++j) { c[j] = L[j] + bco[j]; if (c[j] > cm) { cm = c[j]; gs = j; } }
            float den = 0.f;
#pragma unroll
            for (int j = 0; j < 4; ++j) den += __expf(c[j] - cm);
            const float pg = 1.f / den;
            float f[8];
#pragma unroll
            for (int e = 0; e < 8; ++e) f[e] = L[4 + 8 * gs + e] + bfi[8 * gs + e];
            int i0 = 0; float v0 = f[0];
#pragma unroll
            for (int e = 1; e < 8; ++e) if (f[e] > v0) { v0 = f[e]; i0 = e; }
            int i1 = -1; float v1 = -3.0e38f;
#pragma unroll
            for (int e = 0; e < 8; ++e) if (e != i0 && f[e] > v1) { v1 = f[e]; i1 = e; }
            const float e1 = __expf(v1 - v0); const float w0 = pg / (1.f + e1), w1 = pg * e1 / (1.f + e1);
            const int ex0 = gs * 8 + i0, ex1 = gs * 8 + i1;
            const unsigned p0 = atomicAdd(CNT + 64 * ex0, 1u), p1 = atomicAdd(CNT + 64 * ex1, 1u);
            unsigned* R = ROUTE + (size_t)m * 8;
            R[0] = ex0; R[1] = ex1; R[2] = p0; R[3] = p1; R[4] = __float_as_uint(w0); R[5] = __float_as_uint(w1);
        }
        LDS_WAIT(); asm volatile("" ::: "memory");
    }
}
DI int moe_tables(Frame& F) {
    LAS int* tab = (LAS int*)(F.lds + TEXP_OFF);
    if (F.tid == 0) {
        const unsigned* CNT = (const unsigned*)(F.ws + WS_CTL) + CW_CNT;
        int t = 0;
        for (int e = 0; e < 32; ++e) { const int c = (int)xb_ld((unsigned*)CNT + 64 * e); const int nt = (c + 255) >> 8; tab[192 + e] = t * 256; for (int k = 0; k < nt; ++k) tab[t + k] = e; t += nt; }
        tab[224] = t;
    }
    __syncthreads();
    return tab[224];
}
DI void moe_gather(Frame& F) {
    const LAS int* tab = (const LAS int*)(F.lds + TEXP_OFF);
    const bf16* U2 = (const bf16*)(F.ws + WS_U2); bf16* XG = (bf16*)(F.ws + WS_XG); unsigned* ROUTE = (unsigned*)(F.ws + WS_ROUTE);
    const int gw = F.bx * NWAVES + F.wave, NGW = F.G * NWAVES;
    for (int a = gw; a < 2 * NT; a += NGW) {
        const int m = a >> 1, k = a & 1;
        const unsigned e = ROUTE[(size_t)m * 8 + k], pos = ROUTE[(size_t)m * 8 + 2 + k];
        const int slot = tab[192 + e] + (int)pos;
        const u32x4* src = (const u32x4*)(U2 + (size_t)m * DM) + F.lane; u32x4* dst = (u32x4*)(XG + (size_t)slot * DM) + F.lane;
        dst[0] = src[0]; dst[64] = src[64];
        if (F.lane == 0) ROUTE[(size_t)m * 8 + 6 + k] = (unsigned)slot;
    }
}
DI void moe_combine(Frame& F) {
    float* H = (float*)F.outb; const float* MOD = (const float*)(F.ws + WS_MOD); const bf16* YR = (const bf16*)(F.ws + WS_YROWS); const unsigned* ROUTE = (const unsigned*)(F.ws + WS_ROUTE);
    const float* g2 = F.in[20]; const float* b2 = F.in[21];
    const int gw = F.bx * NWAVES + F.wave, NGW = F.G * NWAVES;
    for (int m = gw; m < NT; m += NGW) {
        const int b = m >> 12; const unsigned* R = ROUTE + (size_t)m * 8;
        const float w0 = __uint_as_float(R[4]), w1 = __uint_as_float(R[5]); const size_t s0 = R[6], s1 = R[7];
        f32x4* hr = (f32x4*)(H + (size_t)m * DM) + F.lane;
        f32x4 v[4]; float s = 0.f;
#pragma unroll
        for (int j = 0; j < 4; ++j) { const int col = 256 * j + 4 * F.lane;
            const u32x2 ya = *(const u32x2*)(YR + s0 * DM + col), yb = *(const u32x2*)(YR + s1 * DM + col);
            const f32x4 y = {w0 * bflo(ya.x) + w1 * bflo(yb.x), w0 * bfhi(ya.x) + w1 * bfhi(yb.x), w0 * bflo(ya.y) + w1 * bflo(yb.y), w0 * bfhi(ya.y) + w1 * bfhi(yb.y)};
            const f32x4 gt = *(const f32x4*)(MOD + b * 6144 + 5120 + col);
            v[j] = hr[64 * j] * ALPHA + gt * y; s += (v[j].x + v[j].y) + (v[j].z + v[j].w); }
        const float mean = wave_sum(s) * (1.f / DM); float s2 = 0.f;
#pragma unroll
        for (int j = 0; j < 4; ++j) { v[j] = v[j] - mean; s2 += (v[j].x * v[j].x + v[j].y * v[j].y) + (v[j].z * v[j].z + v[j].w * v[j].w); }
        const float rstd = 1.f / sqrtf(wave_sum(s2) * (1.f / DM) + LN_EPS);
#pragma unroll
        for (int j = 0; j < 4; ++j) { const int col = 256 * j + 4 * F.lane; hr[64 * j] = v[j] * rstd * *(const f32x4*)(g2 + col) + *(const f32x4*)(b2 + col); }
    }
}

__global__ void __launch_bounds__(NTHREADS, 2) fwd_kernel(Args args) {
    extern __shared__ __attribute__((aligned(16))) unsigned char lds[];
    Frame F;
    F.lds = (LAS unsigned char*)lds;
    F.tid = threadIdx.x; F.lane = F.tid & 63; F.wave = __builtin_amdgcn_readfirstlane(F.tid >> 6);
    F.G = gridDim.x; F.bx = blockIdx.x; F.vcu = (F.G % 8 == 0) ? (F.bx % 8) * (F.G / 8) + F.bx / 8 : F.bx;
    F.ws = args.ws; F.outb = (unsigned char*)args.out;
#pragma unroll
    for (int i = 0; i < 22; ++i) F.in[i] = args.in[i];
    for (int u = F.tid; u < (LDS_BYTES - LDSX_OFF) / 4; u += NTHREADS) ((LAS unsigned*)(F.lds + LDSX_OFF))[u] = 0u;
    __syncthreads();
    unsigned* ctl = (unsigned*)(F.ws + WS_CTL);
    XcdBarrier bar = xcd_barrier_post(ctl + CW_BAR, (volatile LAS unsigned*)(F.lds + MISC_OFF) + 8);
#define GRID_BAR() xcd_barrier(bar)
    const char* U = (const char*)(F.outb + OUT_U); const char* WINT = (const char*)(F.outb + OUT_WINT);
    const int c = F.bx;

    phase0(F); GRID_BAR();
    phase1(F); GRID_BAR();
    { SchedR1 S; S.init(64, 16, F.G, c); S.U = U; S.W = WINT;
      pg8::EpiV<EpiR1> E{EpiR1{(bf16*)(F.ws + WS_RQ), (bf16*)(F.ws + WS_RK), (bf16*)(F.ws + WS_RG)}};
      pg8::gemm_phase<pg8::EpiV<EpiR1>, SchedR1, true>(F.lds, 1024, 1024, 1024, S, E); }
    { SchedR2 S; S.init(12, 64, F.G, c); S.U = U; S.W = WINT;
      pg8::EpiV<EpiR2> E{EpiR2{(bf16*)(F.ws + WS_RVT), (bf16*)(F.ws + WS_KFT), (bf16*)(F.ws + WS_KBT), (const float*)(F.ws + WS_DEC)}};
      pg8::gemm_phase<pg8::EpiV<EpiR2>, SchedR2, true>(F.lds, 1024, 1024, 1024, S, E); }
    GRID_BAR();
    ret_intra(F); GRID_BAR();
    ret_scan(F); GRID_BAR();
    ret_norm(F); GRID_BAR();
    { SchedA1 S; S.init(64, 20, F.G, c); S.U = U; S.W = WINT;
      pg8::EpiV<EpiA1> E{EpiA1{(bf16*)(F.ws + WS_AQ), (bf16*)(F.ws + WS_AK), (bf16*)(F.ws + WS_GA), (bf16*)(F.ws + WS_GR)}};
      pg8::gemm_phase<pg8::EpiV<EpiA1>, SchedA1, true>(F.lds, 1024, 1024, 1024, S, E); }
#pragma unroll 1
    for (int g = 0; g < 3; ++g) {
        const int dil = g == 0 ? 1 : (g == 1 ? 4 : 16);
        SchedA2 S; const int cc = (g == 1) ? c - 128 : c; S.init(2, 64, F.G, (cc >= 0 && cc < 128) ? cc : -1); S.U = U; S.W = WINT; S.g = g; S.r = dil; S.nsub = SEQ / dil;
        pg8::EpiV<EpiA2> E{EpiA2{(bf16*)(F.ws + WS_AVT + (size_t)g * 16 * MiB)}};
        pg8::gemm_phase<pg8::EpiV<EpiA2>, SchedA2, true>(F.lds, 1024, 1024, 1024 * dil, S, E);
    }
    GRID_BAR();
    attn_phase(F); GRID_BAR();
    attn_mix(F); moe_weight_transposes(F); GRID_BAR();
    { SchedG S; S.init(64, 4, F.G, c); S.A = (const char*)(F.ws + WS_ATTMIX); S.B = (const char*)(F.ws + WS_WAT); S.abytes = 256 * 512 * 2; S.bbytes = 256 * 512 * 2;
      pg8::EpiV<EpiG1> E{EpiG1{(const bf16*)(F.ws + WS_GA), (float*)F.outb}};
      pg8::gemm_phase<pg8::EpiV<EpiG1>, SchedG, false>(F.lds, 512, 512, 512, S, E); }
    { SchedG S; S.init(64, 4, F.G, c); S.A = (const char*)(F.ws + WS_RG); S.B = (const char*)(F.ws + WS_WRT); S.abytes = 256 * 2048 * 2; S.bbytes = 256 * 2048 * 2;
      pg8::EpiV<EpiG2> E{EpiG2{(const bf16*)(F.ws + WS_GR), (const float*)F.outb, (bf16*)(F.ws + WS_MERGED)}};
      pg8::gemm_phase<pg8::EpiV<EpiG2>, SchedG, false>(F.lds, 2048, 2048, 2048, S, E); }
    GRID_BAR();
    { SchedG S; S.init(64, 4, F.G, c); S.A = (const char*)(F.ws + WS_MERGED); S.B = (const char*)(F.ws + WS_WOT); S.abytes = 256 * 1024 * 2; S.bbytes = 256 * 1024 * 2;
      pg8::EpiV<EpiG3> E{EpiG3{F.in[0], (const float*)(F.ws + WS_MOD), (float*)F.outb}};
      pg8::gemm_phase<pg8::EpiV<EpiG3>, SchedG, false>(F.lds, 1024, 1024, 1024, S, E); }
    GRID_BAR();
    moe_route(F); GRID_BAR();
    const int ntiles = moe_tables(F);
    moe_gather(F); GRID_BAR();
    { SchedM S; S.init(ntiles, 4, F.G, c); S.A = (const char*)(F.ws + WS_XG); S.B = (const char*)(F.ws + WS_W13T); S.abytes = 256 * 1024 * 2; S.ebytes = (size_t)1024 * 1024 * 2; S.bbytes = 256 * 1024 * 2;
      S.texp = (const LAS int*)(F.lds + TEXP_OFF);
      pg8::EpiV<EpiM3> E{EpiM3{(bf16*)(F.ws + WS_HDN)}};
      pg8::gemm_phase<pg8::EpiV<EpiM3>, SchedM, true>(F.lds, 1024, 1024, 1024, S, E); }
    GRID_BAR();
    { SchedM S; S.init(ntiles, 4, F.G, c); S.A = (const char*)(F.ws + WS_HDN); S.B = (const char*)(F.ws + WS_W2T); S.abytes = 256 * 512 * 2; S.ebytes = (size_t)1024 * 512 * 2; S.bbytes = 256 * 512 * 2;
      S.texp = (const LAS int*)(F.lds + TEXP_OFF);
      pg8::EpiV<EpiM4> E{EpiM4{(bf16*)(F.ws + WS_YROWS)}};
      pg8::gemm_phase<pg8::EpiV<EpiM4>, SchedM, true>(F.lds, 512, 512, 512, S, E); }
    GRID_BAR();
    moe_combine(F);
}

extern "C" void kernel_launch(void* const* d_in, const int* in_sizes, int n_in, void* d_out, int out_size, void* d_ws, size_t ws_size, hipStream_t stream) {
    static int grid = 0;
    if (grid == 0) {
        if (n_in != 22 || out_size != NT * DM || ws_size < WS_END) { fprintf(stderr, "kernel_launch: unexpected problem (n_in %d, out %d, ws %zu)\n", n_in, out_size, ws_size); grid = -1; return; }
        int dev = 0, cus = 0, per_cu = 0;
        if (hipGetDevice(&dev) != hipSuccess || hipDeviceGetAttribute(&cus, hipDeviceAttributeMultiprocessorCount, dev) != hipSuccess) { grid = -1; return; }
        if (hipFuncSetAttribute((const void*)fwd_kernel, hipFuncAttributeMaxDynamicSharedMemorySize, LDS_BYTES) != hipSuccess) { grid = -1; return; }
        if (hipOccupancyMaxActiveBlocksPerMultiprocessor(&per_cu, (const void*)fwd_kernel, NTHREADS, LDS_BYTES) != hipSuccess || per_cu < 1) { fprintf(stderr, "kernel_launch: occupancy query reports %d blocks/CU\n", per_cu); (void)hipGetLastError(); grid = -1; return; }
        grid = cus;
    }
    if (grid < 0) return;
    (void)hipMemsetAsync((char*)d_ws + WS_CTL, 0, CTL_ZERO_BYTES, stream);
    Args a{};
    for (int i = 0; i < 22; ++i) a.in[i] = (const float*)d_in[i];
    a.out = (float*)d_out; a.ws = (unsigned char*)d_ws;
    hipLaunchKernelGGL(fwd_kernel, dim3(grid), dim3(NTHREADS), LDS_BYTES, stream, a);
}
```

```cpp
#ifndef PROF
#define PROF 0
#endif
#ifndef DUP
#define DUP 0
#endif
#define REP(k, ...) do { __VA_ARGS__ if (DUP == (k)) { __VA_ARGS__ } } while (0)
#define REPX(k, ...) do { if (DUP == (k)) { __VA_ARGS__ } } while (0)
#ifndef PROF_A
#define PROF_A 1
#endif
#ifndef PROF_B
#define PROF_B 2
#endif
#include <hip/hip_runtime.h>
#include <cstdio>
#include <cstdint>

#define GAS __attribute__((address_space(1)))
#define LAS __attribute__((address_space(3)))
#define DI __device__ __forceinline__
typedef unsigned short bf16;
typedef float f32x4 __attribute__((ext_vector_type(4)));
typedef float f32x16 __attribute__((ext_vector_type(16)));
typedef float f32x2 __attribute__((ext_vector_type(2)));
typedef short bf16x8 __attribute__((ext_vector_type(8)));
typedef short s16x4 __attribute__((ext_vector_type(4)));
typedef __bf16 bf16x2_t __attribute__((ext_vector_type(2)));
typedef unsigned u32x4 __attribute__((ext_vector_type(4)));
typedef unsigned u32x2 __attribute__((ext_vector_type(2)));

constexpr int NT = 16384, DM = 1024, SEQ = 4096, NB = 4;
constexpr int NWAVES = 8, NTHREADS = 512;
constexpr int LDS_BYTES = 147456, RING_BYTES = 131072, LDSX_OFF = RING_BYTES;
constexpr int MISC_OFF = LDSX_OFF + 320;
constexpr int TEXP_OFF = LDSX_OFF + 1024;
constexpr float LN_EPS = 1e-5f;
constexpr float ALPHA = 1.189207115002721f;

constexpr size_t MiB = 1u << 20;
constexpr size_t WS_CTL = 0, CTL_ZERO_BYTES = 1 * MiB;
constexpr size_t WS_MOD = 1 * MiB;
constexpr size_t WS_DEC = 1 * MiB + 112 * 1024;
constexpr size_t WS_WROUT = 1 * MiB + 128 * 1024;
constexpr size_t WS_WAT = 2 * MiB, WS_WRT = 3 * MiB, WS_WOT = 7 * MiB;
constexpr size_t WS_LSE = 9 * MiB;
constexpr size_t WS_ROUTE = 10 * MiB;
constexpr int NTP = NT + 576;
constexpr size_t WS_RQ = 12 * MiB, WS_RK = 44 * MiB, WS_RG = 76 * MiB, WS_RVT = 140 * MiB, WS_KFT = 207 * MiB, WS_KBT = 241 * MiB, WS_Y = 275 * MiB;
constexpr size_t WS_AQ = 12 * MiB, WS_O0 = 60 * MiB, WS_AK = 140 * MiB, WS_AVT = 188 * MiB, WS_GA = 238 * MiB, WS_GR = 270 * MiB, WS_O1 = 302 * MiB, WS_O2 = 318 * MiB;
constexpr size_t WS_ATTMIX = 12 * MiB, WS_MERGED = 28 * MiB, WS_W13T = 140 * MiB, WS_W2T = 204 * MiB;
constexpr size_t WS_U2 = 238 * MiB, WS_XG = 12 * MiB, WS_HDN = 92 * MiB, WS_YROWS = 238 * MiB;
constexpr size_t WS_END = 339 * MiB;
static_assert((size_t)2048 * NTP * 2 <= 67 * MiB && (size_t)1024 * NTP * 2 <= 34 * MiB && (size_t)1536 * NTP * 2 <= 50 * MiB, "padded transposed tensors fit their regions");
constexpr size_t OUT_U = 0, OUT_WINT = 32 * MiB;
constexpr int CW_BAR = 4096;
constexpr int CW_CNT = 16384;
constexpr int CW_RANK = 20480;

constexpr int C_AQ = 0, C_AK = 1536, C_AV = 3072, C_RQ = 4608, C_RK = 5632, C_RV = 6656, C_RGT = 8704, C_GA = 10752, C_GR = 11776, C_END = 12800;

#define LDS_WAIT() asm volatile("s_waitcnt lgkmcnt(0)" ::: "memory")
#define VM_WAIT() asm volatile("s_waitcnt vmcnt(0)" ::: "memory")
DI unsigned pk2(float lo, float hi) { f32x2 v = {lo, hi}; bf16x2_t r = __builtin_convertvector(v, bf16x2_t); return __builtin_bit_cast(unsigned, r); }
DI float bf2f(unsigned short b) { return __builtin_bit_cast(float, (unsigned)b << 16); }
DI float bflo(unsigned w) { return __builtin_bit_cast(float, w << 16); }
DI float bfhi(unsigned w) { return __builtin_bit_cast(float, w & 0xffff0000u); }
DI float wave_sum(float v) {
#pragma unroll
    for (int o = 1; o < 64; o <<= 1) v += __shfl_xor(v, o);
    return v;
}
DI float sigmoidf_(float x) { return 1.f / (1.f + __expf(-x)); }
DI float log2_sigmoid(float x) { return -log1pf(expf(-x)) * 1.4426950408889634f; }
#define MFMA32(a, b, c) __builtin_amdgcn_mfma_f32_32x32x16_bf16((a), (b), (c), 0, 0, 0)
DI int crow(int reg, int h) { return (reg & 3) + 8 * (reg >> 2) + 4 * h; }
DI bf16x8 pack_step(const f32x16& x, int s) {
    u32x4 p; p[0] = pk2(x[8 * s], x[8 * s + 1]); p[1] = pk2(x[8 * s + 2], x[8 * s + 3]); p[2] = pk2(x[8 * s + 4], x[8 * s + 5]); p[3] = pk2(x[8 * s + 6], x[8 * s + 7]);
    return __builtin_bit_cast(bf16x8, p);
}
DI bf16x8 ld16(const bf16* p) { return *(const bf16x8*)p; }
DI bf16x8 ld8x2(const bf16* p0, const bf16* p1) { const s16x4 a = *(const s16x4*)p0, b = *(const s16x4*)p1; return __builtin_shufflevector(a, b, 0, 1, 2, 3, 4, 5, 6, 7); }
DI size_t blk_off(int row, int k, int kblocks) { return ((size_t)(row >> 5) * kblocks + (k >> 4)) * 512 + ((k >> 3) & 1) * 256 + (row & 31) * 8; }
DI f32x16 zero16() { f32x16 z; for (int i = 0; i < 16; ++i) z[i] = 0.f; return z; }

#define XB_TMO      128
#define XB_XCNT(j)  (256  + 64 * (j))
#define XB_XSUB(j)  (1280 + 64 * (j))
#define XB_XGEN(j)  (2304 + 64 * (j))
#define XB_TOP      3328
#define XB_TOPGEN   3392
#define XCD_BAR_WORDS 3456
#define XB_SPIN_CAP (1u << 18)
DI unsigned xb_ld(unsigned* p)              { return __hip_atomic_load(p, __ATOMIC_RELAXED, __HIP_MEMORY_SCOPE_AGENT); }
DI unsigned xb_add(unsigned* p, unsigned v) { return __hip_atomic_fetch_add(p, v, __ATOMIC_RELAXED, __HIP_MEMORY_SCOPE_AGENT); }
DI unsigned xb_xcc_id() { return (unsigned)__builtin_amdgcn_s_getreg((3 << 11) | 20) & 0xFu; }
#define XB_SPIN(cond, bar) do { unsigned _sp = 0; while (cond) { __builtin_amdgcn_s_sleep(1); \
    if ((++_sp & 255u) == 0u) { if (xb_ld(&(bar)[XB_TMO])) break; if (_sp > XB_SPIN_CAP) { atomicAdd(&(bar)[XB_TMO], 1u); break; } } } } while (0)
struct XcdBarrier { unsigned* bar; unsigned x; volatile LAS unsigned* st; };
DI XcdBarrier xcd_barrier_post(unsigned* bar, volatile LAS unsigned* st) {
    XcdBarrier b; b.bar = bar; b.x = xb_xcc_id(); b.st = st;
    if (threadIdx.x == 0) (void)xb_add(&bar[XB_XCNT(b.x)], 1u);
    return b;
}
DI void xcd_barrier_complete(unsigned* bar, unsigned x, unsigned& nloc, unsigned& nx) {
    const unsigned G = gridDim.x * gridDim.y * gridDim.z;
    unsigned sum, cnt, mine, sp = 0u;
    for (;;) {
        sum = 0u; cnt = 0u; mine = 0u;
#pragma unroll
        for (unsigned j = 0; j < 16; ++j) { const unsigned c = xb_ld(&bar[XB_XCNT(j)]); sum += c; cnt += (c > 0u) ? 1u : 0u; mine = (j == x) ? c : mine; }
        if (sum == G) break;
        __builtin_amdgcn_s_sleep(1);
        if ((++sp & 255u) == 0u) { if (xb_ld(&bar[XB_TMO])) break; if (sp > XB_SPIN_CAP) { atomicAdd(&bar[XB_TMO], 1u); break; } }
    }
    nloc = mine > 0u ? mine : 1u; nx = cnt > 0u ? cnt : 1u;
}
DI void xcd_barrier(const XcdBarrier& b) {
    asm volatile("s_waitcnt vmcnt(0)" ::: "memory");
    __syncthreads();
    if (threadIdx.x == 0) {
        unsigned* bar = b.bar;
        __builtin_amdgcn_s_waitcnt(0);
        unsigned nloc = b.st[0], nx = b.st[1];
        if (nloc == 0u) { xcd_barrier_complete(bar, b.x, nloc, nx); b.st[0] = nloc; b.st[1] = nx; }
        const unsigned old = xb_add(&bar[XB_XSUB(b.x)], 1u);
        const unsigned gen = old / nloc;
        if (old + 1u == (gen + 1u) * nloc) {
            __builtin_amdgcn_fence(__ATOMIC_RELEASE, "agent");
            asm volatile("s_waitcnt vmcnt(0)" ::: "memory");
            const unsigned og = xb_add(&bar[XB_TOP], 1u);
            const unsigned tg = og / nx;
            if (og + 1u == (tg + 1u) * nx) xb_add(&bar[XB_TOPGEN], 1u);
            else XB_SPIN(xb_ld(&bar[XB_TOPGEN]) == tg, bar);
            __builtin_amdgcn_fence(__ATOMIC_ACQUIRE, "agent");
            xb_add(&bar[XB_XGEN(b.x)], 1u);
            asm volatile("s_waitcnt vmcnt(0)" ::: "memory");
        } else {
            XB_SPIN(xb_ld(&bar[XB_XGEN(b.x)]) == gen, bar);
            __builtin_amdgcn_fence(__ATOMIC_ACQUIRE, "agent");
            asm volatile("s_waitcnt vmcnt(0)" ::: "memory");
        }
    }
    __syncthreads();
}

namespace pg8 {
#define PG8_LAS __attribute__((address_space(3)))
constexpr int BM = 256, BK = 64, HALF = 128, HTB = HALF * BK * 2, STAGE_BYTES = 8 * HTB, NXCD = 8, WGM = 8;
__host__ __device__ __forceinline__ int lds_byte(int r, int c) { const int st = (r >> 4) * 2 + (c >> 5), rr = r & 15, cc = c & 31, ob = rr * 64 + cc * 2; return st * 1024 + (ob ^ (((ob >> 9) & 1) << 5)); }
__host__ __device__ __forceinline__ void stage_rc(int b, int& R, int& C) { const int st = b / 1024, sb = b % 1024, swz = sb ^ (((sb >> 9) & 1) << 5); R = (st >> 1) * 16 + swz / 64; C = (st & 1) * 32 + (swz % 64) / 2; }
__host__ __device__ __forceinline__ int perm32(int rho) { const int n = rho >> 4, i = rho & 15; return 8 * (i >> 2) + 4 * n + (i & 3); }
struct Unit { int pm, pn; };
struct StaticOrder {
    int nM, nN, nwg, G, c;
    __host__ __device__ void init(int nM_, int nN_, int G_, int c_) { nM = nM_; nN = nN_; nwg = nM * nN; G = G_; c = c_; }
    __host__ __device__ bool next(int i, Unit& u) const {
        const long L = (long)i * G + c; if (c < 0 || L >= nwg) return false;
        int wgid = (int)L; { const int q = nwg / NXCD, r = nwg % NXCD, xcd = wgid % NXCD, off = wgid / NXCD; wgid = (xcd < r ? xcd * (q + 1) : r * (q + 1) + (xcd - r) * q) + off; }
        const int nig = WGM * nN, gid = wgid / nig, fm = gid * WGM, gsz = (nM - fm) < WGM ? (nM - fm) : WGM;
        u.pm = fm + ((wgid % nig) % gsz); u.pn = (wgid % nig) / gsz; return true;
    }
};
template <class F> struct EpiV {
    F f;
    __device__ __forceinline__ void operator()(const f32x4 (&acc)[2][2][4][2], const Unit& u, int wr, int wc, int fr, int fq) const {
        const int row0 = u.pm * BM + wr * 64 + fr, col0 = u.pn * BM + wc * 32 + 8 * fq;
#pragma unroll
        for (int ai = 0; ai < 2; ++ai)
#pragma unroll
            for (int m = 0; m < 4; ++m)
#pragma unroll
                for (int bj = 0; bj < 2; ++bj) f(row0 + ai * HALF + m * 16, col0 + bj * HALF, acc[ai][bj][m][0], acc[ai][bj][m][1]);
    }
};
template <class Epi, class Sched, bool ALIGN_EPI = false>
__device__ __forceinline__ void gemm_phase(PG8_LAS unsigned char* lds, const int K, const int lda, const int ldb, const Sched& S, const Epi& E) {
    int tid_ = threadIdx.x; asm volatile("" : "+v"(tid_));
    const int tid = tid_, wid = __builtin_amdgcn_readfirstlane(tid >> 6), lane = tid & 63, wr = wid >> 2, wc = wid & 3, fr = lane & 15, fq = lane >> 4;
    const int nt = K / BK;
    unsigned voffA[2], voffB[2];
#pragma unroll
    for (int i = 0; i < 2; ++i) { int R, C; stage_rc(tid * 16 + i * 8192, R, C); const int Rb = (R & ~31) + perm32(R & 31);
        voffA[i] = (unsigned)(R * lda + C) * 2u; voffB[i] = (unsigned)(Rb * ldb + C) * 2u; }
    const size_t kstep = (size_t)(BK * 2);
    const size_t hstepA = (size_t)HALF * lda * 2, hstepB = (size_t)HALF * ldb * 2;
    const unsigned ldsw = (unsigned)wid * 1024u;
    const int aoff = lds_byte(wr * 64 + fr, fq * 8), boff = lds_byte(wc * 32 + fr, fq * 8);
#define PG8_SA(b, h) (((b) * 2 + (h)) * HTB)
#define PG8_SB(b, h) ((4 + (b) * 2 + (h)) * HTB)
#define PG8_STAGE(bufoff, gbase, voff) do { _Pragma("unroll") for (int _i = 0; _i < 2; ++_i) \
        __builtin_amdgcn_global_load_lds((const unsigned*)((const char*)(gbase) + (voff)[_i]), (PG8_LAS unsigned*)(lds + (bufoff) + ldsw + _i * 8192), 16, 0, 0); } while (0)
#define PG8_LDA(dst, b, h) do { _Pragma("unroll") for (int m = 0; m < 4; ++m) _Pragma("unroll") for (int k = 0; k < 2; ++k) dst[m][k] = *(const PG8_LAS bf16x8*)(lds + PG8_SA(b, h) + aoff + m * 2048 + k * 1024); } while (0)
#define PG8_LDB(dst, b, h) do { _Pragma("unroll") for (int n = 0; n < 2; ++n) _Pragma("unroll") for (int k = 0; k < 2; ++k) dst[n][k] = *(const PG8_LAS bf16x8*)(lds + PG8_SB(b, h) + boff + n * 2048 + k * 1024); } while (0)
#define PG8_MMA(ai, bj, At, Bt) do { __builtin_amdgcn_s_setprio(1); _Pragma("unroll") for (int m = 0; m < 4; ++m) _Pragma("unroll") for (int n = 0; n < 2; ++n) _Pragma("unroll") for (int k = 0; k < 2; ++k) \
        acc[ai][bj][m][n] = __builtin_amdgcn_mfma_f32_16x16x32_bf16(Bt[n][k], At[m][k], acc[ai][bj][m][n], 0, 0, 0); __builtin_amdgcn_s_setprio(0); } while (0)
#define PG8_WAIT_V(n) asm volatile("s_waitcnt vmcnt(" #n ")" ::: "memory")
#define PG8_WAIT_L(n) asm volatile("s_waitcnt lgkmcnt(" #n ")" ::: "memory")
#define PG8_BAR __builtin_amdgcn_s_barrier()
#define PG8_SCHED __builtin_amdgcn_sched_barrier(0)
    Unit cur, nxt; int ui = 0;
    if (!S.next(0, cur)) return;
    f32x4 acc[2][2][4][2];
#pragma unroll
    for (int a = 0; a < 2; ++a)
#pragma unroll
        for (int b = 0; b < 2; ++b)
#pragma unroll
            for (int m = 0; m < 4; ++m)
#pragma unroll
                for (int n = 0; n < 2; ++n) acc[a][b][m][n] = (f32x4){0.f, 0.f, 0.f, 0.f};
    bf16x8 At[4][2], B0[2][2], B1[2][2];
    const char* cA = S.a_base(cur); const char* cB = S.b_base(cur);
    PG8_STAGE(PG8_SB(0, 0), cB, voffB); PG8_STAGE(PG8_SB(0, 1), cB + hstepB, voffB); PG8_STAGE(PG8_SA(0, 0), cA, voffA); PG8_STAGE(PG8_SA(0, 1), cA + hstepA, voffA);
    if (wr == 1) PG8_BAR;
    PG8_WAIT_V(2); PG8_BAR;
    PG8_STAGE(PG8_SB(1, 0), cB + kstep, voffB); PG8_STAGE(PG8_SA(1, 0), cA + kstep, voffA); PG8_STAGE(PG8_SB(1, 1), cB + hstepB + kstep, voffB);
    PG8_WAIT_V(6); PG8_BAR;
    for (;;) {
        const bool has_next = S.next(ui + 1, nxt);
        const char* nA = has_next ? S.a_base(nxt) : cA; const char* nB = has_next ? S.b_base(nxt) : cB;
        for (int t = 0; t < nt; t += 2) {
            const bool last = (t == nt - 2);
            const char* a1 = cA + (size_t)(t + 1) * kstep;
            const char* a2 = last ? nA : cA + (size_t)(t + 2) * kstep; const char* b2 = last ? nB : cB + (size_t)(t + 2) * kstep;
            const char* a3 = a2 + kstep; const char* b3 = b2 + kstep;
            PG8_LDB(B0, 0, 0); PG8_LDB(B1, 0, 1); PG8_SCHED; PG8_LDA(At, 0, 0); PG8_STAGE(PG8_SA(1, 1), a1 + hstepA, voffA);
            PG8_WAIT_V(8); PG8_WAIT_L(0); PG8_BAR; PG8_MMA(0, 0, At, B0); PG8_MMA(0, 1, At, B1); PG8_BAR; PG8_SCHED;
            PG8_LDA(At, 0, 1); PG8_STAGE(PG8_SB(0, 0), b2, voffB); PG8_STAGE(PG8_SB(0, 1), b2 + hstepB, voffB); PG8_STAGE(PG8_SA(0, 0), a2, voffA);
            PG8_WAIT_V(8); PG8_WAIT_L(0); PG8_BAR; PG8_MMA(1, 0, At, B0); PG8_MMA(1, 1, At, B1); PG8_BAR; PG8_SCHED;
            PG8_LDB(B0, 1, 0); PG8_LDB(B1, 1, 1); PG8_SCHED; PG8_LDA(At, 1, 0); PG8_STAGE(PG8_SA(0, 1), a2 + hstepA, voffA);
            PG8_WAIT_V(8); PG8_WAIT_L(0); PG8_BAR; PG8_MMA(0, 0, At, B0); PG8_MMA(0, 1, At, B1); PG8_BAR; PG8_SCHED;
            PG8_LDA(At, 1, 1); PG8_STAGE(PG8_SB(1, 0), b3, voffB); PG8_STAGE(PG8_SB(1, 1), b3 + hstepB, voffB); PG8_STAGE(PG8_SA(1, 0), a3, voffA);
            PG8_WAIT_V(8); PG8_WAIT_L(0); PG8_BAR; PG8_MMA(1, 0, At, B0); PG8_MMA(1, 1, At, B1); PG8_BAR; PG8_SCHED;
        }
        if constexpr (ALIGN_EPI) { if (wr == 0) PG8_BAR; }
        E(acc, cur, wr, wc, fr, fq);
        if (!has_next) break;
#pragma unroll
        for (int a = 0; a < 2; ++a)
#pragma unroll
            for (int b = 0; b < 2; ++b)
#pragma unroll
                for (int m = 0; m < 4; ++m)
#pragma unroll
                    for (int n = 0; n < 2; ++n) acc[a][b][m][n] = (f32x4){0.f, 0.f, 0.f, 0.f};
        cur = nxt; cA = nA; cB = nB; ++ui;
        if constexpr (ALIGN_EPI) { if (wr == 1) PG8_BAR; }
    }
    PG8_WAIT_V(0);
    if constexpr (!ALIGN_EPI) { if (wr == 0) PG8_BAR; }
    PG8_BAR;
#undef PG8_SA
#undef PG8_SB
#undef PG8_STAGE
#undef PG8_LDA
#undef PG8_LDB
#undef PG8_MMA
#undef PG8_WAIT_V
#undef PG8_WAIT_L
#undef PG8_BAR
#undef PG8_SCHED
}
}

struct Frame {
    LAS unsigned char* lds;
    int tid, lane, wave, G, vcu, bx;
    unsigned char* ws; unsigned char* outb;
    const float* in[22];
};
struct Args { const float* in[22]; float* out; unsigned char* ws; };
DI int opaque_lane(const Frame& F) { int l = F.lane; asm volatile("" : "+v"(l)); return l; }

template <class RowMap>
DI void transpose_item(const float* W, int K, int N, bf16* WT, RowMap orow, LAS float* scr, int item, int lane) {
    const int nblk = N / 32, kb = item / nblk, nb = item % nblk, k0 = 64 * kb, n0 = 32 * nb;
#pragma unroll 8
    for (int i = 0; i < 32; ++i) { const int kk = 2 * i + (lane >> 5); scr[kk * 33 + (lane & 31)] = W[(size_t)(k0 + kk) * N + n0 + (lane & 31)]; }
    LDS_WAIT(); asm volatile("" ::: "memory");
    const int c = lane & 7;
#pragma unroll
    for (int j = 0; j < 4; ++j) { const int n = (lane >> 3) + 8 * j; const LAS float* s = scr + (8 * c) * 33 + n;
        u32x4 o; o.x = pk2(s[0 * 33], s[1 * 33]); o.y = pk2(s[2 * 33], s[3 * 33]); o.z = pk2(s[4 * 33], s[5 * 33]); o.w = pk2(s[6 * 33], s[7 * 33]);
        *(u32x4*)(WT + (size_t)orow(n0 + n) * K + k0 + 8 * c) = o; }
    LDS_WAIT(); asm volatile("" ::: "memory");
}
struct RowId { int off; DI int operator()(int n) const { return off + n; } };
struct RowW13 { int add; DI int operator()(int n) const { return ((n >> 2) << 3) + (n & 3) + add; } };

DI void phase0(Frame& F) {
    const int lane_ = F.lane;
    const float* c = F.in[1]; const float* w_ada = F.in[2]; const float* b_ada = F.in[3];
    float* MOD = (float*)(F.ws + WS_MOD);
    if (F.bx < 96) {
        const int j = F.bx * 64 + lane_;
        float a0 = 0.f, a1 = 0.f, a2 = 0.f, a3 = 0.f;
        const int k0 = F.wave * 128;
#pragma unroll 8
        for (int k = k0; k < k0 + 128; ++k) { const float w = w_ada[(size_t)k * 6144 + j]; a0 += c[k] * w; a1 += c[1024 + k] * w; a2 += c[2048 + k] * w; a3 += c[3072 + k] * w; }
        LAS float* red = (LAS float*)F.lds;
        red[(F.wave * 4 + 0) * 64 + lane_] = a0; red[(F.wave * 4 + 1) * 64 + lane_] = a1; red[(F.wave * 4 + 2) * 64 + lane_] = a2; red[(F.wave * 4 + 3) * 64 + lane_] = a3;
        __syncthreads();
        if (F.tid < 256) { const int b = F.tid >> 6, l = F.tid & 63; float s = b_ada[F.bx * 64 + l];
#pragma unroll
            for (int w = 0; w < 8; ++w) s += red[(w * 4 + b) * 64 + l];
            MOD[b * 6144 + F.bx * 64 + l] = s; }
        __syncthreads();
    }
    if (F.bx == 0 && F.tid < 8) ((float*)(F.ws + WS_DEC))[F.tid] = log2_sigmoid(F.tid < 4 ? F.in[6][F.tid] : F.in[7][F.tid - 4]);
    { const int gid = F.bx * NTHREADS + F.tid;
      if (gid < 36 * 1024) { const int o = gid >> 10, k = gid & 1023; float v;
          if (o < 4) v = F.in[13][k * 4 + o]; else { const int g = (o - 4) >> 3, e = (o - 4) & 7; v = F.in[15][((size_t)g * 1024 + k) * 8 + e]; }
          ((float*)(F.ws + WS_WROUT))[gid] = v; } }
    LAS float* scr = (LAS float*)(F.lds + 16384 + F.wave * 12288);
    const int gw = F.bx * NWAVES + F.wave, NGW = F.G * NWAVES;
    constexpr int I_IN = 16 * 400, I_A = 8 * 32, I_R = 32 * 32, I_O = 16 * 32;
    for (int it = gw; it < I_IN + I_A + I_R + I_O; it += NGW) {
        int r = it;
        if (r < I_IN) { transpose_item(F.in[4], 1024, C_END, (bf16*)(F.outb + OUT_WINT), RowId{0}, scr, r, lane_); continue; } r -= I_IN;
        if (r < I_A) { transpose_item(F.in[5], 512, 1024, (bf16*)(F.ws + WS_WAT), RowId{0}, scr, r, lane_); continue; } r -= I_A;
        if (r < I_R) { transpose_item(F.in[9], 2048, 1024, (bf16*)(F.ws + WS_WRT), RowId{0}, scr, r, lane_); continue; } r -= I_R;
        transpose_item(F.in[10], 1024, 1024, (bf16*)(F.ws + WS_WOT), RowId{0}, scr, r, lane_);
    }
}
DI void moe_weight_transposes(Frame& F) {
    const int lane_ = F.lane;
    LAS float* scr = (LAS float*)(F.lds + 16384 + F.wave * 12288);
    const int gw = F.bx * NWAVES + F.wave, NGW = F.G * NWAVES;
    bf16* W13T = (bf16*)(F.ws + WS_W13T); bf16* W2T = (bf16*)(F.ws + WS_W2T);
    for (int it = gw; it < 3 * 8192; it += NGW) {
        const int which = it >> 13, r = it & 8191, e = r >> 8, item = r & 255;
        if (which == 0) transpose_item(F.in[17] + (size_t)e * 1024 * 512, 1024, 512, W13T + (size_t)e * 1024 * 1024, RowW13{0}, scr, item, lane_);
        else if (which == 1) transpose_item(F.in[18] + (size_t)e * 1024 * 512, 1024, 512, W13T + (size_t)e * 1024 * 1024, RowW13{4}, scr, item, lane_);
        else transpose_item(F.in[19] + (size_t)e * 512 * 1024, 512, 1024, W2T + (size_t)e * 1024 * 512, RowId{0}, scr, item, lane_);
    }
}

DI void phase1(Frame& F) {
    const int lane_ = opaque_lane(F);
    const float* x = F.in[0]; const float* MOD = (const float*)(F.ws + WS_MOD); bf16* U = (bf16*)(F.outb + OUT_U);
    const int gw = F.bx * NWAVES + F.wave, NGW = F.G * NWAVES;
    for (int m = gw; m < NT; m += NGW) {
        const f32x4* xr = (const f32x4*)(x + (size_t)m * DM) + lane_; const int b = m >> 12;
        f32x4 v[4]; float s = 0.f;
#pragma unroll
        for (int j = 0; j < 4; ++j) { v[j] = xr[64 * j]; s += (v[j].x + v[j].y) + (v[j].z + v[j].w); }
        const float mean = wave_sum(s) * (1.f / DM); float s2 = 0.f;
#pragma unroll
        for (int j = 0; j < 4; ++j) { v[j] = v[j] - mean; s2 += (v[j].x * v[j].x + v[j].y * v[j].y) + (v[j].z * v[j].z + v[j].w * v[j].w); }
        const float rstd = 1.f / sqrtf(wave_sum(s2) * (1.f / DM) + LN_EPS);
        u32x2* o8 = (u32x2*)(U + (size_t)m * DM) + lane_;
#pragma unroll
        for (int j = 0; j < 4; ++j) { const int col = 256 * j + 4 * lane_;
            const f32x4 sh = *(const f32x4*)(MOD + b * 6144 + col), sc = *(const f32x4*)(MOD + b * 6144 + 1024 + col);
            const f32x4 u = v[j] * rstd * (sc + 1.f) + sh;
            u32x2 w; w.x = pk2(u.x, u.y); w.y = pk2(u.z, u.w); o8[64 * j] = w; }
    }
}

DI u32x4 pack8(f32x4 v0, f32x4 v1) { u32x4 w; w.x = pk2(v0[0], v0[1]); w.y = pk2(v0[2], v0[3]); w.z = pk2(v1[0], v1[1]); w.w = pk2(v1[2], v1[3]); return w; }

struct SchedR1 : pg8::StaticOrder { const char* U; const char* W;
    DI const char* a_base(const pg8::Unit& u) const { return U + (size_t)u.pm * 256 * 2048; }
    DI const char* b_base(const pg8::Unit& u) const { const int r = u.pn < 8 ? C_RQ + 256 * u.pn : C_RGT + 256 * (u.pn - 8); return W + (size_t)r * 2048; } };
struct EpiR1 { bf16 *RQ, *RK, *RG;
    DI void operator()(int row, int col, f32x4 v0, f32x4 v1) const {
        if (col < 1024) *(u32x4*)(RQ + blk_off(row, col, 64)) = pack8(v0, v1);
        else if (col < 2048) *(u32x4*)(RK + blk_off(row, col - 1024, 64)) = pack8(v0 * 0.0625f, v1 * 0.0625f);
        else *(u32x4*)(RG + (size_t)row * 2048 + col - 2048) = pack8(v0, v1); } };
struct SchedR2 : pg8::StaticOrder { const char* U; const char* W;
    DI const char* a_base(const pg8::Unit& u) const { const int r = u.pm < 8 ? C_RV + 256 * u.pm : C_RK + 256 * (u.pm - 8); return W + (size_t)r * 2048; }
    DI const char* b_base(const pg8::Unit& u) const { return U + (size_t)u.pn * 256 * 2048; } };
struct EpiR2 { bf16 *RVT, *KFT, *KBT; const float* DEC;
    DI void operator()(int row, int col, f32x4 v0, f32x4 v1) const {
        if (row < 2048) { *(u32x4*)(RVT + blk_off(row, col, 1024)) = pack8(v0, v1); return; }
        const int f = row - 2048, h = f >> 8; const float p0 = (float)(col & 127);
        const float a = DEC[h], b = DEC[4 + h];
        f32x4 kf0, kf1, kb0, kb1;
#pragma unroll
        for (int e = 0; e < 4; ++e) {
            const float pa = p0 + (float)e, pb = p0 + (float)(e + 4);
            kf0[e] = v0[e] * 0.0625f * __builtin_amdgcn_exp2f(a * (127.f - pa)); kf1[e] = v1[e] * 0.0625f * __builtin_amdgcn_exp2f(a * (127.f - pb));
            kb0[e] = v0[e] * 0.0625f * __builtin_amdgcn_exp2f(b * pa);           kb1[e] = v1[e] * 0.0625f * __builtin_amdgcn_exp2f(b * pb); }
        *(u32x4*)(KFT + blk_off(f, col, 1024)) = pack8(kf0, kf1);
        *(u32x4*)(KBT + blk_off(f, col, 1024)) = pack8(kb0, kb1); } };
struct SchedQK : pg8::StaticOrder { const char* U; const char* W; int g, r, nsub;
    DI const char* a_base(const pg8::Unit& u) const { const int b = u.pm >> 4, v0 = (u.pm & 15) * 256, rho = v0 / nsub, i0 = v0 % nsub; return U + (size_t)(b * SEQ + rho + r * i0) * 2048; }
    DI const char* b_base(const pg8::Unit& u) const { const int rw = (u.pn < 2 ? C_AQ : C_AK) + 512 * g + 256 * (u.pn & 1); return W + (size_t)rw * 2048; } };
struct EpiQK { bf16 *AQ, *AK;
    DI void operator()(int row, int col, f32x4 v0, f32x4 v1) const {
        if (col < 512) *(u32x4*)(AQ + blk_off(row, col, 32)) = pack8(v0, v1);
        else *(u32x4*)(AK + blk_off(row, col - 512, 32)) = pack8(v0, v1); } };
struct SchedGate : pg8::StaticOrder { const char* U; const char* W;
    DI const char* a_base(const pg8::Unit& u) const { return U + (size_t)u.pm * 256 * 2048; }
    DI const char* b_base(const pg8::Unit& u) const { return W + (size_t)(C_GA + 256 * u.pn) * 2048; } };
struct EpiGate { bf16 *GA, *GR;
    DI void operator()(int row, int col, f32x4 v0, f32x4 v1) const {
        f32x4 s0, s1;
#pragma unroll
        for (int e = 0; e < 4; ++e) { s0[e] = sigmoidf_(v0[e]); s1[e] = sigmoidf_(v1[e]); }
        bf16* dst = col < 1024 ? GA + (size_t)row * 1024 + col : GR + (size_t)row * 1024 + col - 1024;
        *(u32x4*)dst = pack8(s0, s1); } };
struct SchedA2 : pg8::StaticOrder { const char* U; const char* W; int g, r, nsub;
    DI const char* a_base(const pg8::Unit& u) const { return W + (size_t)(C_AV + 512 * g + 256 * u.pm) * 2048; }
    DI const char* b_base(const pg8::Unit& u) const { const int b = u.pn >> 4, v0 = (u.pn & 15) * 256, rho = v0 / nsub, i0 = v0 % nsub; return U + (size_t)(b * SEQ + rho + r * i0) * 2048; } };
struct EpiA2 { bf16* AVT;
    DI void operator()(int row, int col, f32x4 v0, f32x4 v1) const { *(u32x4*)(AVT + blk_off(row, col, 1024)) = pack8(v0, v1); } };
struct SchedG : pg8::StaticOrder { const char* A; const char* B; size_t abytes, bbytes;
    DI const char* a_base(const pg8::Unit& u) const { return A + (size_t)u.pm * abytes; }
    DI const char* b_base(const pg8::Unit& u) const { return B + (size_t)u.pn * bbytes; } };
struct EpiG1 { const bf16* GA; float* P1;
    DI void operator()(int row, int col, f32x4 v0, f32x4 v1) const {
        const u32x4 g = *(const u32x4*)(GA + (size_t)row * 1024 + col);
        f32x4 o0 = {v0[0] * bflo(g.x), v0[1] * bfhi(g.x), v0[2] * bflo(g.y), v0[3] * bfhi(g.y)}, o1 = {v1[0] * bflo(g.z), v1[1] * bfhi(g.z), v1[2] * bflo(g.w), v1[3] * bfhi(g.w)};
        *(f32x4*)(P1 + (size_t)row * 1024 + col) = o0; *(f32x4*)(P1 + (size_t)row * 1024 + col + 4) = o1; } };
struct EpiG2 { const bf16* GR; const float* P1; bf16* MERGED;
    DI void operator()(int row, int col, f32x4 v0, f32x4 v1) const {
        const u32x4 g = *(const u32x4*)(GR + (size_t)row * 1024 + col);
        const f32x4 p0 = *(const f32x4*)(P1 + (size_t)row * 1024 + col), p1 = *(const f32x4*)(P1 + (size_t)row * 1024 + col + 4);
        f32x4 o0 = {p0[0] + v0[0] * bflo(g.x), p0[1] + v0[1] * bfhi(g.x), p0[2] + v0[2] * bflo(g.y), p0[3] + v0[3] * bfhi(g.y)};
        f32x4 o1 = {p1[0] + v1[0] * bflo(g.z), p1[1] + v1[1] * bfhi(g.z), p1[2] + v1[2] * bflo(g.w), p1[3] + v1[3] * bfhi(g.w)};
        *(u32x4*)(MERGED + (size_t)row * 1024 + col) = pack8(o0, o1); } };
struct EpiG3 { const float* x; const float* MOD; float* H;
    DI void operator()(int row, int col, f32x4 v0, f32x4 v1) const {
        const int b = row >> 12; const float* gp = MOD + b * 6144 + 2048 + col; const float* xp = x + (size_t)row * 1024 + col;
        const f32x4 g0 = *(const f32x4*)gp, g1 = *(const f32x4*)(gp + 4), x0 = *(const f32x4*)xp, x1 = *(const f32x4*)(xp + 4);
        *(f32x4*)(H + (size_t)row * 1024 + col) = x0 * ALPHA + g0 * v0; *(f32x4*)(H + (size_t)row * 1024 + col + 4) = x1 * ALPHA + g1 * v1; } };
struct SchedM : pg8::StaticOrder { const char* A; const char* B; size_t abytes, ebytes, bbytes; const LAS int* texp;
    DI const char* a_base(const pg8::Unit& u) const { return A + (size_t)u.pm * abytes; }
    DI const char* b_base(const pg8::Unit& u) const { return B + (size_t)texp[u.pm] * ebytes + (size_t)u.pn * bbytes; } };
struct EpiM3 { bf16* HDN;
    DI void operator()(int row, int col, f32x4 a, f32x4 b) const {
        f32x4 o;
#pragma unroll
        for (int e = 0; e < 4; ++e) o[e] = a[e] * sigmoidf_(a[e]) * b[e];
        u32x2 w; w.x = pk2(o[0], o[1]); w.y = pk2(o[2], o[3]);
        *(u32x2*)(HDN + (size_t)row * 512 + (col >> 1)) = w; } };
struct EpiM4 { bf16* Y;
    DI void operator()(int row, int col, f32x4 v0, f32x4 v1) const { *(u32x4*)(Y + (size_t)row * 1024 + col) = pack8(v0, v1); } };

DI void ret_intra(Frame& F) {
    const int lane_ = F.lane;
    const bf16* RQ = (const bf16*)(F.ws + WS_RQ); const bf16* RK = (const bf16*)(F.ws + WS_RK); const bf16* RVT = (const bf16*)(F.ws + WS_RVT); bf16* Y = (bf16*)(F.ws + WS_Y);
    const float* DEC = (const float*)(F.ws + WS_DEC);
    const int r = lane_ & 31, h = lane_ >> 5;
    const int gw = F.vcu * NWAVES + F.wave, NGW = F.G * NWAVES;
    for (int it = gw; it < 4096; it += NGW) {
        const int dh = it & 1, ntl = (it >> 1) & 3, ch = (it >> 3) & 31, hd = (it >> 8) & 3, b = it >> 10;
        const int tok0 = b * SEQ + ch * 128, rb0 = tok0 >> 5;
        const float lf = DEC[hd], lb = DEC[4 + hd];
        f32x16 pT[4]; for (int i = 0; i < 4; ++i) pT[i] = zero16();
        const bf16* qp = RQ + ((size_t)(rb0 + ntl) * 64 + hd * 16) * 512 + lane_ * 8;
        const bf16* kp = RK + ((size_t)rb0 * 64 + hd * 16) * 512 + lane_ * 8;
#pragma unroll 4
        for (int ks = 0; ks < 16; ++ks) {
            const bf16x8 bq = ld16(qp + ks * 512);
#pragma unroll
            for (int mt = 0; mt < 4; ++mt) { const bf16x8 ak = ld16(kp + (size_t)mt * 64 * 512 + ks * 512); pT[mt] = MFMA32(ak, bq, pT[mt]); }
        }
        bf16x8 pb[4][2];
        const int n = 32 * ntl + r;
#pragma unroll
        for (int mt = 0; mt < 4; ++mt) {
#pragma unroll
            for (int i = 0; i < 16; ++i) { const int m = 32 * mt + crow(i, h); const int d = n - m;
                const float w = d >= 0 ? __builtin_amdgcn_exp2f(lf * (float)d) : __builtin_amdgcn_exp2f(lb * (float)(-d));
                pT[mt][i] *= w; }
            pb[mt][0] = pack_step(pT[mt], 0); pb[mt][1] = pack_step(pT[mt], 1);
        }
#pragma unroll 4
        for (int dt = 0; dt < 8; ++dt) {
            const int dv0 = hd * 512 + dh * 256 + dt * 32;
            const bf16* vp = RVT + ((size_t)(dv0 >> 5) * 1024 + (tok0 >> 4)) * 512 + r * 8 + 4 * h;
            f32x16 acc = zero16();
#pragma unroll
            for (int mt = 0; mt < 4; ++mt)
#pragma unroll
                for (int s2 = 0; s2 < 2; ++s2) { const bf16* bp = vp + (2 * mt + s2) * 512; acc = MFMA32(ld8x2(bp, bp + 256), pb[mt][s2], acc); }
            char* yp = (char*)Y + ((((size_t)(b * 4 + hd) * 32 + ch) * 4 + ntl) * 16 + dh * 8 + dt) * 2048 + lane_ * 32;
            u32x4 w0, w1;
            w0.x = pk2(acc[0], acc[1]); w0.y = pk2(acc[2], acc[3]); w0.z = pk2(acc[4], acc[5]); w0.w = pk2(acc[6], acc[7]);
            w1.x = pk2(acc[8], acc[9]); w1.y = pk2(acc[10], acc[11]); w1.z = pk2(acc[12], acc[13]); w1.w = pk2(acc[14], acc[15]);
            *(u32x4*)yp = w0; *(u32x4*)(yp + 16) = w1;
        }
    }
}
#define SBAR_ __builtin_amdgcn_sched_barrier(0)
constexpr int ST_SZ = 16 * 512, VT_SZ = 8 * 512, VT_OFF = 2 * 2 * ST_SZ;
DI bf16x8 ldg16(const char* base, unsigned off) { return *(const bf16x8*)(base + off); }
template <int VAR> DI void ret_scan(Frame& F) {
    const int lane_ = F.lane;
    const int r = lane_ & 31, h = lane_ >> 5, dir = F.wave >> 2, wg = F.wave & 3;
    LAS bf16* ST = (LAS bf16*)F.lds + dir * (2 * ST_SZ);
    LAS bf16* VT = (LAS bf16*)F.lds + VT_OFF + dir * (2 * VT_SZ);
    const unsigned loff = (unsigned)lane_ * 16u;
    const unsigned voff = (unsigned)(wg * 64 + lane_) * 32u;
    for (int unit = F.vcu; unit < 256; unit += F.G) {
        const int sl = unit & 15, hd = (unit >> 4) & 3, b = unit >> 6;
        const float lg = ((const float*)(F.ws + WS_DEC))[4 * dir + hd];
        const float cd = __builtin_amdgcn_exp2f(lg * 128.f);
        const float p = (float)(32 * wg + r);
        const float qd = dir ? __builtin_amdgcn_exp2f(lg * (128.f - p)) : __builtin_amdgcn_exp2f(lg * (p + 1.f));
        const char* qb = (const char*)(F.ws + WS_RQ) + (((size_t)(b * 128 + wg) * 64) + hd * 16) * 1024;
        const char* kb = (const char*)(F.ws + (dir ? WS_KBT : WS_KFT)) + ((size_t)(hd * 8 + 2 * wg) * 1024 + b * 256) * 1024;
        const char* vb = (const char*)(F.ws + WS_RVT) + ((size_t)(hd * 16 + sl) * 1024 + b * 256) * 1024;
        char* yb = VAR == 0 ? (char*)(F.ws + WS_Y) + ((((size_t)(b * 4 + hd) * 32) * 4 + wg) * 16 + sl) * 2048 : (char*)(F.ws + 339 * MiB) + (size_t)unit * 16384 + (dir * 4 + wg) * 2048;
#ifndef SCAN_SKEW
#define SCAN_SKEW 6
#endif
        if (sl != 0) { for (int z = 0; z < SCAN_SKEW; ++z) __builtin_amdgcn_s_sleep(16); }
        bf16x8 Qf[16], Kf0[8], Kf1[8];
        { const int c0 = dir ? 31 : 0, c1 = dir ? 30 : 1;
          const bf16x8 va = ldg16(vb + c0 * 8192, voff), vb2 = ldg16(vb + c0 * 8192, voff + 16);
#pragma unroll
          for (int ks = 0; ks < 8; ++ks) { Kf0[ks] = ldg16(kb + c0 * 8192, loff + 1024 * ks); Kf1[ks] = ldg16(kb + (size_t)1024 * 1024 + c0 * 8192, loff + 1024 * ks); }
#pragma unroll
          for (int ks = 0; ks < 16; ++ks) Qf[ks] = ldg16(qb + (size_t)c1 * 4 * 65536, loff + 1024 * ks);
          *(LAS bf16x8*)((LAS char*)VT + voff) = va; *(LAS bf16x8*)((LAS char*)VT + voff + 16) = vb2; }
        asm volatile("s_waitcnt lgkmcnt(0)" ::: "memory"); __builtin_amdgcn_s_barrier(); asm volatile("" ::: "memory");
        f32x16 S0 = zero16(), S1 = zero16();
        u32x4 yv0 = {0u, 0u, 0u, 0u}, yv1 = {0u, 0u, 0u, 0u};
#pragma unroll
        for (int step = 0; step < 32; ++step) {
            const int ch = dir ? 31 - step : step;
            int chn = dir ? ch - 1 : ch + 1; chn = chn < 0 ? 0 : (chn > 31 ? 31 : chn);
            const int cur = step & 1;
            char* yp = (VAR == 0 ? yb + (size_t)ch * 4 * 16 * 2048 : yb) + lane_ * 32;
            if (step > 0 && (step >= 15 && step <= 17) && VAR != 2 && VAR != 5) { yv0 = __builtin_nontemporal_load((const u32x4*)yp); yv1 = __builtin_nontemporal_load((const u32x4*)(yp + 16)); }
            SBAR_;
            if (step > 0) {
                const LAS char* sp = (const LAS char*)(ST + cur * ST_SZ) + loff;
                f32x16 acc = zero16();
#pragma unroll
                for (int kg = 0; kg < 8; ++kg) {
                    bf16x8 as[2];
#pragma unroll
                    for (int k = 0; k < 2; ++k) as[k] = *(const LAS bf16x8*)(sp + 1024 * (2 * kg + k));
#pragma unroll
                    for (int k = 0; k < 2; ++k) acc = MFMA32(as[k], Qf[2 * kg + k], acc);
                    SBAR_;
                }
                u32x4 w0, w1;
#pragma unroll
                for (int k = 0; k < 4; ++k) { w0[k] = pk2(bflo(yv0[k]) + acc[2 * k] * qd, bfhi(yv0[k]) + acc[2 * k + 1] * qd); w1[k] = pk2(bflo(yv1[k]) + acc[8 + 2 * k] * qd, bfhi(yv1[k]) + acc[8 + 2 * k + 1] * qd); }
                if (VAR == 2 || VAR == 5) asm volatile("" :: "v"(w0.x), "v"(w0.y), "v"(w0.z), "v"(w0.w), "v"(w1.x), "v"(w1.y), "v"(w1.z), "v"(w1.w)); else { *(u32x4*)yp = w0; *(u32x4*)(yp + 16) = w1; }
                SBAR_;
            }
            if (step < 31 && !(step + 1 >= 15 && step + 1 <= 17) && VAR != 2 && VAR != 5) {
                const char* ypn = (VAR == 0 ? yb + (size_t)chn * 4 * 16 * 2048 : yb) + lane_ * 32;
                yv0 = __builtin_nontemporal_load((const u32x4*)ypn); yv1 = __builtin_nontemporal_load((const u32x4*)(ypn + 16)); }
            SBAR_;
            if (step > 0 && VAR != 3 && VAR != 5) {
#pragma unroll
                for (int ks = 0; ks < 16; ++ks) Qf[ks] = ldg16(qb + (size_t)chn * 4 * 65536, loff + 1024 * ks);
            }
            SBAR_;
            const bf16x8 vn0 = ldg16(vb + chn * 8192, voff), vn1 = ldg16(vb + chn * 8192, voff + 16);
            if (step < 31) {
#pragma unroll
                for (int i = 0; i < 16; ++i) { S0[i] *= cd; S1[i] *= cd; }
                const LAS char* vp = (const LAS char*)(VT + cur * VT_SZ) + loff;
#pragma unroll
                for (int kg = 0; kg < 2; ++kg) {
                    bf16x8 bv[4];
#pragma unroll
                    for (int k = 0; k < 4; ++k) bv[k] = *(const LAS bf16x8*)(vp + 1024 * (4 * kg + k));
#pragma unroll
                    for (int k = 0; k < 4; ++k) { S0 = MFMA32(Kf0[4 * kg + k], bv[k], S0); S1 = MFMA32(Kf1[4 * kg + k], bv[k], S1); }
                    SBAR_;
                }
                if (VAR != 4 && VAR != 5) {
#pragma unroll
                for (int ks = 0; ks < 8; ++ks) { Kf0[ks] = ldg16(kb + chn * 8192, loff + 1024 * ks); Kf1[ks] = ldg16(kb + (size_t)1024 * 1024 + chn * 8192, loff + 1024 * ks); } }
                SBAR_;
                LAS char* vw = (LAS char*)(VT + (cur ^ 1) * VT_SZ) + voff;
                *(LAS bf16x8*)vw = vn0; *(LAS bf16x8*)(vw + 16) = vn1;
                LAS bf16* wp = ST + (cur ^ 1) * ST_SZ + (4 * wg) * 512 + r * 8 + 4 * h;
#pragma unroll
                for (int g = 0; g < 4; ++g) {
                    u32x2 w0; w0.x = pk2(S0[4 * g], S0[4 * g + 1]); w0.y = pk2(S0[4 * g + 2], S0[4 * g + 3]); *(LAS u32x2*)(wp + (g >> 1) * 512 + (g & 1) * 256) = w0;
                    u32x2 w1; w1.x = pk2(S1[4 * g], S1[4 * g + 1]); w1.y = pk2(S1[4 * g + 2], S1[4 * g + 3]); *(LAS u32x2*)(wp + (2 + (g >> 1)) * 512 + (g & 1) * 256) = w1; }
            }
            if (step >= 12 && step <= 18) asm volatile("s_waitcnt vmcnt(0)" ::: "memory");
            asm volatile("s_waitcnt lgkmcnt(0)" ::: "memory"); __builtin_amdgcn_s_barrier(); asm volatile("" ::: "memory"); SBAR_;
        }
        VM_WAIT();
    }
}
template <bool DRY> DI void ret_norm(Frame& F) {
    const int lane_ = F.lane;
    const char* Y = (const char*)(F.ws + WS_Y); bf16* RG = (bf16*)(F.ws + WS_RG); bf16* OUTP = DRY ? (bf16*)(F.ws + WS_RQ) : RG; const float* gain = F.in[8];
    const int r = lane_ & 31, h = lane_ >> 5;
    LAS char* T = (LAS char*)F.lds + F.wave * (32 * 272);
    const int gw = F.bx * NWAVES + F.wave, NGW = F.G * NWAVES;
    for (int it = gw; it < 2048; it += NGW) {
        const int ntl = it & 3, ch = (it >> 2) & 31, hd = (it >> 7) & 3, b = it >> 9;
        const char* yp = Y + ((size_t)it * 16) * 2048 + lane_ * 32;
        const size_t tok0 = (size_t)b * SEQ + ch * 128 + 32 * ntl;
        float s = 0.f, s2 = 0.f;
#pragma unroll 4
        for (int dvt = 0; dvt < 16; ++dvt) { const u32x4 a = *(const u32x4*)(yp + dvt * 2048), c = *(const u32x4*)(yp + dvt * 2048 + 16);
#pragma unroll
            for (int k = 0; k < 4; ++k) { const float x0 = bflo(a[k]), x1 = bfhi(a[k]), x2 = bflo(c[k]), x3 = bfhi(c[k]); s += (x0 + x1) + (x2 + x3); s2 += (x0 * x0 + x1 * x1) + (x2 * x2 + x3 * x3); } }
        s += __shfl_xor(s, 32); s2 += __shfl_xor(s2, 32);
        const float mean = s * (1.f / 512.f);
        const float var = fmaxf(s2 * (1.f / 512.f) - mean * mean, 0.f);
        const float rstd = 1.f / sqrtf(var + LN_EPS);
#pragma unroll 1
        for (int grp = 0; grp < 4; ++grp) {
#pragma unroll
            for (int t = 0; t < 4; ++t) {
                const u32x4 a = *(const u32x4*)(yp + (4 * grp + t) * 2048), c = *(const u32x4*)(yp + (4 * grp + t) * 2048 + 16);
                const u32x2 av[4] = {{a.x, a.y}, {a.z, a.w}, {c.x, c.y}, {c.z, c.w}};
#pragma unroll
                for (int q = 0; q < 4; ++q) { u32x2 w; w.x = pk2((bflo(av[q].x) - mean) * rstd, (bfhi(av[q].x) - mean) * rstd); w.y = pk2((bflo(av[q].y) - mean) * rstd, (bfhi(av[q].y) - mean) * rstd);
                    *(LAS u32x2*)(T + r * 272 + (32 * t + 8 * q + 4 * h) * 2) = w; }
            }
            LDS_WAIT(); asm volatile("" ::: "memory");
#pragma unroll
            for (int k = 0; k < 8; ++k) {
                const int task = lane_ + 64 * k, tk = task >> 4, cchunk = task & 15;
                const u32x4 v = *(const LAS u32x4*)(T + tk * 272 + cchunk * 16);
                const int col = hd * 512 + 128 * grp + 8 * cchunk;
                const size_t off = (tok0 + tk) * 2048 + col;
                const u32x4 gwv = *(const u32x4*)(RG + off); const f32x4 ga = *(const f32x4*)(gain + col), gb = *(const f32x4*)(gain + col + 4);
                float o[8];
#pragma unroll
                for (int e = 0; e < 4; ++e) { const float g0 = bflo(gwv[e]), g1 = bfhi(gwv[e]); const float n0 = e < 2 ? ga[2 * e] : gb[2 * e - 4], n1 = e < 2 ? ga[2 * e + 1] : gb[2 * e - 3];
                    o[2 * e] = g0 * sigmoidf_(g0) * bflo(v[e]) * n0; o[2 * e + 1] = g1 * sigmoidf_(g1) * bfhi(v[e]) * n1; }
                u32x4 w; w.x = pk2(o[0], o[1]); w.y = pk2(o[2], o[3]); w.z = pk2(o[4], o[5]); w.w = pk2(o[6], o[7]);
                *(u32x4*)(OUTP + off) = w;
            }
            LDS_WAIT(); asm volatile("" ::: "memory");
        }
    }
}

DI void attn_phase(Frame& F) {
    const int lane_ = F.lane;
    float* LSE = (float*)(F.ws + WS_LSE);
    const int r = lane_ & 31, h = lane_ >> 5;
    const int gw = F.vcu * NWAVES + F.wave, NGW = F.G * NWAVES;
    for (int it = gw; it < 6144; it += NGW) {
        const int g = it >> 11, rem = it & 2047;
        const int dil = g == 0 ? 1 : (g == 1 ? 4 : 16), nsub = SEQ / dil, nqt = nsub >> 5;
        const int qt = rem % nqt; const int rem2 = rem / nqt; const int rho = rem2 % dil; const int bh = rem2 / dil; const int hg = bh & 3, b = bh >> 2;
        const int head = 4 * g + hg;
        const float slope = __builtin_amdgcn_exp2f(-8.f * (float)(head + 1) * (1.f / 12.f)) * (float)dil;
        const bf16* AQ = (const bf16*)(F.ws + WS_AQ + (size_t)g * 16 * MiB); const bf16* AK = (const bf16*)(F.ws + WS_AK + (size_t)g * 16 * MiB);
        const bf16* AVT = (const bf16*)(F.ws + WS_AVT) + (size_t)g * 512 * NT;
        bf16* OG = (bf16*)(F.ws + (g == 0 ? WS_O0 : (g == 1 ? WS_O1 : WS_O2)));
        const int i0 = 32 * qt;
        const int v0 = b * SEQ + rho * nsub;
        const size_t tokbase = (size_t)b * SEQ + rho;
        bf16x8 bq[8];
        { const bf16* qp = AQ + ((size_t)((v0 + i0) >> 5) * 32 + hg * 8) * 512 + lane_ * 8;
#pragma unroll
          for (int ks = 0; ks < 8; ++ks) bq[ks] = ld16(qp + ks * 512); }
        f32x16 sT[5];
#pragma unroll
        for (int kt = 0; kt < 5; ++kt) {
            int ik0 = i0 - 64 + 32 * kt; ik0 = ik0 < 0 ? 0 : (ik0 >= nsub ? nsub - 32 : ik0);
            const bf16* kp = AK + ((size_t)((v0 + ik0) >> 5) * 32 + hg * 8) * 512 + lane_ * 8;
            f32x16 acc = zero16();
#pragma unroll
            for (int ks = 0; ks < 8; ++ks) acc = MFMA32(ld16(kp + ks * 512), bq[ks], acc);
            sT[kt] = acc;
        }
        const int iq = i0 + r;
        float mx = -3.0e38f;
#pragma unroll
        for (int kt = 0; kt < 5; ++kt)
#pragma unroll
            for (int i = 0; i < 16; ++i) { const int ik = i0 - 64 + 32 * kt + crow(i, h); const int d = ik - iq; const int ad = d < 0 ? -d : d;
                const bool valid = (ad <= 64) && (ik >= 0) && (ik < nsub);
                const float sc = valid ? sT[kt][i] * 0.08838834764831845f - slope * (float)ad : -1e30f;
                sT[kt][i] = sc; mx = fmaxf(mx, sc); }
        mx = fmaxf(mx, __shfl_xor(mx, 32));
        float sum = 0.f;
#pragma unroll
        for (int kt = 0; kt < 5; ++kt)
#pragma unroll
            for (int i = 0; i < 16; ++i) { const float p = __expf(sT[kt][i] - mx); sT[kt][i] = p; sum += p; }
        sum += __shfl_xor(sum, 32);
        const float inv = 1.f / sum;
        if (h == 0) LSE[((size_t)g * NT + tokbase + (size_t)dil * iq) * 4 + hg] = mx + __logf(sum);
        bf16x8 pb[5][2];
#pragma unroll
        for (int kt = 0; kt < 5; ++kt) { pb[kt][0] = pack_step(sT[kt], 0); pb[kt][1] = pack_step(sT[kt], 1); }
        bf16* op = OG + (tokbase + (size_t)dil * iq) * 512 + hg * 128 + 4 * h;
#pragma unroll
        for (int dt = 0; dt < 4; ++dt) {
            const bf16* vp = AVT + ((size_t)(hg * 4 + dt) * 1024) * 512 + r * 8 + 4 * h;
            f32x16 acc = zero16();
#pragma unroll
            for (int kt = 0; kt < 5; ++kt) {
                int ik0 = i0 - 64 + 32 * kt; ik0 = ik0 < 0 ? 0 : (ik0 >= nsub ? nsub - 32 : ik0);
                const bf16* bp = vp + (size_t)((v0 + ik0) >> 4) * 512;
#pragma unroll
                for (int s2 = 0; s2 < 2; ++s2) acc = MFMA32(ld8x2(bp + s2 * 512, bp + s2 * 512 + 256), pb[kt][s2], acc);
            }
#pragma unroll
            for (int q = 0; q < 4; ++q) { u32x2 w; w.x = pk2(acc[4 * q] * inv, acc[4 * q + 1] * inv); w.y = pk2(acc[4 * q + 2] * inv, acc[4 * q + 3] * inv); *(u32x2*)(op + 32 * dt + 8 * q) = w; }
        }
    }
}
DI void attn_mix(Frame& F) {
    const int lane_ = opaque_lane(F);
    const bf16* O0 = (const bf16*)(F.ws + WS_O0); const bf16* O1 = (const bf16*)(F.ws + WS_O1); const bf16* O2 = (const bf16*)(F.ws + WS_O2);
    const float* LSE = (const float*)(F.ws + WS_LSE); bf16* MIX = (bf16*)(F.ws + WS_ATTMIX);
    const int gw = F.bx * NWAVES + F.wave, NGW = F.G * NWAVES;
    for (int m = gw; m < NT; m += NGW) {
        const int hg = lane_ >> 4;
        const float l0 = LSE[((size_t)0 * NT + m) * 4 + hg], l1 = LSE[((size_t)1 * NT + m) * 4 + hg], l2 = LSE[((size_t)2 * NT + m) * 4 + hg];
        const float mx = fmaxf(l0, fmaxf(l1, l2)); const float e0 = __expf(l0 - mx), e1 = __expf(l1 - mx), e2 = __expf(l2 - mx); const float inv = 1.f / (e0 + e1 + e2);
        const float w0 = e0 * inv, w1 = e1 * inv, w2 = e2 * inv;
        const size_t off = (size_t)m * 512 + 8 * lane_;
        const u32x4 a = *(const u32x4*)(O0 + off), b = *(const u32x4*)(O1 + off), c = *(const u32x4*)(O2 + off);
        u32x4 o;
        o.x = pk2(w0 * bflo(a.x) + w1 * bflo(b.x) + w2 * bflo(c.x), w0 * bfhi(a.x) + w1 * bfhi(b.x) + w2 * bfhi(c.x));
        o.y = pk2(w0 * bflo(a.y) + w1 * bflo(b.y) + w2 * bflo(c.y), w0 * bfhi(a.y) + w1 * bfhi(b.y) + w2 * bfhi(c.y));
        o.z = pk2(w0 * bflo(a.z) + w1 * bflo(b.z) + w2 * bflo(c.z), w0 * bfhi(a.z) + w1 * bfhi(b.z) + w2 * bfhi(c.z));
        o.w = pk2(w0 * bflo(a.w) + w1 * bflo(b.w) + w2 * bflo(c.w), w0 * bfhi(a.w) + w1 * bfhi(b.w) + w2 * bfhi(c.w));
        *(u32x4*)(MIX + off) = o;
    }
}

DI float reduce4(const float (&p)[4], int lane) {
    const bool hi = (lane & 32) != 0;
    float a0 = hi ? p[2] : p[0], a1 = hi ? p[3] : p[1]; const float b0 = hi ? p[0] : p[2], b1 = hi ? p[1] : p[3];
    a0 += __shfl_xor(b0, 32); a1 += __shfl_xor(b1, 32);
    const bool hi2 = (lane & 16) != 0;
    float c = hi2 ? a1 : a0; const float d = hi2 ? a0 : a1;
    c += __shfl_xor(d, 16);
    c += __shfl_xor(c, 8); c += __shfl_xor(c, 4); c += __shfl_xor(c, 2); c += __shfl_xor(c, 1);
    return c;
}
DI void bcast4(float c, float (&o)[4]) {
#pragma unroll
    for (int t = 0; t < 4; ++t) o[t] = __builtin_bit_cast(float, __builtin_amdgcn_readlane(__builtin_bit_cast(int, c), 16 * t));
}
template <bool DRY> DI void moe_route(Frame& F) {
    const int lane_ = opaque_lane(F);
    float* H = (float*)F.outb; float* HO = DRY ? (float*)(F.ws + WS_XG) : H; const float* MOD = (const float*)(F.ws + WS_MOD); const float* WR = (const float*)(F.ws + WS_WROUT);
    bf16* U2 = (bf16*)(F.ws + (DRY ? WS_XG + 64 * MiB : WS_U2)); unsigned* ROUTE = (unsigned*)(F.ws + (DRY ? WS_XG + 100 * MiB : WS_ROUTE)); unsigned* CNT = (unsigned*)(F.ws + WS_CTL) + CW_CNT + (DRY ? 4096 : 0);
    const float* g1 = F.in[11]; const float* b1 = F.in[12]; const float* bco = F.in[14]; const float* bfi = F.in[16];
    LAS float* lg = (LAS float*)F.lds + F.wave * 256;
    const int gw = F.bx * NWAVES + F.wave, NGW = F.G * NWAVES;
    f32x4 un[4][4];
    { const int m0 = gw * 4;
      if (m0 < NT) {
#pragma unroll
        for (int t = 0; t < 4; ++t) { const f32x4* hr = (const f32x4*)(H + (size_t)(m0 + t) * DM) + lane_;
#pragma unroll
            for (int j = 0; j < 4; ++j) un[t][j] = hr[64 * j]; } } }
    for (int m0 = gw * 4; m0 < NT; m0 += NGW * 4) {
        const int b = m0 >> 12;
        f32x4 u[4][4];
        float ps[4], tot[4];
#pragma unroll
        for (int t = 0; t < 4; ++t) { float s = 0.f;
#pragma unroll
            for (int j = 0; j < 4; ++j) { u[t][j] = un[t][j]; s += (u[t][j].x + u[t][j].y) + (u[t][j].z + u[t][j].w); }
            ps[t] = s; }
        { const int m1 = m0 + NGW * 4;
          if (m1 < NT) {
#pragma unroll
            for (int t = 0; t < 4; ++t) { const f32x4* hr = (const f32x4*)(H + (size_t)(m1 + t) * DM) + lane_;
#pragma unroll
                for (int j = 0; j < 4; ++j) un[t][j] = hr[64 * j]; } } }
        bcast4(reduce4(ps, lane_), tot);
#pragma unroll
        for (int t = 0; t < 4; ++t) { const float mean = tot[t] * (1.f / DM); float s2 = 0.f;
#pragma unroll
            for (int j = 0; j < 4; ++j) { u[t][j] = u[t][j] - mean; s2 += (u[t][j].x * u[t][j].x + u[t][j].y * u[t][j].y) + (u[t][j].z * u[t][j].z + u[t][j].w * u[t][j].w); }
            ps[t] = s2; }
        bcast4(reduce4(ps, lane_), tot);
#pragma unroll
        for (int t = 0; t < 4; ++t) { const float rstd = 1.f / sqrtf(tot[t] * (1.f / DM) + LN_EPS); f32x4* hw = (f32x4*)(HO + (size_t)(m0 + t) * DM) + lane_; float s = 0.f;
#pragma unroll
            for (int j = 0; j < 4; ++j) { const int col = 256 * j + 4 * lane_; const f32x4 gg = *(const f32x4*)(g1 + col), bb = *(const f32x4*)(b1 + col);
                u[t][j] = u[t][j] * rstd * gg + bb; hw[64 * j] = u[t][j]; s += (u[t][j].x + u[t][j].y) + (u[t][j].z + u[t][j].w); }
            ps[t] = s; }
        bcast4(reduce4(ps, lane_), tot);
#pragma unroll
        for (int t = 0; t < 4; ++t) { const float mean = tot[t] * (1.f / DM); float s2 = 0.f;
#pragma unroll
            for (int j = 0; j < 4; ++j) { u[t][j] = u[t][j] - mean; s2 += (u[t][j].x * u[t][j].x + u[t][j].y * u[t][j].y) + (u[t][j].z * u[t][j].z + u[t][j].w * u[t][j].w); }
            ps[t] = s2; }
        bcast4(reduce4(ps, lane_), tot);
#pragma unroll
        for (int t = 0; t < 4; ++t) { const float rstd = 1.f / sqrtf(tot[t] * (1.f / DM) + LN_EPS); u32x2* o8 = (u32x2*)(U2 + (size_t)(m0 + t) * DM) + lane_;
#pragma unroll
            for (int j = 0; j < 4; ++j) { const int col = 256 * j + 4 * lane_;
                const f32x4 sh = *(const f32x4*)(MOD + b * 6144 + 3072 + col), sc = *(const f32x4*)(MOD + b * 6144 + 4096 + col);
                u[t][j] = u[t][j] * rstd * (sc + 1.f) + sh;
                u32x2 w; w.x = pk2(u[t][j].x, u[t][j].y); w.y = pk2(u[t][j].z, u[t][j].w); o8[64 * j] = w; } }
#ifndef ROUTE_NO
#define ROUTE_NO 36
#endif
#pragma unroll 2
        for (int o = 0; o < (DRY ? ROUTE_NO : 36); ++o) {
            const f32x4* wr = (const f32x4*)(WR + o * 1024) + lane_;
            f32x4 w[4];
#pragma unroll
            for (int j = 0; j < 4; ++j) w[j] = wr[64 * j];
#pragma unroll
            for (int t = 0; t < 4; ++t) { float a = 0.f;
#pragma unroll
                for (int j = 0; j < 4; ++j) a += (u[t][j].x * w[j].x + u[t][j].y * w[j].y) + (u[t][j].z * w[j].z + u[t][j].w * w[j].w);
                ps[t] = a; }
            const float c = reduce4(ps, lane_);
            if ((lane_ & 15) == 0) lg[(lane_ >> 4) * 64 + o] = c;
        }
        LDS_WAIT(); asm volatile("" ::: "memory");
        if (lane_ < 4) {
            const int t = lane_, m = m0 + t; const LAS float* L = lg + t * 64;
            float c[4]; int gs = 0; float cm = -3.0e38f;
#pragma unroll
            for (int j = 0; j < 4; ++j) { c[j] = L[j] + bco[j]; if (c[j] > cm) { cm = c[j]; gs = j; } }
            float den = 0.f;
#pragma unroll
            for (int j = 0; j < 4; ++j) den += __expf(c[j] - cm);
            const float pg = 1.f / den;
            float f[8];
#pragma unroll
            for (int e = 0; e < 8; ++e) f[e] = L[4 + 8 * gs + e] + bfi[8 * gs + e];
            int i0 = 0; float v0 = f[0];
#pragma unroll
            for (int e = 1; e < 8; ++e) if (f[e] > v0) { v0 = f[e]; i0 = e; }
            int i1 = -1; float v1 = -3.0e38f;
#pragma unroll
            for (int e = 0; e < 8; ++e) if (e != i0 && f[e] > v1) { v1 = f[e]; i1 = e; }
            const float e1 = __expf(v1 - v0); const float w0 = pg / (1.f + e1), w1 = pg * e1 / (1.f + e1);
            const int ex0 = gs * 8 + i0, ex1 = gs * 8 + i1;
            const unsigned p0 = atomicAdd(CNT + 64 * ex0, 1u), p1 = atomicAdd(CNT + 64 * ex1, 1u);
            unsigned* R = ROUTE + (size_t)m * 8;
            R[0] = ex0; R[1] = ex1; R[2] = p0; R[3] = p1; R[4] = __float_as_uint(w0); R[5] = __float_as_uint(w1);
        }
        LDS_WAIT(); asm volatile("" ::: "memory");
    }
}
DI int moe_tables(Frame& F) {
    LAS int* tab = (LAS int*)(F.lds + TEXP_OFF);
    if (F.tid == 0) {
        const unsigned* CNT = (const unsigned*)(F.ws + WS_CTL) + CW_CNT;
        int t = 0;
        for (int e = 0; e < 32; ++e) { const int c = (int)xb_ld((unsigned*)CNT + 64 * e); const int nt = (c + 255) >> 8; tab[192 + e] = t * 256; for (int k = 0; k < nt; ++k) tab[t + k] = e; t += nt; }
        tab[224] = t;
    }
    __syncthreads();
    return tab[224];
}
DI void moe_gather(Frame& F) {
    const int lane_ = opaque_lane(F);
    const LAS int* tab = (const LAS int*)(F.lds + TEXP_OFF);
    const bf16* U2 = (const bf16*)(F.ws + WS_U2); bf16* XG = (bf16*)(F.ws + WS_XG); unsigned* ROUTE = (unsigned*)(F.ws + WS_ROUTE);
    const int gw = F.bx * NWAVES + F.wave, NGW = F.G * NWAVES;
    for (int a = gw; a < 2 * NT; a += NGW) {
        const int m = a >> 1, k = a & 1;
        const unsigned e = ROUTE[(size_t)m * 8 + k], pos = ROUTE[(size_t)m * 8 + 2 + k];
        const int slot = tab[192 + e] + (int)pos;
        const u32x4* src = (const u32x4*)(U2 + (size_t)m * DM) + lane_; u32x4* dst = (u32x4*)(XG + (size_t)slot * DM) + lane_;
        dst[0] = src[0]; dst[64] = src[64];
        if (lane_ == 0) ROUTE[(size_t)m * 8 + 6 + k] = (unsigned)slot;
    }
}
template <bool DRY> DI void moe_combine(Frame& F) {
    const int lane_ = opaque_lane(F);
    float* H = (float*)F.outb; float* HO = DRY ? (float*)(F.ws + WS_XG) : H; const float* MOD = (const float*)(F.ws + WS_MOD); const bf16* YR = (const bf16*)(F.ws + WS_YROWS); const unsigned* ROUTE = (const unsigned*)(F.ws + WS_ROUTE);
    const float* g2 = F.in[20]; const float* b2 = F.in[21];
    const int gw = F.bx * NWAVES + F.wave, NGW = F.G * NWAVES;
    for (int m = gw; m < NT; m += NGW) {
        const int b = m >> 12; const unsigned* R = ROUTE + (size_t)m * 8;
        const float w0 = __uint_as_float(R[4]), w1 = __uint_as_float(R[5]); const size_t s0 = R[6], s1 = R[7];
        f32x4* hr = (f32x4*)(H + (size_t)m * DM) + lane_; f32x4* hw = (f32x4*)(HO + (size_t)m * DM) + lane_;
        f32x4 v[4]; float s = 0.f;
#pragma unroll
        for (int j = 0; j < 4; ++j) { const int col = 256 * j + 4 * lane_;
            const u32x2 ya = *(const u32x2*)(YR + s0 * DM + col), yb = *(const u32x2*)(YR + s1 * DM + col);
            const f32x4 y = {w0 * bflo(ya.x) + w1 * bflo(yb.x), w0 * bfhi(ya.x) + w1 * bfhi(yb.x), w0 * bflo(ya.y) + w1 * bflo(yb.y), w0 * bfhi(ya.y) + w1 * bfhi(yb.y)};
            const f32x4 gt = *(const f32x4*)(MOD + b * 6144 + 5120 + col);
            v[j] = hr[64 * j] * ALPHA + gt * y; s += (v[j].x + v[j].y) + (v[j].z + v[j].w); }
        const float mean = wave_sum(s) * (1.f / DM); float s2 = 0.f;
#pragma unroll
        for (int j = 0; j < 4; ++j) { v[j] = v[j] - mean; s2 += (v[j].x * v[j].x + v[j].y * v[j].y) + (v[j].z * v[j].z + v[j].w * v[j].w); }
        const float rstd = 1.f / sqrtf(wave_sum(s2) * (1.f / DM) + LN_EPS);
#pragma unroll
        for (int j = 0; j < 4; ++j) { const int col = 256 * j + 4 * lane_; hw[64 * j] = v[j] * rstd * *(const f32x4*)(g2 + col) + *(const f32x4*)(b2 + col); }
    }
}

__global__ void __launch_bounds__(NTHREADS, 2) fwd_kernel(Args args) {
    extern __shared__ __attribute__((aligned(16))) unsigned char lds[];
    Frame F;
    F.lds = (LAS unsigned char*)lds;
    F.tid = threadIdx.x; F.lane = F.tid & 63; F.wave = __builtin_amdgcn_readfirstlane(F.tid >> 6);
    F.G = gridDim.x; F.bx = blockIdx.x; F.vcu = (F.G % 8 == 0) ? (F.bx % 8) * (F.G / 8) + F.bx / 8 : F.bx;
    F.ws = args.ws; F.outb = (unsigned char*)args.out;
#pragma unroll
    for (int i = 0; i < 22; ++i) F.in[i] = args.in[i];
    for (int u = F.tid; u < (LDS_BYTES - LDSX_OFF) / 4; u += NTHREADS) ((LAS unsigned*)(F.lds + LDSX_OFF))[u] = 0u;
    __syncthreads();
    unsigned* ctl = (unsigned*)(F.ws + WS_CTL);
    XcdBarrier bar = xcd_barrier_post(ctl + CW_BAR, (volatile LAS unsigned*)(F.lds + MISC_OFF) + 8);
    if (F.tid == 0) ((volatile LAS unsigned*)(F.lds + MISC_OFF))[12] = xb_add(ctl + CW_RANK + 64 * bar.x, 1u);
    unsigned long long* TS = (unsigned long long*)(ctl + 32768);
    int nst = 1;
    if (PROF && F.bx == 0 && F.tid == 0) TS[0] = __builtin_amdgcn_s_memrealtime();
#define GRID_BAR() do { xcd_barrier(bar); if (PROF && F.bx == 0 && F.tid == 0) TS[nst] = __builtin_amdgcn_s_memrealtime(); ++nst; } while (0)
    const char* U = (const char*)(F.outb + OUT_U); const char* WINT = (const char*)(F.outb + OUT_WINT);

    REP(1,  phase0(F); GRID_BAR();
    phase1(F); GRID_BAR(); );
    { volatile LAS unsigned* M = (volatile LAS unsigned*)(F.lds + MISC_OFF);
      if (F.tid == 0) { unsigned pre = 0, nx = 0, mine = 0, even = 1, idx = 0;
          for (unsigned j = 0; j < 16; ++j) { const unsigned cj = xb_ld(ctl + CW_BAR + XB_XCNT(j)); if (j < bar.x) { pre += cj; idx += (cj > 0u); } if (j == bar.x) mine = cj; nx += (cj > 0u); if (cj != 0u && cj * 8u != (unsigned)F.G) even = 0; }
          const unsigned rank = M[12];
          M[13] = pre + rank; M[14] = (even && nx == 8u) ? rank * 8u + idx : (unsigned)F.bx; (void)mine; }
      __syncthreads();
      F.vcu = (int)M[13]; }
    const int c = (int)((volatile LAS unsigned*)(F.lds + MISC_OFF))[14];
    REP(2,
    { SchedR1 S; S.init(64, 16, F.G, c); S.U = U; S.W = WINT;
      pg8::EpiV<EpiR1> E{EpiR1{(bf16*)(F.ws + WS_RQ), (bf16*)(F.ws + WS_RK), (bf16*)(F.ws + WS_RG)}};
      pg8::gemm_phase<pg8::EpiV<EpiR1>, SchedR1, true>(F.lds, 1024, 1024, 1024, S, E); }
    { SchedR2 S; S.init(12, 64, F.G, c); S.U = U; S.W = WINT;
      pg8::EpiV<EpiR2> E{EpiR2{(bf16*)(F.ws + WS_RVT), (bf16*)(F.ws + WS_KFT), (bf16*)(F.ws + WS_KBT), (const float*)(F.ws + WS_DEC)}};
      pg8::gemm_phase<pg8::EpiV<EpiR2>, SchedR2, true>(F.lds, 1024, 1024, 1024, S, E); }
    GRID_BAR(); );
    REPX(14, ret_intra(F); GRID_BAR(); );
    REP(3,  ret_intra(F); GRID_BAR();
    ret_scan<0>(F); GRID_BAR(); );
#ifndef SVAR
#define SVAR 1
#endif
    REPX(15, ret_scan<SVAR>(F); GRID_BAR(); );
    ret_norm<false>(F); GRID_BAR();
    REPX(10, ret_norm<true>(F); GRID_BAR(); );
    REP(4,
    _Pragma("unroll 1")
    for (int g = 0; g < 3; ++g) {
        const int dil = g == 0 ? 1 : (g == 1 ? 4 : 16);
        SchedQK S; S.init(64, 4, F.G, c); S.U = U; S.W = WINT; S.g = g; S.r = dil; S.nsub = SEQ / dil;
        pg8::EpiV<EpiQK> E{EpiQK{(bf16*)(F.ws + WS_AQ + (size_t)g * 16 * MiB), (bf16*)(F.ws + WS_AK + (size_t)g * 16 * MiB)}};
        pg8::gemm_phase<pg8::EpiV<EpiQK>, SchedQK, false>(F.lds, 1024, 1024 * dil, 1024, S, E);
    }
    { SchedGate S; S.init(64, 8, F.G, c); S.U = U; S.W = WINT;
      pg8::EpiV<EpiGate> E{EpiGate{(bf16*)(F.ws + WS_GA), (bf16*)(F.ws + WS_GR)}};
      pg8::gemm_phase<pg8::EpiV<EpiGate>, SchedGate, true>(F.lds, 1024, 1024, 1024, S, E); }
_Pragma("unroll 1")
    for (int g = 0; g < 3; ++g) {
        const int dil = g == 0 ? 1 : (g == 1 ? 4 : 16);
        SchedA2 S; const int cc = (g == 1) ? c - 128 : c; S.init(2, 64, F.G, (cc >= 0 && cc < 128) ? cc : -1); S.U = U; S.W = WINT; S.g = g; S.r = dil; S.nsub = SEQ / dil;
        pg8::EpiV<EpiA2> E{EpiA2{(bf16*)(F.ws + WS_AVT) + (size_t)g * 512 * NT}};
        pg8::gemm_phase<pg8::EpiV<EpiA2>, SchedA2, true>(F.lds, 1024, 1024, 1024 * dil, S, E);
    }
    GRID_BAR(); );
    REP(5,  attn_phase(F); GRID_BAR(); );
    REP(6,  attn_mix(F); moe_weight_transposes(F); GRID_BAR(); );
    REP(7,
    { SchedG S; S.init(64, 4, F.G, c); S.A = (const char*)(F.ws + WS_ATTMIX); S.B = (const char*)(F.ws + WS_WAT); S.abytes = 256 * 512 * 2; S.bbytes = 256 * 512 * 2;
      pg8::EpiV<EpiG1> E{EpiG1{(const bf16*)(F.ws + WS_GA), (float*)F.outb}};
      pg8::gemm_phase<pg8::EpiV<EpiG1>, SchedG, false>(F.lds, 512, 512, 512, S, E); }
    { SchedG S; S.init(64, 4, F.G, c); S.A = (const char*)(F.ws + WS_RG); S.B = (const char*)(F.ws + WS_WRT); S.abytes = 256 * 2048 * 2; S.bbytes = 256 * 2048 * 2;
      pg8::EpiV<EpiG2> E{EpiG2{(const bf16*)(F.ws + WS_GR), (const float*)F.outb, (bf16*)(F.ws + WS_MERGED)}};
      pg8::gemm_phase<pg8::EpiV<EpiG2>, SchedG, false>(F.lds, 2048, 2048, 2048, S, E); }
    GRID_BAR();
    { SchedG S; S.init(64, 4, F.G, c); S.A = (const char*)(F.ws + WS_MERGED); S.B = (const char*)(F.ws + WS_WOT); S.abytes = 256 * 1024 * 2; S.bbytes = 256 * 1024 * 2;
      pg8::EpiV<EpiG3> E{EpiG3{F.in[0], (const float*)(F.ws + WS_MOD), (float*)F.outb}};
      pg8::gemm_phase<pg8::EpiV<EpiG3>, SchedG, false>(F.lds, 1024, 1024, 1024, S, E); }
    GRID_BAR(); );
    moe_route<false>(F); GRID_BAR();
    REPX(11, moe_route<true>(F); GRID_BAR(); );
    const int ntiles = moe_tables(F);
    REP(8,  moe_gather(F); GRID_BAR(); );
    REP(9,
    { SchedM S; S.init(ntiles, 4, F.G, c); S.A = (const char*)(F.ws + WS_XG); S.B = (const char*)(F.ws + WS_W13T); S.abytes = 256 * 1024 * 2; S.ebytes = (size_t)1024 * 1024 * 2; S.bbytes = 256 * 1024 * 2;
      S.texp = (const LAS int*)(F.lds + TEXP_OFF);
      pg8::EpiV<EpiM3> E{EpiM3{(bf16*)(F.ws + WS_HDN)}};
      pg8::gemm_phase<pg8::EpiV<EpiM3>, SchedM, true>(F.lds, 1024, 1024, 1024, S, E); }
    GRID_BAR();
    { SchedM S; S.init(ntiles, 4, F.G, c); S.A = (const char*)(F.ws + WS_HDN); S.B = (const char*)(F.ws + WS_W2T); S.abytes = 256 * 512 * 2; S.ebytes = (size_t)1024 * 512 * 2; S.bbytes = 256 * 512 * 2;
      S.texp = (const LAS int*)(F.lds + TEXP_OFF);
      pg8::EpiV<EpiM4> E{EpiM4{(bf16*)(F.ws + WS_YROWS)}};
      pg8::gemm_phase<pg8::EpiV<EpiM4>, SchedM, true>(F.lds, 512, 512, 512, S, E); }
    GRID_BAR(); );
    REPX(12, moe_combine<true>(F); GRID_BAR(); );
    REPX(13, GRID_BAR(); GRID_BAR(); GRID_BAR(); GRID_BAR(); GRID_BAR(); GRID_BAR(); GRID_BAR(); GRID_BAR(); GRID_BAR(); GRID_BAR(); );
    moe_combine<false>(F);
#if PROF
    GRID_BAR();
    { const unsigned long long ta0 = __hip_atomic_load(TS + PROF_A - 1, __ATOMIC_RELAXED, __HIP_MEMORY_SCOPE_AGENT), ta1 = __hip_atomic_load(TS + PROF_A, __ATOMIC_RELAXED, __HIP_MEMORY_SCOPE_AGENT);
      const unsigned long long tb0 = __hip_atomic_load(TS + PROF_B - 1, __ATOMIC_RELAXED, __HIP_MEMORY_SCOPE_AGENT), tb1 = __hip_atomic_load(TS + PROF_B, __ATOMIC_RELAXED, __HIP_MEMORY_SCOPE_AGENT);
      const float V1 = (float)(ta1 - ta0) * 0.01f, V2 = (float)(tb1 - tb0) * 0.01f * 20.f;
      float* out = (float*)F.outb;
      for (int i = F.bx * NTHREADS + F.tid; i < NT * DM; i += F.G * NTHREADS) out[i] = (i < 16) ? V2 : V1; }
#endif
}

extern "C" void kernel_launch(void* const* d_in, const int* in_sizes, int n_in, void* d_out, int out_size, void* d_ws, size_t ws_size, hipStream_t stream) {
    static int grid = 0;
    if (grid == 0) {
        if (n_in != 22 || out_size != NT * DM || ws_size < WS_END) { fprintf(stderr, "kernel_launch: unexpected problem (n_in %d, out %d, ws %zu)\n", n_in, out_size, ws_size); grid = -1; return; }
        int dev = 0, cus = 0, per_cu = 0;
        if (hipGetDevice(&dev) != hipSuccess || hipDeviceGetAttribute(&cus, hipDeviceAttributeMultiprocessorCount, dev) != hipSuccess) { grid = -1; return; }
        if (hipFuncSetAttribute((const void*)fwd_kernel, hipFuncAttributeMaxDynamicSharedMemorySize, LDS_BYTES) != hipSuccess) { grid = -1; return; }
        if (hipOccupancyMaxActiveBlocksPerMultiprocessor(&per_cu, (const void*)fwd_kernel, NTHREADS, LDS_BYTES) != hipSuccess || per_cu < 1) { fprintf(stderr, "kernel_launch: occupancy query reports %d blocks/CU\n", per_cu); (void)hipGetLastError(); grid = -1; return; }
        grid = cus;
    }
    if (grid < 0) return;
    (void)hipMemsetAsync((char*)d_ws + WS_CTL, 0, CTL_ZERO_BYTES, stream);
    Args a{};
    for (int i = 0; i < 22; ++i) a.in[i] = (const float*)d_in[i];
    a.out = (float*)d_out; a.ws = (unsigned char*)d_ws;
    hipLaunchKernelGGL(fwd_kernel, dim3(grid), dim3(NTHREADS), LDS_BYTES, stream, a);
}
```

```cpp
#ifndef PROF
#define PROF 0
#endif
#ifndef DUP
#define DUP 0
#endif
#define REP(k, ...) do { __VA_ARGS__ if (DUP == (k)) { __VA_ARGS__ } } while (0)
#define REPX(k, ...) do { if (DUP == (k)) { __VA_ARGS__ } } while (0)
#ifndef PROF_A
#define PROF_A 1
#endif
#ifndef PROF_B
#define PROF_B 2
#endif
#include <hip/hip_runtime.h>
#include <cstdio>
#include <cstdint>

#define GAS __attribute__((address_space(1)))
#define LAS __attribute__((address_space(3)))
#define DI __device__ __forceinline__
typedef unsigned short bf16;
typedef float f32x4 __attribute__((ext_vector_type(4)));
typedef float f32x16 __attribute__((ext_vector_type(16)));
typedef float f32x2 __attribute__((ext_vector_type(2)));
typedef short bf16x8 __attribute__((ext_vector_type(8)));
typedef short s16x4 __attribute__((ext_vector_type(4)));
typedef __bf16 bf16x2_t __attribute__((ext_vector_type(2)));
typedef unsigned u32x4 __attribute__((ext_vector_type(4)));
typedef unsigned u32x2 __attribute__((ext_vector_type(2)));

constexpr int NT = 16384, DM = 1024, SEQ = 4096, NB = 4;
constexpr int NWAVES = 8, NTHREADS = 512;
constexpr int LDS_BYTES = 147456, RING_BYTES = 131072, LDSX_OFF = RING_BYTES;
constexpr int MISC_OFF = LDSX_OFF + 320;
constexpr int TEXP_OFF = LDSX_OFF + 1024;
constexpr float LN_EPS = 1e-5f;
constexpr float ALPHA = 1.189207115002721f;

constexpr size_t MiB = 1u << 20;
constexpr size_t WS_CTL = 0, CTL_ZERO_BYTES = (PROF ? 1024 : 128) * 1024;
constexpr size_t WS_MOD = 1 * MiB;
constexpr size_t WS_DEC = 1 * MiB + 112 * 1024;
constexpr size_t WS_WROUT = 1 * MiB + 128 * 1024;
constexpr size_t WS_WAT = 2 * MiB, WS_WRT = 3 * MiB, WS_WOT = 7 * MiB;
constexpr size_t WS_LSE = 9 * MiB;
constexpr size_t WS_ROUTE = 10 * MiB;
constexpr int NTP = NT + 576;
constexpr size_t WS_RQ = 12 * MiB, WS_RK = 44 * MiB, WS_RG = 76 * MiB, WS_RVT = 140 * MiB, WS_KFT = 207 * MiB, WS_KBT = 241 * MiB, WS_Y = 275 * MiB;
constexpr size_t WS_AQ = 12 * MiB, WS_O0 = 60 * MiB, WS_AK = 140 * MiB, WS_AVT = 188 * MiB, WS_GA = 238 * MiB, WS_GR = 270 * MiB, WS_O1 = 302 * MiB, WS_O2 = 318 * MiB;
constexpr size_t WS_ATTMIX = 12 * MiB, WS_MERGED = 28 * MiB, WS_W13T = 140 * MiB, WS_W2T = 204 * MiB;
constexpr size_t WS_U2 = 238 * MiB, WS_XG = 12 * MiB, WS_HDN = 92 * MiB, WS_YROWS = 238 * MiB;
constexpr size_t WS_END = 339 * MiB;
static_assert((size_t)2048 * NTP * 2 <= 67 * MiB && (size_t)1024 * NTP * 2 <= 34 * MiB && (size_t)1536 * NTP * 2 <= 50 * MiB, "padded transposed tensors fit their regions");
constexpr size_t OUT_U = 0, OUT_WINT = 32 * MiB;
constexpr int CW_BAR = 4096;
constexpr int CW_CNT = 16384;
constexpr int CW_RANK = 20480;

constexpr int C_AQ = 0, C_AK = 1536, C_AV = 3072, C_RQ = 4608, C_RK = 5632, C_RV = 6656, C_RGT = 8704, C_GA = 10752, C_GR = 11776, C_END = 12800;

#define LDS_WAIT() asm volatile("s_waitcnt lgkmcnt(0)" ::: "memory")
#define VM_WAIT() asm volatile("s_waitcnt vmcnt(0)" ::: "memory")
DI unsigned pk2(float lo, float hi) { f32x2 v = {lo, hi}; bf16x2_t r = __builtin_convertvector(v, bf16x2_t); return __builtin_bit_cast(unsigned, r); }
DI float bf2f(unsigned short b) { return __builtin_bit_cast(float, (unsigned)b << 16); }
DI float bflo(unsigned w) { return __builtin_bit_cast(float, w << 16); }
DI float bfhi(unsigned w) { return __builtin_bit_cast(float, w & 0xffff0000u); }
DI float wave_sum(float v) {
#pragma unroll
    for (int o = 1; o < 64; o <<= 1) v += __shfl_xor(v, o);
    return v;
}
DI float sigmoidf_(float x) { return 1.f / (1.f + __expf(-x)); }
DI float log2_sigmoid(float x) { return -log1pf(expf(-x)) * 1.4426950408889634f; }
#define MFMA32(a, b, c) __builtin_amdgcn_mfma_f32_32x32x16_bf16((a), (b), (c), 0, 0, 0)
DI int crow(int reg, int h) { return (reg & 3) + 8 * (reg >> 2) + 4 * h; }
DI bf16x8 pack_step(const f32x16& x, int s) {
    u32x4 p; p[0] = pk2(x[8 * s], x[8 * s + 1]); p[1] = pk2(x[8 * s + 2], x[8 * s + 3]); p[2] = pk2(x[8 * s + 4], x[8 * s + 5]); p[3] = pk2(x[8 * s + 6], x[8 * s + 7]);
    return __builtin_bit_cast(bf16x8, p);
}
DI bf16x8 ld16(const bf16* p) { return *(const bf16x8*)p; }
DI bf16x8 ld8x2(const bf16* p0, const bf16* p1) { const s16x4 a = *(const s16x4*)p0, b = *(const s16x4*)p1; return __builtin_shufflevector(a, b, 0, 1, 2, 3, 4, 5, 6, 7); }
DI size_t blk_off(int row, int k, int kblocks) { return ((size_t)(row >> 5) * kblocks + (k >> 4)) * 512 + ((k >> 3) & 1) * 256 + (row & 31) * 8; }
DI f32x16 zero16() { f32x16 z; for (int i = 0; i < 16; ++i) z[i] = 0.f; return z; }

#define XB_TMO      128
#define XB_XCNT(j)  (256  + 64 * (j))
#define XB_XSUB(j)  (1280 + 64 * (j))
#define XB_XGEN(j)  (2304 + 64 * (j))
#define XB_TOP      3328
#define XB_TOPGEN   3392
#define XCD_BAR_WORDS 3456
#define XB_SPIN_CAP (1u << 18)
DI unsigned xb_ld(unsigned* p)              { return __hip_atomic_load(p, __ATOMIC_RELAXED, __HIP_MEMORY_SCOPE_AGENT); }
DI unsigned xb_add(unsigned* p, unsigned v) { return __hip_atomic_fetch_add(p, v, __ATOMIC_RELAXED, __HIP_MEMORY_SCOPE_AGENT); }
DI unsigned xb_xcc_id() { return (unsigned)__builtin_amdgcn_s_getreg((3 << 11) | 20) & 0xFu; }
#define XB_SPIN(cond, bar) do { unsigned _sp = 0; while (cond) { __builtin_amdgcn_s_sleep(1); \
    if ((++_sp & 255u) == 0u) { if (xb_ld(&(bar)[XB_TMO])) break; if (_sp > XB_SPIN_CAP) { atomicAdd(&(bar)[XB_TMO], 1u); break; } } } } while (0)
struct XcdBarrier { unsigned* bar; unsigned x; volatile LAS unsigned* st; };
DI XcdBarrier xcd_barrier_post(unsigned* bar, volatile LAS unsigned* st) {
    XcdBarrier b; b.bar = bar; b.x = xb_xcc_id(); b.st = st;
    if (threadIdx.x == 0) (void)xb_add(&bar[XB_XCNT(b.x)], 1u);
    return b;
}
DI void xcd_barrier_complete(unsigned* bar, unsigned x, unsigned& nloc, unsigned& nx) {
    const unsigned G = gridDim.x * gridDim.y * gridDim.z;
    unsigned sum, cnt, mine, sp = 0u;
    for (;;) {
        sum = 0u; cnt = 0u; mine = 0u;
#pragma unroll
        for (unsigned j = 0; j < 16; ++j) { const unsigned c = xb_ld(&bar[XB_XCNT(j)]); sum += c; cnt += (c > 0u) ? 1u : 0u; mine = (j == x) ? c : mine; }
        if (sum == G) break;
        __builtin_amdgcn_s_sleep(1);
        if ((++sp & 255u) == 0u) { if (xb_ld(&bar[XB_TMO])) break; if (sp > XB_SPIN_CAP) { atomicAdd(&bar[XB_TMO], 1u); break; } }
    }
    nloc = mine > 0u ? mine : 1u; nx = cnt > 0u ? cnt : 1u;
}
DI void xcd_barrier(const XcdBarrier& b) {
    asm volatile("s_waitcnt vmcnt(0)" ::: "memory");
    __syncthreads();
    if (threadIdx.x == 0) {
        unsigned* bar = b.bar;
        __builtin_amdgcn_s_waitcnt(0);
        unsigned nloc = b.st[0], nx = b.st[1];
        if (nloc == 0u) { xcd_barrier_complete(bar, b.x, nloc, nx); b.st[0] = nloc; b.st[1] = nx; }
        const unsigned old = xb_add(&bar[XB_XSUB(b.x)], 1u);
        const unsigned gen = old / nloc;
        if (old + 1u == (gen + 1u) * nloc) {
            __builtin_amdgcn_fence(__ATOMIC_RELEASE, "agent");
            asm volatile("s_waitcnt vmcnt(0)" ::: "memory");
            const unsigned og = xb_add(&bar[XB_TOP], 1u);
            const unsigned tg = og / nx;
            if (og + 1u == (tg + 1u) * nx) xb_add(&bar[XB_TOPGEN], 1u);
            else XB_SPIN(xb_ld(&bar[XB_TOPGEN]) == tg, bar);
            __builtin_amdgcn_fence(__ATOMIC_ACQUIRE, "agent");
            xb_add(&bar[XB_XGEN(b.x)], 1u);
            asm volatile("s_waitcnt vmcnt(0)" ::: "memory");
        } else {
            XB_SPIN(xb_ld(&bar[XB_XGEN(b.x)]) == gen, bar);
            __builtin_amdgcn_fence(__ATOMIC_ACQUIRE, "agent");
            asm volatile("s_waitcnt vmcnt(0)" ::: "memory");
        }
    }
    __syncthreads();
}

namespace pg8 {
#define PG8_LAS __attribute__((address_space(3)))
constexpr int BM = 256, BK = 64, HALF = 128, HTB = HALF * BK * 2, STAGE_BYTES = 8 * HTB, NXCD = 8, WGM = 8;
__host__ __device__ __forceinline__ int lds_byte(int r, int c) { const int st = (r >> 4) * 2 + (c >> 5), rr = r & 15, cc = c & 31, ob = rr * 64 + cc * 2; return st * 1024 + (ob ^ (((ob >> 9) & 1) << 5)); }
__host__ __device__ __forceinline__ void stage_rc(int b, int& R, int& C) { const int st = b / 1024, sb = b % 1024, swz = sb ^ (((sb >> 9) & 1) << 5); R = (st >> 1) * 16 + swz / 64; C = (st & 1) * 32 + (swz % 64) / 2; }
__host__ __device__ __forceinline__ int perm32(int rho) { const int n = rho >> 4, i = rho & 15; return 8 * (i >> 2) + 4 * n + (i & 3); }
struct Unit { int pm, pn; };
struct StaticOrder {
    int nM, nN, nwg, G, c;
    __host__ __device__ void init(int nM_, int nN_, int G_, int c_) { nM = nM_; nN = nN_; nwg = nM * nN; G = G_; c = c_; }
    __host__ __device__ bool next(int i, Unit& u) const {
        const long L = (long)i * G + c; if (c < 0 || L >= nwg) return false;
        int wgid = (int)L; { const int q = nwg / NXCD, r = nwg % NXCD, xcd = wgid % NXCD, off = wgid / NXCD; wgid = (xcd < r ? xcd * (q + 1) : r * (q + 1) + (xcd - r) * q) + off; }
        const int nig = WGM * nN, gid = wgid / nig, fm = gid * WGM, gsz = (nM - fm) < WGM ? (nM - fm) : WGM;
        u.pm = fm + ((wgid % nig) % gsz); u.pn = (wgid % nig) / gsz; return true;
    }
};
template <class F> struct EpiV {
    F f;
    __device__ __forceinline__ void operator()(const f32x4 (&acc)[2][2][4][2], const Unit& u, int wr, int wc, int fr, int fq) const {
        const int row0 = u.pm * BM + wr * 64 + fr, col0 = u.pn * BM + wc * 32 + 8 * fq;
#pragma unroll
        for (int ai = 0; ai < 2; ++ai)
#pragma unroll
            for (int m = 0; m < 4; ++m)
#pragma unroll
                for (int bj = 0; bj < 2; ++bj) f(row0 + ai * HALF + m * 16, col0 + bj * HALF, acc[ai][bj][m][0], acc[ai][bj][m][1]);
    }
};
template <class Epi, class Sched, bool ALIGN_EPI = false>
__device__ __forceinline__ void gemm_phase(PG8_LAS unsigned char* lds, const int K, const int lda, const int ldb, const Sched& S, const Epi& E) {
    int tid_ = threadIdx.x; asm volatile("" : "+v"(tid_));
    const int tid = tid_, wid = __builtin_amdgcn_readfirstlane(tid >> 6), lane = tid & 63, wr = wid >> 2, wc = wid & 3, fr = lane & 15, fq = lane >> 4;
    const int nt = K / BK;
    unsigned voffA[2], voffB[2];
#pragma unroll
    for (int i = 0; i < 2; ++i) { int R, C; stage_rc(tid * 16 + i * 8192, R, C); const int Rb = (R & ~31) + perm32(R & 31);
        voffA[i] = (unsigned)(R * lda + C) * 2u; voffB[i] = (unsigned)(Rb * ldb + C) * 2u; }
    const size_t kstep = (size_t)(BK * 2);
    const size_t hstepA = (size_t)HALF * lda * 2, hstepB = (size_t)HALF * ldb * 2;
    const unsigned ldsw = (unsigned)wid * 1024u;
    const int aoff = lds_byte(wr * 64 + fr, fq * 8), boff = lds_byte(wc * 32 + fr, fq * 8);
#define PG8_SA(b, h) (((b) * 2 + (h)) * HTB)
#define PG8_SB(b, h) ((4 + (b) * 2 + (h)) * HTB)
#define PG8_STAGE(bufoff, gbase, voff) do { _Pragma("unroll") for (int _i = 0; _i < 2; ++_i) \
        __builtin_amdgcn_global_load_lds((const unsigned*)((const char*)(gbase) + (voff)[_i]), (PG8_LAS unsigned*)(lds + (bufoff) + ldsw + _i * 8192), 16, 0, 0); } while (0)
#define PG8_LDA(dst, b, h) do { _Pragma("unroll") for (int m = 0; m < 4; ++m) _Pragma("unroll") for (int k = 0; k < 2; ++k) dst[m][k] = *(const PG8_LAS bf16x8*)(lds + PG8_SA(b, h) + aoff + m * 2048 + k * 1024); } while (0)
#define PG8_LDB(dst, b, h) do { _Pragma("unroll") for (int n = 0; n < 2; ++n) _Pragma("unroll") for (int k = 0; k < 2; ++k) dst[n][k] = *(const PG8_LAS bf16x8*)(lds + PG8_SB(b, h) + boff + n * 2048 + k * 1024); } while (0)
#define PG8_MMA(ai, bj, At, Bt) do { __builtin_amdgcn_s_setprio(1); _Pragma("unroll") for (int m = 0; m < 4; ++m) _Pragma("unroll") for (int n = 0; n < 2; ++n) _Pragma("unroll") for (int k = 0; k < 2; ++k) \
        acc[ai][bj][m][n] = __builtin_amdgcn_mfma_f32_16x16x32_bf16(Bt[n][k], At[m][k], acc[ai][bj][m][n], 0, 0, 0); __builtin_amdgcn_s_setprio(0); } while (0)
#define PG8_WAIT_V(n) asm volatile("s_waitcnt vmcnt(" #n ")" ::: "memory")
#define PG8_WAIT_L(n) asm volatile("s_waitcnt lgkmcnt(" #n ")" ::: "memory")
#define PG8_BAR __builtin_amdgcn_s_barrier()
#define PG8_SCHED __builtin_amdgcn_sched_barrier(0)
    Unit cur, nxt; int ui = 0;
    if (!S.next(0, cur)) return;
    f32x4 acc[2][2][4][2];
#pragma unroll
    for (int a = 0; a < 2; ++a)
#pragma unroll
        for (int b = 0; b < 2; ++b)
#pragma unroll
            for (int m = 0; m < 4; ++m)
#pragma unroll
                for (int n = 0; n < 2; ++n) acc[a][b][m][n] = (f32x4){0.f, 0.f, 0.f, 0.f};
    bf16x8 At[4][2], B0[2][2], B1[2][2];
    const char* cA = S.a_base(cur); const char* cB = S.b_base(cur);
    PG8_STAGE(PG8_SB(0, 0), cB, voffB); PG8_STAGE(PG8_SB(0, 1), cB + hstepB, voffB); PG8_STAGE(PG8_SA(0, 0), cA, voffA); PG8_STAGE(PG8_SA(0, 1), cA + hstepA, voffA);
    if (wr == 1) PG8_BAR;
    PG8_WAIT_V(2); PG8_BAR;
    PG8_STAGE(PG8_SB(1, 0), cB + kstep, voffB); PG8_STAGE(PG8_SA(1, 0), cA + kstep, voffA); PG8_STAGE(PG8_SB(1, 1), cB + hstepB + kstep, voffB);
    PG8_WAIT_V(6); PG8_BAR;
    for (;;) {
        const bool has_next = S.next(ui + 1, nxt);
        const char* nA = has_next ? S.a_base(nxt) : cA; const char* nB = has_next ? S.b_base(nxt) : cB;
        for (int t = 0; t < nt; t += 2) {
            const bool last = (t == nt - 2);
            const char* a1 = cA + (size_t)(t + 1) * kstep;
            const char* a2 = last ? nA : cA + (size_t)(t + 2) * kstep; const char* b2 = last ? nB : cB + (size_t)(t + 2) * kstep;
            const char* a3 = a2 + kstep; const char* b3 = b2 + kstep;
            PG8_LDB(B0, 0, 0); PG8_LDB(B1, 0, 1); PG8_SCHED; PG8_LDA(At, 0, 0); PG8_STAGE(PG8_SA(1, 1), a1 + hstepA, voffA);
            PG8_WAIT_V(8); PG8_WAIT_L(0); PG8_BAR; PG8_MMA(0, 0, At, B0); PG8_MMA(0, 1, At, B1); PG8_BAR; PG8_SCHED;
            PG8_LDA(At, 0, 1); PG8_STAGE(PG8_SB(0, 0), b2, voffB); PG8_STAGE(PG8_SB(0, 1), b2 + hstepB, voffB); PG8_STAGE(PG8_SA(0, 0), a2, voffA);
            PG8_WAIT_V(8); PG8_WAIT_L(0); PG8_BAR; PG8_MMA(1, 0, At, B0); PG8_MMA(1, 1, At, B1); PG8_BAR; PG8_SCHED;
            PG8_LDB(B0, 1, 0); PG8_LDB(B1, 1, 1); PG8_SCHED; PG8_LDA(At, 1, 0); PG8_STAGE(PG8_SA(0, 1), a2 + hstepA, voffA);
            PG8_WAIT_V(8); PG8_WAIT_L(0); PG8_BAR; PG8_MMA(0, 0, At, B0); PG8_MMA(0, 1, At, B1); PG8_BAR; PG8_SCHED;
            PG8_LDA(At, 1, 1); PG8_STAGE(PG8_SB(1, 0), b3, voffB); PG8_STAGE(PG8_SB(1, 1), b3 + hstepB, voffB); PG8_STAGE(PG8_SA(1, 0), a3, voffA);
            PG8_WAIT_V(8); PG8_WAIT_L(0); PG8_BAR; PG8_MMA(1, 0, At, B0); PG8_MMA(1, 1, At, B1); PG8_BAR; PG8_SCHED;
        }
        if constexpr (ALIGN_EPI) { if (wr == 0) PG8_BAR; }
        E(acc, cur, wr, wc, fr, fq);
        if (!has_next) break;
#pragma unroll
        for (int a = 0; a < 2; ++a)
#pragma unroll
            for (int b = 0; b < 2; ++b)
#pragma unroll
                for (int m = 0; m < 4; ++m)
#pragma unroll
                    for (int n = 0; n < 2; ++n) acc[a][b][m][n] = (f32x4){0.f, 0.f, 0.f, 0.f};
        cur = nxt; cA = nA; cB = nB; ++ui;
        if constexpr (ALIGN_EPI) { if (wr == 1) PG8_BAR; }
    }
    PG8_WAIT_V(0);
    if constexpr (!ALIGN_EPI) { if (wr == 0) PG8_BAR; }
    PG8_BAR;
#undef PG8_SA
#undef PG8_SB
#undef PG8_STAGE
#undef PG8_LDA
#undef PG8_LDB
#undef PG8_MMA
#undef PG8_WAIT_V
#undef PG8_WAIT_L
#undef PG8_BAR
#undef PG8_SCHED
}
}

struct Frame {
    LAS unsigned char* lds;
    int tid, lane, wave, G, vcu, bx;
    unsigned char* ws; unsigned char* outb;
    const float* in[22];
};
struct Args { const float* in[22]; float* out; unsigned char* ws; };
DI int opaque_lane(const Frame& F) { int l = F.lane; asm volatile("" : "+v"(l)); return l; }

template <class RowMap>
DI void transpose_item(const float* W, int K, int N, bf16* WT, RowMap orow, LAS float* scr, int item, int lane) {
    const int nblk = N / 32, kb = item / nblk, nb = item % nblk, k0 = 64 * kb, n0 = 32 * nb;
#pragma unroll 8
    for (int i = 0; i < 32; ++i) { const int kk = 2 * i + (lane >> 5); scr[kk * 33 + (lane & 31)] = W[(size_t)(k0 + kk) * N + n0 + (lane & 31)]; }
    LDS_WAIT(); asm volatile("" ::: "memory");
    const int c = lane & 7;
#pragma unroll
    for (int j = 0; j < 4; ++j) { const int n = (lane >> 3) + 8 * j; const LAS float* s = scr + (8 * c) * 33 + n;
        u32x4 o; o.x = pk2(s[0 * 33], s[1 * 33]); o.y = pk2(s[2 * 33], s[3 * 33]); o.z = pk2(s[4 * 33], s[5 * 33]); o.w = pk2(s[6 * 33], s[7 * 33]);
        *(u32x4*)(WT + (size_t)orow(n0 + n) * K + k0 + 8 * c) = o; }
    LDS_WAIT(); asm volatile("" ::: "memory");
}
struct RowId { int off; DI int operator()(int n) const { return off + n; } };
struct RowW13 { int add; DI int operator()(int n) const { return ((n >> 2) << 3) + (n & 3) + add; } };

DI void phase0(Frame& F) {
    const int lane_ = F.lane;
    const float* c = F.in[1]; const float* w_ada = F.in[2]; const float* b_ada = F.in[3];
    float* MOD = (float*)(F.ws + WS_MOD);
    if (F.bx < 96) {
        const int j = F.bx * 64 + lane_;
        float a0 = 0.f, a1 = 0.f, a2 = 0.f, a3 = 0.f;
        const int k0 = F.wave * 128;
#pragma unroll 8
        for (int k = k0; k < k0 + 128; ++k) { const float w = w_ada[(size_t)k * 6144 + j]; a0 += c[k] * w; a1 += c[1024 + k] * w; a2 += c[2048 + k] * w; a3 += c[3072 + k] * w; }
        LAS float* red = (LAS float*)F.lds;
        red[(F.wave * 4 + 0) * 64 + lane_] = a0; red[(F.wave * 4 + 1) * 64 + lane_] = a1; red[(F.wave * 4 + 2) * 64 + lane_] = a2; red[(F.wave * 4 + 3) * 64 + lane_] = a3;
        __syncthreads();
        if (F.tid < 256) { const int b = F.tid >> 6, l = F.tid & 63; float s = b_ada[F.bx * 64 + l];
#pragma unroll
            for (int w = 0; w < 8; ++w) s += red[(w * 4 + b) * 64 + l];
            MOD[b * 6144 + F.bx * 64 + l] = s; }
        __syncthreads();
    }
    if (F.bx == 0 && F.tid < 8) ((float*)(F.ws + WS_DEC))[F.tid] = log2_sigmoid(F.tid < 4 ? F.in[6][F.tid] : F.in[7][F.tid - 4]);
    { const int gid = F.bx * NTHREADS + F.tid;
      if (gid < 36 * 1024) { const int o = gid >> 10, k = gid & 1023; float v;
          if (o < 4) v = F.in[13][k * 4 + o]; else { const int g = (o - 4) >> 3, e = (o - 4) & 7; v = F.in[15][((size_t)g * 1024 + k) * 8 + e]; }
          ((float*)(F.ws + WS_WROUT))[gid] = v; } }
    LAS float* scr = (LAS float*)(F.lds + 16384 + F.wave * 12288);
    const int gw = F.bx * NWAVES + F.wave, NGW = F.G * NWAVES;
    constexpr int I_IN = 16 * 400, I_A = 8 * 32, I_R = 32 * 32, I_O = 16 * 32;
    for (int it = gw; it < I_IN + I_A + I_R + I_O; it += NGW) {
        int r = it;
        if (r < I_IN) { transpose_item(F.in[4], 1024, C_END, (bf16*)(F.outb + OUT_WINT), RowId{0}, scr, r, lane_); continue; } r -= I_IN;
        if (r < I_A) { transpose_item(F.in[5], 512, 1024, (bf16*)(F.ws + WS_WAT), RowId{0}, scr, r, lane_); continue; } r -= I_A;
        if (r < I_R) { transpose_item(F.in[9], 2048, 1024, (bf16*)(F.ws + WS_WRT), RowId{0}, scr, r, lane_); continue; } r -= I_R;
        transpose_item(F.in[10], 1024, 1024, (bf16*)(F.ws + WS_WOT), RowId{0}, scr, r, lane_);
    }
}
DI void moe_weight_transposes(Frame& F) {
    const int lane_ = F.lane;
    LAS float* scr = (LAS float*)(F.lds + 16384 + F.wave * 12288);
    const int gw = F.bx * NWAVES + F.wave, NGW = F.G * NWAVES;
    bf16* W13T = (bf16*)(F.ws + WS_W13T); bf16* W2T = (bf16*)(F.ws + WS_W2T);
    for (int it = gw; it < 3 * 8192; it += NGW) {
        const int which = it >> 13, r = it & 8191, e = r >> 8, item = r & 255;
        if (which == 0) transpose_item(F.in[17] + (size_t)e * 1024 * 512, 1024, 512, W13T + (size_t)e * 1024 * 1024, RowW13{0}, scr, item, lane_);
        else if (which == 1) transpose_item(F.in[18] + (size_t)e * 1024 * 512, 1024, 512, W13T + (size_t)e * 1024 * 1024, RowW13{4}, scr, item, lane_);
        else transpose_item(F.in[19] + (size_t)e * 512 * 1024, 512, 1024, W2T + (size_t)e * 1024 * 512, RowId{0}, scr, item, lane_);
    }
}

DI void phase1(Frame& F) {
    const int lane_ = opaque_lane(F);
    const float* x = F.in[0]; const float* MOD = (const float*)(F.ws + WS_MOD); bf16* U = (bf16*)(F.outb + OUT_U);
    const int gw = F.bx * NWAVES + F.wave, NGW = F.G * NWAVES;
    for (int m = gw; m < NT; m += NGW) {
        const f32x4* xr = (const f32x4*)(x + (size_t)m * DM) + lane_; const int b = m >> 12;
        f32x4 v[4]; float s = 0.f;
#pragma unroll
        for (int j = 0; j < 4; ++j) { v[j] = xr[64 * j]; s += (v[j].x + v[j].y) + (v[j].z + v[j].w); }
        const float mean = wave_sum(s) * (1.f / DM); float s2 = 0.f;
#pragma unroll
        for (int j = 0; j < 4; ++j) { v[j] = v[j] - mean; s2 += (v[j].x * v[j].x + v[j].y * v[j].y) + (v[j].z * v[j].z + v[j].w * v[j].w); }
        const float rstd = 1.f / sqrtf(wave_sum(s2) * (1.f / DM) + LN_EPS);
        u32x2* o8 = (u32x2*)(U + (size_t)m * DM) + lane_;
#pragma unroll
        for (int j = 0; j < 4; ++j) { const int col = 256 * j + 4 * lane_;
            const f32x4 sh = *(const f32x4*)(MOD + b * 6144 + col), sc = *(const f32x4*)(MOD + b * 6144 + 1024 + col);
            const f32x4 u = v[j] * rstd * (sc + 1.f) + sh;
            u32x2 w; w.x = pk2(u.x, u.y); w.y = pk2(u.z, u.w); o8[64 * j] = w; }
    }
}

DI u32x4 pack8(f32x4 v0, f32x4 v1) { u32x4 w; w.x = pk2(v0[0], v0[1]); w.y = pk2(v0[2], v0[3]); w.z = pk2(v1[0], v1[1]); w.w = pk2(v1[2], v1[3]); return w; }

struct SchedR1 : pg8::StaticOrder { const char* U; const char* W;
    DI const char* a_base(const pg8::Unit& u) const { return U + (size_t)u.pm * 256 * 2048; }
    DI const char* b_base(const pg8::Unit& u) const { const int r = u.pn < 8 ? C_RQ + 256 * u.pn : C_RGT + 256 * (u.pn - 8); return W + (size_t)r * 2048; } };
struct EpiR1 { bf16 *RQ, *RK, *RG;
    DI void operator()(int row, int col, f32x4 v0, f32x4 v1) const {
        if (col < 1024) *(u32x4*)(RQ + blk_off(row, col, 64)) = pack8(v0, v1);
        else if (col < 2048) *(u32x4*)(RK + blk_off(row, col - 1024, 64)) = pack8(v0 * 0.0625f, v1 * 0.0625f);
        else *(u32x4*)(RG + (size_t)row * 2048 + col - 2048) = pack8(v0, v1); } };
struct SchedR2 : pg8::StaticOrder { const char* U; const char* W;
    DI const char* a_base(const pg8::Unit& u) const { const int r = u.pm < 8 ? C_RV + 256 * u.pm : C_RK + 256 * (u.pm - 8); return W + (size_t)r * 2048; }
    DI const char* b_base(const pg8::Unit& u) const { return U + (size_t)u.pn * 256 * 2048; } };
struct EpiR2 { bf16 *RVT, *KFT, *KBT; const float* DEC;
    DI void operator()(int row, int col, f32x4 v0, f32x4 v1) const {
        if (row < 2048) { *(u32x4*)(RVT + blk_off(row, col, 1024)) = pack8(v0, v1); return; }
        const int f = row - 2048, h = f >> 8; const float p0 = (float)(col & 127);
        const float a = DEC[h], b = DEC[4 + h];
        f32x4 kf0, kf1, kb0, kb1;
#pragma unroll
        for (int e = 0; e < 4; ++e) {
            const float pa = p0 + (float)e, pb = p0 + (float)(e + 4);
            kf0[e] = v0[e] * 0.0625f * __builtin_amdgcn_exp2f(a * (127.f - pa)); kf1[e] = v1[e] * 0.0625f * __builtin_amdgcn_exp2f(a * (127.f - pb));
            kb0[e] = v0[e] * 0.0625f * __builtin_amdgcn_exp2f(b * pa);           kb1[e] = v1[e] * 0.0625f * __builtin_amdgcn_exp2f(b * pb); }
        *(u32x4*)(KFT + blk_off(f, col, 1024)) = pack8(kf0, kf1);
        *(u32x4*)(KBT + blk_off(f, col, 1024)) = pack8(kb0, kb1); } };
struct SchedQK : pg8::StaticOrder { const char* U; const char* W; int g, r, nsub;
    DI const char* a_base(const pg8::Unit& u) const { const int b = u.pm >> 4, v0 = (u.pm & 15) * 256, rho = v0 / nsub, i0 = v0 % nsub; return U + (size_t)(b * SEQ + rho + r * i0) * 2048; }
    DI const char* b_base(const pg8::Unit& u) const { const int rw = (u.pn < 2 ? C_AQ : C_AK) + 512 * g + 256 * (u.pn & 1); return W + (size_t)rw * 2048; } };
struct EpiQK { bf16 *AQ, *AK;
    DI void operator()(int row, int col, f32x4 v0, f32x4 v1) const {
        if (col < 512) *(u32x4*)(AQ + blk_off(row, col, 32)) = pack8(v0, v1);
        else *(u32x4*)(AK + blk_off(row, col - 512, 32)) = pack8(v0, v1); } };
struct SchedGate : pg8::StaticOrder { const char* U; const char* W;
    DI const char* a_base(const pg8::Unit& u) const { return U + (size_t)u.pm * 256 * 2048; }
    DI const char* b_base(const pg8::Unit& u) const { return W + (size_t)(C_GA + 256 * u.pn) * 2048; } };
struct EpiGate { bf16 *GA, *GR;
    DI void operator()(int row, int col, f32x4 v0, f32x4 v1) const {
        f32x4 s0, s1;
#pragma unroll
        for (int e = 0; e < 4; ++e) { s0[e] = sigmoidf_(v0[e]); s1[e] = sigmoidf_(v1[e]); }
        bf16* dst = col < 1024 ? GA + (size_t)row * 1024 + col : GR + (size_t)row * 1024 + col - 1024;
        *(u32x4*)dst = pack8(s0, s1); } };
struct SchedA2 : pg8::StaticOrder { const char* U; const char* W; int g, r, nsub;
    DI const char* a_base(const pg8::Unit& u) const { return W + (size_t)(C_AV + 512 * g + 256 * u.pm) * 2048; }
    DI const char* b_base(const pg8::Unit& u) const { const int b = u.pn >> 4, v0 = (u.pn & 15) * 256, rho = v0 / nsub, i0 = v0 % nsub; return U + (size_t)(b * SEQ + rho + r * i0) * 2048; } };
struct EpiA2 { bf16* AVT;
    DI void operator()(int row, int col, f32x4 v0, f32x4 v1) const { *(u32x4*)(AVT + blk_off(row, col, 1024)) = pack8(v0, v1); } };
struct SchedG : pg8::StaticOrder { const char* A; const char* B; size_t abytes, bbytes;
    DI const char* a_base(const pg8::Unit& u) const { return A + (size_t)u.pm * abytes; }
    DI const char* b_base(const pg8::Unit& u) const { return B + (size_t)u.pn * bbytes; } };
struct EpiG1 { const bf16* GA; bf16* P1;
    DI void operator()(int row, int col, f32x4 v0, f32x4 v1) const {
        const u32x4 g = *(const u32x4*)(GA + (size_t)row * 1024 + col);
        f32x4 o0 = {v0[0] * bflo(g.x), v0[1] * bfhi(g.x), v0[2] * bflo(g.y), v0[3] * bfhi(g.y)}, o1 = {v1[0] * bflo(g.z), v1[1] * bfhi(g.z), v1[2] * bflo(g.w), v1[3] * bfhi(g.w)};
        *(u32x4*)(P1 + (size_t)row * 1024 + col) = pack8(o0, o1); } };
struct EpiG2 { const bf16* GR; const bf16* P1; bf16* MERGED;
    DI void operator()(int row, int col, f32x4 v0, f32x4 v1) const {
        const u32x4 g = *(const u32x4*)(GR + (size_t)row * 1024 + col);
        const u32x4 p = *(const u32x4*)(P1 + (size_t)row * 1024 + col);
        f32x4 o0 = {bflo(p.x) + v0[0] * bflo(g.x), bfhi(p.x) + v0[1] * bfhi(g.x), bflo(p.y) + v0[2] * bflo(g.y), bfhi(p.y) + v0[3] * bfhi(g.y)};
        f32x4 o1 = {bflo(p.z) + v1[0] * bflo(g.z), bfhi(p.z) + v1[1] * bfhi(g.z), bflo(p.w) + v1[2] * bflo(g.w), bfhi(p.w) + v1[3] * bfhi(g.w)};
        *(u32x4*)(MERGED + (size_t)row * 1024 + col) = pack8(o0, o1); } };
struct EpiG3 { const float* x; const float* MOD; float* H;
    DI void operator()(int row, int col, f32x4 v0, f32x4 v1) const {
        const int b = row >> 12; const float* gp = MOD + b * 6144 + 2048 + col; const float* xp = x + (size_t)row * 1024 + col;
        const f32x4 g0 = *(const f32x4*)gp, g1 = *(const f32x4*)(gp + 4), x0 = *(const f32x4*)xp, x1 = *(const f32x4*)(xp + 4);
        *(f32x4*)(H + (size_t)row * 1024 + col) = x0 * ALPHA + g0 * v0; *(f32x4*)(H + (size_t)row * 1024 + col + 4) = x1 * ALPHA + g1 * v1; } };
struct SchedM : pg8::StaticOrder { const char* A; const char* B; size_t abytes, ebytes, bbytes; const LAS int* texp;
    DI const char* a_base(const pg8::Unit& u) const { return A + (size_t)u.pm * abytes; }
    DI const char* b_base(const pg8::Unit& u) const { return B + (size_t)texp[u.pm] * ebytes + (size_t)u.pn * bbytes; } };
struct EpiM3 { bf16* HDN;
    DI void operator()(int row, int col, f32x4 a, f32x4 b) const {
        f32x4 o;
#pragma unroll
        for (int e = 0; e < 4; ++e) o[e] = a[e] * sigmoidf_(a[e]) * b[e];
        u32x2 w; w.x = pk2(o[0], o[1]); w.y = pk2(o[2], o[3]);
        *(u32x2*)(HDN + (size_t)row * 512 + (col >> 1)) = w; } };
struct EpiM4 { bf16* Y;
    DI void operator()(int row, int col, f32x4 v0, f32x4 v1) const { *(u32x4*)(Y + (size_t)row * 1024 + col) = pack8(v0, v1); } };

DI void ret_intra(Frame& F) {
    const int lane_ = F.lane;
    const bf16* RQ = (const bf16*)(F.ws + WS_RQ); const bf16* RK = (const bf16*)(F.ws + WS_RK); const bf16* RVT = (const bf16*)(F.ws + WS_RVT); bf16* Y = (bf16*)(F.ws + WS_Y);
    const float* DEC = (const float*)(F.ws + WS_DEC);
    const int r = lane_ & 31, h = lane_ >> 5;
    const int gw = F.vcu * NWAVES + F.wave, NGW = F.G * NWAVES;
    for (int it = gw; it < 4096; it += NGW) {
        const int dh = it & 1, ntl = (it >> 1) & 3, ch = (it >> 3) & 31, hd = (it >> 8) & 3, b = it >> 10;
        const int tok0 = b * SEQ + ch * 128, rb0 = tok0 >> 5;
        const float lf = DEC[hd], lb = DEC[4 + hd];
        f32x16 pT[4]; for (int i = 0; i < 4; ++i) pT[i] = zero16();
        const bf16* qp = RQ + ((size_t)(rb0 + ntl) * 64 + hd * 16) * 512 + lane_ * 8;
        const bf16* kp = RK + ((size_t)rb0 * 64 + hd * 16) * 512 + lane_ * 8;
#pragma unroll 4
        for (int ks = 0; ks < 16; ++ks) {
            const bf16x8 bq = ld16(qp + ks * 512);
#pragma unroll
            for (int mt = 0; mt < 4; ++mt) { const bf16x8 ak = ld16(kp + (size_t)mt * 64 * 512 + ks * 512); pT[mt] = MFMA32(ak, bq, pT[mt]); }
        }
        bf16x8 pb[4][2];
        const int n = 32 * ntl + r;
#pragma unroll
        for (int mt = 0; mt < 4; ++mt) {
#pragma unroll
            for (int i = 0; i < 16; ++i) { const int m = 32 * mt + crow(i, h); const int d = n - m;
                const float w = d >= 0 ? __builtin_amdgcn_exp2f(lf * (float)d) : __builtin_amdgcn_exp2f(lb * (float)(-d));
                pT[mt][i] *= w; }
            pb[mt][0] = pack_step(pT[mt], 0); pb[mt][1] = pack_step(pT[mt], 1);
        }
#pragma unroll 4
        for (int dt = 0; dt < 8; ++dt) {
            const int dv0 = hd * 512 + dh * 256 + dt * 32;
            const bf16* vp = RVT + ((size_t)(dv0 >> 5) * 1024 + (tok0 >> 4)) * 512 + r * 8 + 4 * h;
            f32x16 acc = zero16();
#pragma unroll
            for (int mt = 0; mt < 4; ++mt)
#pragma unroll
                for (int s2 = 0; s2 < 2; ++s2) { const bf16* bp = vp + (2 * mt + s2) * 512; acc = MFMA32(ld8x2(bp, bp + 256), pb[mt][s2], acc); }
            char* yp = (char*)Y + ((((size_t)(b * 4 + hd) * 32 + ch) * 4 + ntl) * 16 + dh * 8 + dt) * 2048 + lane_ * 32;
            u32x4 w0, w1;
            w0.x = pk2(acc[0], acc[1]); w0.y = pk2(acc[2], acc[3]); w0.z = pk2(acc[4], acc[5]); w0.w = pk2(acc[6], acc[7]);
            w1.x = pk2(acc[8], acc[9]); w1.y = pk2(acc[10], acc[11]); w1.z = pk2(acc[12], acc[13]); w1.w = pk2(acc[14], acc[15]);
            *(u32x4*)yp = w0; *(u32x4*)(yp + 16) = w1;
        }
    }
}
#define SBAR_ __builtin_amdgcn_sched_barrier(0)
constexpr int ST_SZ = 16 * 512, VT_SZ = 8 * 512, VT_OFF = 2 * 2 * ST_SZ;
DI bf16x8 ldg16(const char* base, unsigned off) { return *(const bf16x8*)(base + off); }
template <int VAR> DI void ret_scan(Frame& F) {
    const int lane_ = F.lane;
    const int r = lane_ & 31, h = lane_ >> 5, dir = F.wave >> 2, wg = F.wave & 3;
    LAS bf16* ST = (LAS bf16*)F.lds + dir * (2 * ST_SZ);
    LAS bf16* VT = (LAS bf16*)F.lds + VT_OFF + dir * (2 * VT_SZ);
    const unsigned loff = (unsigned)lane_ * 16u;
    const unsigned voff = (unsigned)(wg * 64 + lane_) * 32u;
    for (int unit = F.vcu; unit < 256; unit += F.G) {
        const int sl = unit & 15, hd = (unit >> 4) & 3, b = unit >> 6;
        const float lg = ((const float*)(F.ws + WS_DEC))[4 * dir + hd];
        const float cd = __builtin_amdgcn_exp2f(lg * 128.f);
        const float p = (float)(32 * wg + r);
        const float qd = dir ? __builtin_amdgcn_exp2f(lg * (128.f - p)) : __builtin_amdgcn_exp2f(lg * (p + 1.f));
        const char* qb = (const char*)(F.ws + WS_RQ) + (((size_t)(b * 128 + wg) * 64) + hd * 16) * 1024;
        const char* kb = (const char*)(F.ws + (dir ? WS_KBT : WS_KFT)) + ((size_t)(hd * 8 + 2 * wg) * 1024 + b * 256) * 1024;
        const char* vb = (const char*)(F.ws + WS_RVT) + ((size_t)(hd * 16 + sl) * 1024 + b * 256) * 1024;
        char* yb = VAR == 0 ? (char*)(F.ws + WS_Y) + ((((size_t)(b * 4 + hd) * 32) * 4 + wg) * 16 + sl) * 2048 : (char*)(F.ws + 339 * MiB) + (size_t)unit * 16384 + (dir * 4 + wg) * 2048;
#ifndef SCAN_SKEW
#define SCAN_SKEW 6
#endif
        if (sl != 0) { for (int z = 0; z < SCAN_SKEW; ++z) __builtin_amdgcn_s_sleep(16); }
        bf16x8 Qf[16], Kf0[8], Kf1[8];
        { const int c0 = dir ? 31 : 0, c1 = dir ? 30 : 1;
          const bf16x8 va = ldg16(vb + c0 * 8192, voff), vb2 = ldg16(vb + c0 * 8192, voff + 16);
#pragma unroll
          for (int ks = 0; ks < 8; ++ks) { Kf0[ks] = ldg16(kb + c0 * 8192, loff + 1024 * ks); Kf1[ks] = ldg16(kb + (size_t)1024 * 1024 + c0 * 8192, loff + 1024 * ks); }
#pragma unroll
          for (int ks = 0; ks < 16; ++ks) Qf[ks] = ldg16(qb + (size_t)c1 * 4 * 65536, loff + 1024 * ks);
          *(LAS bf16x8*)((LAS char*)VT + voff) = va; *(LAS bf16x8*)((LAS char*)VT + voff + 16) = vb2; }
        asm volatile("s_waitcnt lgkmcnt(0)" ::: "memory"); __builtin_amdgcn_s_barrier(); asm volatile("" ::: "memory");
        f32x16 S0 = zero16(), S1 = zero16();
        u32x4 yv0 = {0u, 0u, 0u, 0u}, yv1 = {0u, 0u, 0u, 0u};
#pragma unroll
        for (int step = 0; step < 32; ++step) {
            const int ch = dir ? 31 - step : step;
            int chn = dir ? ch - 1 : ch + 1; chn = chn < 0 ? 0 : (chn > 31 ? 31 : chn);
            const int cur = step & 1;
            char* yp = (VAR == 0 ? yb + (size_t)ch * 4 * 16 * 2048 : yb) + lane_ * 32;
            if (step > 0 && (step >= 15 && step <= 17) && VAR != 2 && VAR != 5) { yv0 = __builtin_nontemporal_load((const u32x4*)yp); yv1 = __builtin_nontemporal_load((const u32x4*)(yp + 16)); }
            SBAR_;
            if (step > 0) {
                const LAS char* sp = (const LAS char*)(ST + cur * ST_SZ) + loff;
                f32x16 acc = zero16();
#pragma unroll
                for (int kg = 0; kg < 8; ++kg) {
                    bf16x8 as[2];
#pragma unroll
                    for (int k = 0; k < 2; ++k) as[k] = *(const LAS bf16x8*)(sp + 1024 * (2 * kg + k));
#pragma unroll
                    for (int k = 0; k < 2; ++k) acc = MFMA32(as[k], Qf[2 * kg + k], acc);
                    SBAR_;
                }
                u32x4 w0, w1;
#pragma unroll
                for (int k = 0; k < 4; ++k) { w0[k] = pk2(bflo(yv0[k]) + acc[2 * k] * qd, bfhi(yv0[k]) + acc[2 * k + 1] * qd); w1[k] = pk2(bflo(yv1[k]) + acc[8 + 2 * k] * qd, bfhi(yv1[k]) + acc[8 + 2 * k + 1] * qd); }
                if (VAR == 2 || VAR == 5) asm volatile("" :: "v"(w0.x), "v"(w0.y), "v"(w0.z), "v"(w0.w), "v"(w1.x), "v"(w1.y), "v"(w1.z), "v"(w1.w)); else { *(u32x4*)yp = w0; *(u32x4*)(yp + 16) = w1; }
                SBAR_;
            }
            if (step < 31 && !(step + 1 >= 15 && step + 1 <= 17) && VAR != 2 && VAR != 5) {
                const char* ypn = (VAR == 0 ? yb + (size_t)chn * 4 * 16 * 2048 : yb) + lane_ * 32;
                yv0 = __builtin_nontemporal_load((const u32x4*)ypn); yv1 = __builtin_nontemporal_load((const u32x4*)(ypn + 16)); }
            SBAR_;
            if (step > 0 && VAR != 3 && VAR != 5) {
#pragma unroll
                for (int ks = 0; ks < 16; ++ks) Qf[ks] = ldg16(qb + (size_t)chn * 4 * 65536, loff + 1024 * ks);
            }
            SBAR_;
            const bf16x8 vn0 = ldg16(vb + chn * 8192, voff), vn1 = ldg16(vb + chn * 8192, voff + 16);
            if (step < 31) {
#pragma unroll
                for (int i = 0; i < 16; ++i) { S0[i] *= cd; S1[i] *= cd; }
                const LAS char* vp = (const LAS char*)(VT + cur * VT_SZ) + loff;
#pragma unroll
                for (int kg = 0; kg < 2; ++kg) {
                    bf16x8 bv[4];
#pragma unroll
                    for (int k = 0; k < 4; ++k) bv[k] = *(const LAS bf16x8*)(vp + 1024 * (4 * kg + k));
#pragma unroll
                    for (int k = 0; k < 4; ++k) { S0 = MFMA32(Kf0[4 * kg + k], bv[k], S0); S1 = MFMA32(Kf1[4 * kg + k], bv[k], S1); }
                    SBAR_;
                }
                if (VAR != 4 && VAR != 5) {
#pragma unroll
                for (int ks = 0; ks < 8; ++ks) { Kf0[ks] = ldg16(kb + chn * 8192, loff + 1024 * ks); Kf1[ks] = ldg16(kb + (size_t)1024 * 1024 + chn * 8192, loff + 1024 * ks); } }
                SBAR_;
                LAS char* vw = (LAS char*)(VT + (cur ^ 1) * VT_SZ) + voff;
                *(LAS bf16x8*)vw = vn0; *(LAS bf16x8*)(vw + 16) = vn1;
                LAS bf16* wp = ST + (cur ^ 1) * ST_SZ + (4 * wg) * 512 + r * 8 + 4 * h;
#pragma unroll
                for (int g = 0; g < 4; ++g) {
                    u32x2 w0; w0.x = pk2(S0[4 * g], S0[4 * g + 1]); w0.y = pk2(S0[4 * g + 2], S0[4 * g + 3]); *(LAS u32x2*)(wp + (g >> 1) * 512 + (g & 1) * 256) = w0;
                    u32x2 w1; w1.x = pk2(S1[4 * g], S1[4 * g + 1]); w1.y = pk2(S1[4 * g + 2], S1[4 * g + 3]); *(LAS u32x2*)(wp + (2 + (g >> 1)) * 512 + (g & 1) * 256) = w1; }
            }
            if (step >= 12 && step <= 18) asm volatile("s_waitcnt vmcnt(0)" ::: "memory");
            asm volatile("s_waitcnt lgkmcnt(0)" ::: "memory"); __builtin_amdgcn_s_barrier(); asm volatile("" ::: "memory"); SBAR_;
        }
        VM_WAIT();
    }
}
template <bool DRY> DI void ret_norm(Frame& F) {
    const int lane_ = F.lane;
    const char* Y = (const char*)(F.ws + WS_Y); bf16* RG = (bf16*)(F.ws + WS_RG); bf16* OUTP = DRY ? (bf16*)(F.ws + WS_RQ) : RG; const float* gain = F.in[8];
    const int r = lane_ & 31, h = lane_ >> 5;
    LAS char* T = (LAS char*)F.lds + F.wave * (32 * 272);
    const int gw = F.bx * NWAVES + F.wave, NGW = F.G * NWAVES;
    for (int it = gw; it < 2048; it += NGW) {
        const int ntl = it & 3, ch = (it >> 2) & 31, hd = (it >> 7) & 3, b = it >> 9;
        const char* yp = Y + ((size_t)it * 16) * 2048 + lane_ * 32;
        const size_t tok0 = (size_t)b * SEQ + ch * 128 + 32 * ntl;
        float s = 0.f, s2 = 0.f;
#pragma unroll 4
        for (int dvt = 0; dvt < 16; ++dvt) { const u32x4 a = *(const u32x4*)(yp + dvt * 2048), c = *(const u32x4*)(yp + dvt * 2048 + 16);
#pragma unroll
            for (int k = 0; k < 4; ++k) { const float x0 = bflo(a[k]), x1 = bfhi(a[k]), x2 = bflo(c[k]), x3 = bfhi(c[k]); s += (x0 + x1) + (x2 + x3); s2 += (x0 * x0 + x1 * x1) + (x2 * x2 + x3 * x3); } }
        s += __shfl_xor(s, 32); s2 += __shfl_xor(s2, 32);
        const float mean = s * (1.f / 512.f);
        const float var = fmaxf(s2 * (1.f / 512.f) - mean * mean, 0.f);
        const float rstd = 1.f / sqrtf(var + LN_EPS);
#pragma unroll 1
        for (int grp = 0; grp < 4; ++grp) {
#pragma unroll
            for (int t = 0; t < 4; ++t) {
                const u32x4 a = *(const u32x4*)(yp + (4 * grp + t) * 2048), c = *(const u32x4*)(yp + (4 * grp + t) * 2048 + 16);
                const u32x2 av[4] = {{a.x, a.y}, {a.z, a.w}, {c.x, c.y}, {c.z, c.w}};
#pragma unroll
                for (int q = 0; q < 4; ++q) { u32x2 w; w.x = pk2((bflo(av[q].x) - mean) * rstd, (bfhi(av[q].x) - mean) * rstd); w.y = pk2((bflo(av[q].y) - mean) * rstd, (bfhi(av[q].y) - mean) * rstd);
                    *(LAS u32x2*)(T + r * 272 + (32 * t + 8 * q + 4 * h) * 2) = w; }
            }
            LDS_WAIT(); asm volatile("" ::: "memory");
#pragma unroll
            for (int k = 0; k < 8; ++k) {
                const int task = lane_ + 64 * k, tk = task >> 4, cchunk = task & 15;
                const u32x4 v = *(const LAS u32x4*)(T + tk * 272 + cchunk * 16);
                const int col = hd * 512 + 128 * grp + 8 * cchunk;
                const size_t off = (tok0 + tk) * 2048 + col;
                const u32x4 gwv = *(const u32x4*)(RG + off); const f32x4 ga = *(const f32x4*)(gain + col), gb = *(const f32x4*)(gain + col + 4);
                float o[8];
#pragma unroll
                for (int e = 0; e < 4; ++e) { const float g0 = bflo(gwv[e]), g1 = bfhi(gwv[e]); const float n0 = e < 2 ? ga[2 * e] : gb[2 * e - 4], n1 = e < 2 ? ga[2 * e + 1] : gb[2 * e - 3];
                    o[2 * e] = g0 * sigmoidf_(g0) * bflo(v[e]) * n0; o[2 * e + 1] = g1 * sigmoidf_(g1) * bfhi(v[e]) * n1; }
                u32x4 w; w.x = pk2(o[0], o[1]); w.y = pk2(o[2], o[3]); w.z = pk2(o[4], o[5]); w.w = pk2(o[6], o[7]);
                *(u32x4*)(OUTP + off) = w;
            }
            LDS_WAIT(); asm volatile("" ::: "memory");
        }
    }
}

DI void attn_phase(Frame& F) {
    const int lane_ = F.lane;
    float* LSE = (float*)(F.ws + WS_LSE);
    const int r = lane_ & 31, h = lane_ >> 5;
    const int gw = F.vcu * NWAVES + F.wave, NGW = F.G * NWAVES;
    for (int it = gw; it < 6144; it += NGW) {
        const int g = it >> 11, rem = it & 2047;
        const int dil = g == 0 ? 1 : (g == 1 ? 4 : 16), nsub = SEQ / dil, nqt = nsub >> 5;
        const int qt = rem % nqt; const int rem2 = rem / nqt; const int rho = rem2 % dil; const int bh = rem2 / dil; const int hg = bh & 3, b = bh >> 2;
        const int head = 4 * g + hg;
        const float slope = __builtin_amdgcn_exp2f(-8.f * (float)(head + 1) * (1.f / 12.f)) * (float)dil;
        const bf16* AQ = (const bf16*)(F.ws + WS_AQ + (size_t)g * 16 * MiB); const bf16* AK = (const bf16*)(F.ws + WS_AK + (size_t)g * 16 * MiB);
        const bf16* AVT = (const bf16*)(F.ws + WS_AVT) + (size_t)g * 512 * NT;
        bf16* OG = (bf16*)(F.ws + (g == 0 ? WS_O0 : (g == 1 ? WS_O1 : WS_O2)));
        const int i0 = 32 * qt;
        const int v0 = b * SEQ + rho * nsub;
        const size_t tokbase = (size_t)b * SEQ + rho;
        bf16x8 bq[8];
        { const bf16* qp = AQ + ((size_t)((v0 + i0) >> 5) * 32 + hg * 8) * 512 + lane_ * 8;
#pragma unroll
          for (int ks = 0; ks < 8; ++ks) bq[ks] = ld16(qp + ks * 512); }
        f32x16 sT[5];
#pragma unroll
        for (int kt = 0; kt < 5; ++kt) {
            int ik0 = i0 - 64 + 32 * kt; ik0 = ik0 < 0 ? 0 : (ik0 >= nsub ? nsub - 32 : ik0);
            const bf16* kp = AK + ((size_t)((v0 + ik0) >> 5) * 32 + hg * 8) * 512 + lane_ * 8;
            f32x16 acc = zero16();
#pragma unroll
            for (int ks = 0; ks < 8; ++ks) acc = MFMA32(ld16(kp + ks * 512), bq[ks], acc);
            sT[kt] = acc;
        }
        const int iq = i0 + r;
        float mx = -3.0e38f;
#pragma unroll
        for (int kt = 0; kt < 5; ++kt)
#pragma unroll
            for (int i = 0; i < 16; ++i) { const int ik = i0 - 64 + 32 * kt + crow(i, h); const int d = ik - iq; const int ad = d < 0 ? -d : d;
                const bool valid = (ad <= 64) && (ik >= 0) && (ik < nsub);
                const float sc = valid ? sT[kt][i] * 0.08838834764831845f - slope * (float)ad : -1e30f;
                sT[kt][i] = sc; mx = fmaxf(mx, sc); }
        mx = fmaxf(mx, __shfl_xor(mx, 32));
        float sum = 0.f;
#pragma unroll
        for (int kt = 0; kt < 5; ++kt)
#pragma unroll
            for (int i = 0; i < 16; ++i) { const float p = __expf(sT[kt][i] - mx); sT[kt][i] = p; sum += p; }
        sum += __shfl_xor(sum, 32);
        const float inv = 1.f / sum;
        if (h == 0) LSE[((size_t)g * NT + tokbase + (size_t)dil * iq) * 4 + hg] = mx + __logf(sum);
        bf16x8 pb[5][2];
#pragma unroll
        for (int kt = 0; kt < 5; ++kt) { pb[kt][0] = pack_step(sT[kt], 0); pb[kt][1] = pack_step(sT[kt], 1); }
        bf16* op = OG + (tokbase + (size_t)dil * iq) * 512 + hg * 128 + 4 * h;
#pragma unroll
        for (int dt = 0; dt < 4; ++dt) {
            const bf16* vp = AVT + ((size_t)(hg * 4 + dt) * 1024) * 512 + r * 8 + 4 * h;
            f32x16 acc = zero16();
#pragma unroll
            for (int kt = 0; kt < 5; ++kt) {
                int ik0 = i0 - 64 + 32 * kt; ik0 = ik0 < 0 ? 0 : (ik0 >= nsub ? nsub - 32 : ik0);
                const bf16* bp = vp + (size_t)((v0 + ik0) >> 4) * 512;
#pragma unroll
                for (int s2 = 0; s2 < 2; ++s2) acc = MFMA32(ld8x2(bp + s2 * 512, bp + s2 * 512 + 256), pb[kt][s2], acc);
            }
#pragma unroll
            for (int q = 0; q < 4; ++q) { u32x2 w; w.x = pk2(acc[4 * q] * inv, acc[4 * q + 1] * inv); w.y = pk2(acc[4 * q + 2] * inv, acc[4 * q + 3] * inv); *(u32x2*)(op + 32 * dt + 8 * q) = w; }
        }
    }
}
DI void attn_mix(Frame& F) {
    const int lane_ = opaque_lane(F);
    const bf16* O0 = (const bf16*)(F.ws + WS_O0); const bf16* O1 = (const bf16*)(F.ws + WS_O1); const bf16* O2 = (const bf16*)(F.ws + WS_O2);
    const float* LSE = (const float*)(F.ws + WS_LSE); bf16* MIX = (bf16*)(F.ws + WS_ATTMIX);
    const int gw = F.bx * NWAVES + F.wave, NGW = F.G * NWAVES;
    for (int m = gw; m < NT; m += NGW) {
        const int hg = lane_ >> 4;
        const float l0 = LSE[((size_t)0 * NT + m) * 4 + hg], l1 = LSE[((size_t)1 * NT + m) * 4 + hg], l2 = LSE[((size_t)2 * NT + m) * 4 + hg];
        const float mx = fmaxf(l0, fmaxf(l1, l2)); const float e0 = __expf(l0 - mx), e1 = __expf(l1 - mx), e2 = __expf(l2 - mx); const float inv = 1.f / (e0 + e1 + e2);
        const float w0 = e0 * inv, w1 = e1 * inv, w2 = e2 * inv;
        const size_t off = (size_t)m * 512 + 8 * lane_;
        const u32x4 a = *(const u32x4*)(O0 + off), b = *(const u32x4*)(O1 + off), c = *(const u32x4*)(O2 + off);
        u32x4 o;
        o.x = pk2(w0 * bflo(a.x) + w1 * bflo(b.x) + w2 * bflo(c.x), w0 * bfhi(a.x) + w1 * bfhi(b.x) + w2 * bfhi(c.x));
        o.y = pk2(w0 * bflo(a.y) + w1 * bflo(b.y) + w2 * bflo(c.y), w0 * bfhi(a.y) + w1 * bfhi(b.y) + w2 * bfhi(c.y));
        o.z = pk2(w0 * bflo(a.z) + w1 * bflo(b.z) + w2 * bflo(c.z), w0 * bfhi(a.z) + w1 * bfhi(b.z) + w2 * bfhi(c.z));
        o.w = pk2(w0 * bflo(a.w) + w1 * bflo(b.w) + w2 * bflo(c.w), w0 * bfhi(a.w) + w1 * bfhi(b.w) + w2 * bfhi(c.w));
        *(u32x4*)(MIX + off) = o;
    }
}

DI float reduce4(const float (&p)[4], int lane) {
    const bool hi = (lane & 32) != 0;
    float a0 = hi ? p[2] : p[0], a1 = hi ? p[3] : p[1]; const float b0 = hi ? p[0] : p[2], b1 = hi ? p[1] : p[3];
    a0 += __shfl_xor(b0, 32); a1 += __shfl_xor(b1, 32);
    const bool hi2 = (lane & 16) != 0;
    float c = hi2 ? a1 : a0; const float d = hi2 ? a0 : a1;
    c += __shfl_xor(d, 16);
    c += __shfl_xor(c, 8); c += __shfl_xor(c, 4); c += __shfl_xor(c, 2); c += __shfl_xor(c, 1);
    return c;
}
DI void bcast4(float c, float (&o)[4]) {
#pragma unroll
    for (int t = 0; t < 4; ++t) o[t] = __builtin_bit_cast(float, __builtin_amdgcn_readlane(__builtin_bit_cast(int, c), 16 * t));
}
template <bool DRY> DI void moe_route(Frame& F) {
    const int lane_ = opaque_lane(F);
    float* H = (float*)F.outb; float* HO = DRY ? (float*)(F.ws + WS_XG) : H; const float* MOD = (const float*)(F.ws + WS_MOD); const float* WR = (const float*)(F.ws + WS_WROUT);
    bf16* U2 = (bf16*)(F.ws + (DRY ? WS_XG + 64 * MiB : WS_U2)); unsigned* ROUTE = (unsigned*)(F.ws + (DRY ? WS_XG + 100 * MiB : WS_ROUTE)); unsigned* CNT = (unsigned*)(F.ws + WS_CTL) + CW_CNT + (DRY ? 4096 : 0);
    const float* g1 = F.in[11]; const float* b1 = F.in[12]; const float* bco = F.in[14]; const float* bfi = F.in[16];
    LAS float* lg = (LAS float*)F.lds + F.wave * 256;
    const int gw = F.bx * NWAVES + F.wave, NGW = F.G * NWAVES;
    f32x4 un[4][4];
    { const int m0 = gw * 4;
      if (m0 < NT) {
#pragma unroll
        for (int t = 0; t < 4; ++t) { const f32x4* hr = (const f32x4*)(H + (size_t)(m0 + t) * DM) + lane_;
#pragma unroll
            for (int j = 0; j < 4; ++j) un[t][j] = hr[64 * j]; } } }
    for (int m0 = gw * 4; m0 < NT; m0 += NGW * 4) {
        const int b = m0 >> 12;
        f32x4 u[4][4];
        float ps[4], tot[4];
#pragma unroll
        for (int t = 0; t < 4; ++t) { float s = 0.f;
#pragma unroll
            for (int j = 0; j < 4; ++j) { u[t][j] = un[t][j]; s += (u[t][j].x + u[t][j].y) + (u[t][j].z + u[t][j].w); }
            ps[t] = s; }
        { const int m1 = m0 + NGW * 4;
          if (m1 < NT) {
#pragma unroll
            for (int t = 0; t < 4; ++t) { const f32x4* hr = (const f32x4*)(H + (size_t)(m1 + t) * DM) + lane_;
#pragma unroll
                for (int j = 0; j < 4; ++j) un[t][j] = hr[64 * j]; } } }
        bcast4(reduce4(ps, lane_), tot);
#pragma unroll
        for (int t = 0; t < 4; ++t) { const float mean = tot[t] * (1.f / DM); float s2 = 0.f;
#pragma unroll
            for (int j = 0; j < 4; ++j) { u[t][j] = u[t][j] - mean; s2 += (u[t][j].x * u[t][j].x + u[t][j].y * u[t][j].y) + (u[t][j].z * u[t][j].z + u[t][j].w * u[t][j].w); }
            ps[t] = s2; }
        bcast4(reduce4(ps, lane_), tot);
#pragma unroll
        for (int t = 0; t < 4; ++t) { const float rstd = 1.f / sqrtf(tot[t] * (1.f / DM) + LN_EPS); f32x4* hw = (f32x4*)(HO + (size_t)(m0 + t) * DM) + lane_; float s = 0.f;
#pragma unroll
            for (int j = 0; j < 4; ++j) { const int col = 256 * j + 4 * lane_; const f32x4 gg = *(const f32x4*)(g1 + col), bb = *(const f32x4*)(b1 + col);
                u[t][j] = u[t][j] * rstd * gg + bb; hw[64 * j] = u[t][j]; s += (u[t][j].x + u[t][j].y) + (u[t][j].z + u[t][j].w); }
            ps[t] = s; }
        bcast4(reduce4(ps, lane_), tot);
#pragma unroll
        for (int t = 0; t < 4; ++t) { const float mean = tot[t] * (1.f / DM); float s2 = 0.f;
#pragma unroll
            for (int j = 0; j < 4; ++j) { u[t][j] = u[t][j] - mean; s2 += (u[t][j].x * u[t][j].x + u[t][j].y * u[t][j].y) + (u[t][j].z * u[t][j].z + u[t][j].w * u[t][j].w); }
            ps[t] = s2; }
        bcast4(reduce4(ps, lane_), tot);
#pragma unroll
        for (int t = 0; t < 4; ++t) { const float rstd = 1.f / sqrtf(tot[t] * (1.f / DM) + LN_EPS); u32x2* o8 = (u32x2*)(U2 + (size_t)(m0 + t) * DM) + lane_;
#pragma unroll
            for (int j = 0; j < 4; ++j) { const int col = 256 * j + 4 * lane_;
                const f32x4 sh = *(const f32x4*)(MOD + b * 6144 + 3072 + col), sc = *(const f32x4*)(MOD + b * 6144 + 4096 + col);
                u[t][j] = u[t][j] * rstd * (sc + 1.f) + sh;
                u32x2 w; w.x = pk2(u[t][j].x, u[t][j].y); w.y = pk2(u[t][j].z, u[t][j].w); o8[64 * j] = w; } }
#ifndef ROUTE_NO
#define ROUTE_NO 36
#endif
#pragma unroll 2
        for (int o = 0; o < (DRY ? ROUTE_NO : 36); ++o) {
            const f32x4* wr = (const f32x4*)(WR + o * 1024) + lane_;
            f32x4 w[4];
#pragma unroll
            for (int j = 0; j < 4; ++j) w[j] = wr[64 * j];
#pragma unroll
            for (int t = 0; t < 4; ++t) { float a = 0.f;
#pragma unroll
                for (int j = 0; j < 4; ++j) a += (u[t][j].x * w[j].x + u[t][j].y * w[j].y) + (u[t][j].z * w[j].z + u[t][j].w * w[j].w);
                ps[t] = a; }
            const float c = reduce4(ps, lane_);
            if ((lane_ & 15) == 0) lg[(lane_ >> 4) * 64 + o] = c;
        }
        LDS_WAIT(); asm volatile("" ::: "memory");
        if (lane_ < 4) {
            const int t = lane_, m = m0 + t; const LAS float* L = lg + t * 64;
            float c[4]; int gs = 0; float cm = -3.0e38f;
#pragma unroll
            for (int j = 0; j < 4; ++j) { c[j] = L[j] + bco[j]; if (c[j] > cm) { cm = c[j]; gs = j; } }
            float den = 0.f;
#pragma unroll
            for (int j = 0; j < 4; ++j) den += __expf(c[j] - cm);
            const float pg = 1.f / den;
            float f[8];
#pragma unroll
            for (int e = 0; e < 8; ++e) f[e] = L[4 + 8 * gs + e] + bfi[8 * gs + e];
            int i0 = 0; float v0 = f[0];
#pragma unroll
            for (int e = 1; e < 8; ++e) if (f[e] > v0) { v0 = f[e]; i0 = e; }
            int i1 = -1; float v1 = -3.0e38f;
#pragma unroll
            for (int e = 0; e < 8; ++e) if (e != i0 && f[e] > v1) { v1 = f[e]; i1 = e; }
            const float e1 = __expf(v1 - v0); const float w0 = pg / (1.f + e1), w1 = pg * e1 / (1.f + e1);
            const int ex0 = gs * 8 + i0, ex1 = gs * 8 + i1;
            const unsigned p0 = atomicAdd(CNT + 64 * ex0, 1u), p1 = atomicAdd(CNT + 64 * ex1, 1u);
            unsigned* R = ROUTE + (size_t)m * 8;
            R[0] = ex0; R[1] = ex1; R[2] = p0; R[3] = p1; R[4] = __float_as_uint(w0); R[5] = __float_as_uint(w1);
        }
        LDS_WAIT(); asm volatile("" ::: "memory");
    }
}
DI int moe_tables(Frame& F) {
    LAS int* tab = (LAS int*)(F.lds + TEXP_OFF);
    if (F.tid == 0) {
        const unsigned* CNT = (const unsigned*)(F.ws + WS_CTL) + CW_CNT;
        int t = 0;
        for (int e = 0; e < 32; ++e) { const int c = (int)xb_ld((unsigned*)CNT + 64 * e); const int nt = (c + 255) >> 8; tab[192 + e] = t * 256; for (int k = 0; k < nt; ++k) tab[t + k] = e; t += nt; }
        tab[224] = t;
    }
    __syncthreads();
    return tab[224];
}
DI void moe_gather(Frame& F) {
    const int lane_ = opaque_lane(F);
    const LAS int* tab = (const LAS int*)(F.lds + TEXP_OFF);
    const bf16* U2 = (const bf16*)(F.ws + WS_U2); bf16* XG = (bf16*)(F.ws + WS_XG); unsigned* ROUTE = (unsigned*)(F.ws + WS_ROUTE);
    const int gw = F.bx * NWAVES + F.wave, NGW = F.G * NWAVES;
    for (int a = gw; a < 2 * NT; a += NGW) {
        const int m = a >> 1, k = a & 1;
        const unsigned e = ROUTE[(size_t)m * 8 + k], pos = ROUTE[(size_t)m * 8 + 2 + k];
        const int slot = tab[192 + e] + (int)pos;
        const u32x4* src = (const u32x4*)(U2 + (size_t)m * DM) + lane_; u32x4* dst = (u32x4*)(XG + (size_t)slot * DM) + lane_;
        dst[0] = src[0]; dst[64] = src[64];
        if (lane_ == 0) ROUTE[(size_t)m * 8 + 6 + k] = (unsigned)slot;
    }
}
template <bool DRY> DI void moe_combine(Frame& F) {
    const int lane_ = opaque_lane(F);
    float* H = (float*)F.outb; float* HO = DRY ? (float*)(F.ws + WS_XG) : H; const float* MOD = (const float*)(F.ws + WS_MOD); const bf16* YR = (const bf16*)(F.ws + WS_YROWS); const unsigned* ROUTE = (const unsigned*)(F.ws + WS_ROUTE);
    const float* g2 = F.in[20]; const float* b2 = F.in[21];
    const int gw = F.bx * NWAVES + F.wave, NGW = F.G * NWAVES;
    for (int m = gw; m < NT; m += NGW) {
        const int b = m >> 12; const unsigned* R = ROUTE + (size_t)m * 8;
        const float w0 = __uint_as_float(R[4]), w1 = __uint_as_float(R[5]); const size_t s0 = R[6], s1 = R[7];
        f32x4* hr = (f32x4*)(H + (size_t)m * DM) + lane_; f32x4* hw = (f32x4*)(HO + (size_t)m * DM) + lane_;
        f32x4 v[4]; float s = 0.f;
#pragma unroll
        for (int j = 0; j < 4; ++j) { const int col = 256 * j + 4 * lane_;
            const u32x2 ya = *(const u32x2*)(YR + s0 * DM + col), yb = *(const u32x2*)(YR + s1 * DM + col);
            const f32x4 y = {w0 * bflo(ya.x) + w1 * bflo(yb.x), w0 * bfhi(ya.x) + w1 * bfhi(yb.x), w0 * bflo(ya.y) + w1 * bflo(yb.y), w0 * bfhi(ya.y) + w1 * bfhi(yb.y)};
            const f32x4 gt = *(const f32x4*)(MOD + b * 6144 + 5120 + col);
            v[j] = hr[64 * j] * ALPHA + gt * y; s += (v[j].x + v[j].y) + (v[j].z + v[j].w); }
        const float mean = wave_sum(s) * (1.f / DM); float s2 = 0.f;
#pragma unroll
        for (int j = 0; j < 4; ++j) { v[j] = v[j] - mean; s2 += (v[j].x * v[j].x + v[j].y * v[j].y) + (v[j].z * v[j].z + v[j].w * v[j].w); }
        const float rstd = 1.f / sqrtf(wave_sum(s2) * (1.f / DM) + LN_EPS);
#pragma unroll
        for (int j = 0; j < 4; ++j) { const int col = 256 * j + 4 * lane_; hw[64 * j] = v[j] * rstd * *(const f32x4*)(g2 + col) + *(const f32x4*)(b2 + col); }
    }
}

__global__ void __launch_bounds__(NTHREADS, 2) fwd_kernel(Args args) {
    extern __shared__ __attribute__((aligned(16))) unsigned char lds[];
    Frame F;
    F.lds = (LAS unsigned char*)lds;
    F.tid = threadIdx.x; F.lane = F.tid & 63; F.wave = __builtin_amdgcn_readfirstlane(F.tid >> 6);
    F.G = gridDim.x; F.bx = blockIdx.x; F.vcu = (F.G % 8 == 0) ? (F.bx % 8) * (F.G / 8) + F.bx / 8 : F.bx;
    F.ws = args.ws; F.outb = (unsigned char*)args.out;
#pragma unroll
    for (int i = 0; i < 22; ++i) F.in[i] = args.in[i];
    for (int u = F.tid; u < (LDS_BYTES - LDSX_OFF) / 4; u += NTHREADS) ((LAS unsigned*)(F.lds + LDSX_OFF))[u] = 0u;
    __syncthreads();
    unsigned* ctl = (unsigned*)(F.ws + WS_CTL);
    XcdBarrier bar = xcd_barrier_post(ctl + CW_BAR, (volatile LAS unsigned*)(F.lds + MISC_OFF) + 8);
    if (F.tid == 0) ((volatile LAS unsigned*)(F.lds + MISC_OFF))[12] = xb_add(ctl + CW_RANK + 64 * bar.x, 1u);
    unsigned long long* TS = (unsigned long long*)(ctl + 32768);
    int nst = 1;
    if (PROF && F.bx == 0 && F.tid == 0) TS[0] = __builtin_amdgcn_s_memrealtime();
#define GRID_BAR() do { xcd_barrier(bar); if (PROF && F.bx == 0 && F.tid == 0) TS[nst] = __builtin_amdgcn_s_memrealtime(); ++nst; } while (0)
    const char* U = (const char*)(F.outb + OUT_U); const char* WINT = (const char*)(F.outb + OUT_WINT);

    REP(1,  phase0(F); GRID_BAR();
    phase1(F); GRID_BAR(); );
    { volatile LAS unsigned* M = (volatile LAS unsigned*)(F.lds + MISC_OFF);
      if (F.tid == 0) { unsigned pre = 0, nx = 0, mine = 0, even = 1, idx = 0;
          for (unsigned j = 0; j < 16; ++j) { const unsigned cj = xb_ld(ctl + CW_BAR + XB_XCNT(j)); if (j < bar.x) { pre += cj; idx += (cj > 0u); } if (j == bar.x) mine = cj; nx += (cj > 0u); if (cj != 0u && cj * 8u != (unsigned)F.G) even = 0; }
          const unsigned rank = M[12];
          M[13] = pre + rank; M[14] = (even && nx == 8u) ? rank * 8u + idx : (unsigned)F.bx; (void)mine; }
      __syncthreads();
      F.vcu = (int)M[13]; }
    const int c = (int)((volatile LAS unsigned*)(F.lds + MISC_OFF))[14];
    REP(2,
    { SchedR1 S; S.init(64, 16, F.G, c); S.U = U; S.W = WINT;
      pg8::EpiV<EpiR1> E{EpiR1{(bf16*)(F.ws + WS_RQ), (bf16*)(F.ws + WS_RK), (bf16*)(F.ws + WS_RG)}};
      pg8::gemm_phase<pg8::EpiV<EpiR1>, SchedR1, true>(F.lds, 1024, 1024, 1024, S, E); }
    { SchedR2 S; S.init(12, 64, F.G, c); S.U = U; S.W = WINT;
      pg8::EpiV<EpiR2> E{EpiR2{(bf16*)(F.ws + WS_RVT), (bf16*)(F.ws + WS_KFT), (bf16*)(F.ws + WS_KBT), (const float*)(F.ws + WS_DEC)}};
      pg8::gemm_phase<pg8::EpiV<EpiR2>, SchedR2, true>(F.lds, 1024, 1024, 1024, S, E); }
    GRID_BAR(); );
    REPX(14, ret_intra(F); GRID_BAR(); );
    REP(3,  ret_intra(F); GRID_BAR();
    ret_scan<0>(F); GRID_BAR(); );
#ifndef SVAR
#define SVAR 1
#endif
    REPX(15, ret_scan<SVAR>(F); GRID_BAR(); );
    ret_norm<false>(F); GRID_BAR();
    REPX(10, ret_norm<true>(F); GRID_BAR(); );
    REP(4,
    _Pragma("unroll 1")
    for (int g = 0; g < 3; ++g) {
        const int dil = g == 0 ? 1 : (g == 1 ? 4 : 16);
        SchedQK S; S.init(64, 4, F.G, c); S.U = U; S.W = WINT; S.g = g; S.r = dil; S.nsub = SEQ / dil;
        pg8::EpiV<EpiQK> E{EpiQK{(bf16*)(F.ws + WS_AQ + (size_t)g * 16 * MiB), (bf16*)(F.ws + WS_AK + (size_t)g * 16 * MiB)}};
        pg8::gemm_phase<pg8::EpiV<EpiQK>, SchedQK, false>(F.lds, 1024, 1024 * dil, 1024, S, E);
    }
    { SchedGate S; S.init(64, 8, F.G, c); S.U = U; S.W = WINT;
      pg8::EpiV<EpiGate> E{EpiGate{(bf16*)(F.ws + WS_GA), (bf16*)(F.ws + WS_GR)}};
      pg8::gemm_phase<pg8::EpiV<EpiGate>, SchedGate, true>(F.lds, 1024, 1024, 1024, S, E); }
_Pragma("unroll 1")
    for (int g = 0; g < 3; ++g) {
        const int dil = g == 0 ? 1 : (g == 1 ? 4 : 16);
        SchedA2 S; const int cc = (g == 1) ? c - 128 : c; S.init(2, 64, F.G, (cc >= 0 && cc < 128) ? cc : -1); S.U = U; S.W = WINT; S.g = g; S.r = dil; S.nsub = SEQ / dil;
        pg8::EpiV<EpiA2> E{EpiA2{(bf16*)(F.ws + WS_AVT) + (size_t)g * 512 * NT}};
        pg8::gemm_phase<pg8::EpiV<EpiA2>, SchedA2, true>(F.lds, 1024, 1024, 1024 * dil, S, E);
    }
    GRID_BAR(); );
    REP(5,  attn_phase(F); GRID_BAR(); );
    REP(6,  attn_mix(F); GRID_BAR(); );
    REP(7,
    { SchedG S; S.init(64, 4, F.G, c); S.A = (const char*)(F.ws + WS_ATTMIX); S.B = (const char*)(F.ws + WS_WAT); S.abytes = 256 * 512 * 2; S.bbytes = 256 * 512 * 2;
      pg8::EpiV<EpiG1> E{EpiG1{(const bf16*)(F.ws + WS_GA), (bf16*)F.outb}};
      pg8::gemm_phase<pg8::EpiV<EpiG1>, SchedG, false>(F.lds, 512, 512, 512, S, E); }
    { SchedG S; S.init(64, 4, F.G, c); S.A = (const char*)(F.ws + WS_RG); S.B = (const char*)(F.ws + WS_WRT); S.abytes = 256 * 2048 * 2; S.bbytes = 256 * 2048 * 2;
      pg8::EpiV<EpiG2> E{EpiG2{(const bf16*)(F.ws + WS_GR), (const bf16*)F.outb, (bf16*)(F.ws + WS_MERGED)}};
      pg8::gemm_phase<pg8::EpiV<EpiG2>, SchedG, false>(F.lds, 2048, 2048, 2048, S, E); }
    GRID_BAR();
    { SchedG S; S.init(64, 4, F.G, c); S.A = (const char*)(F.ws + WS_MERGED); S.B = (const char*)(F.ws + WS_WOT); S.abytes = 256 * 1024 * 2; S.bbytes = 256 * 1024 * 2;
      pg8::EpiV<EpiG3> E{EpiG3{F.in[0], (const float*)(F.ws + WS_MOD), (float*)F.outb}};
      pg8::gemm_phase<pg8::EpiV<EpiG3>, SchedG, false>(F.lds, 1024, 1024, 1024, S, E); }
    GRID_BAR(); );
    if (F.wave & 1) { moe_weight_transposes(F); moe_route<false>(F); } else { moe_route<false>(F); moe_weight_transposes(F); }
    GRID_BAR();
    REPX(11, moe_route<true>(F); GRID_BAR(); );
    const int ntiles = moe_tables(F);
    REP(8,  moe_gather(F); GRID_BAR(); );
    REP(9,
    { SchedM S; S.init(ntiles, 4, F.G, c); S.A = (const char*)(F.ws + WS_XG); S.B = (const char*)(F.ws + WS_W13T); S.abytes = 256 * 1024 * 2; S.ebytes = (size_t)1024 * 1024 * 2; S.bbytes = 256 * 1024 * 2;
      S.texp = (const LAS int*)(F.lds + TEXP_OFF);
      pg8::EpiV<EpiM3> E{EpiM3{(bf16*)(F.ws + WS_HDN)}};
      pg8::gemm_phase<pg8::EpiV<EpiM3>, SchedM, true>(F.lds, 1024, 1024, 1024, S, E); }
    GRID_BAR();
    { SchedM S; S.init(ntiles, 4, F.G, c); S.A = (const char*)(F.ws + WS_HDN); S.B = (const char*)(F.ws + WS_W2T); S.abytes = 256 * 512 * 2; S.ebytes = (size_t)1024 * 512 * 2; S.bbytes = 256 * 512 * 2;
      S.texp = (const LAS int*)(F.lds + TEXP_OFF);
      pg8::EpiV<EpiM4> E{EpiM4{(bf16*)(F.ws + WS_YROWS)}};
      pg8::gemm_phase<pg8::EpiV<EpiM4>, SchedM, true>(F.lds, 512, 512, 512, S, E); }
    GRID_BAR(); );
    REPX(12, moe_combine<true>(F); GRID_BAR(); );
    REPX(13, GRID_BAR(); GRID_BAR(); GRID_BAR(); GRID_BAR(); GRID_BAR(); GRID_BAR(); GRID_BAR(); GRID_BAR(); GRID_BAR(); GRID_BAR(); );
    moe_combine<false>(F);
#if PROF
    GRID_BAR();
    { const unsigned long long ta0 = __hip_atomic_load(TS + PROF_A - 1, __ATOMIC_RELAXED, __HIP_MEMORY_SCOPE_AGENT), ta1 = __hip_atomic_load(TS + PROF_A, __ATOMIC_RELAXED, __HIP_MEMORY_SCOPE_AGENT);
      const unsigned long long tb0 = __hip_atomic_load(TS + PROF_B - 1, __ATOMIC_RELAXED, __HIP_MEMORY_SCOPE_AGENT), tb1 = __hip_atomic_load(TS + PROF_B, __ATOMIC_RELAXED, __HIP_MEMORY_SCOPE_AGENT);
      const float V1 = (float)(ta1 - ta0) * 0.01f, V2 = (float)(tb1 - tb0) * 0.01f * 20.f;
      float* out = (float*)F.outb;
      for (int i = F.bx * NTHREADS + F.tid; i < NT * DM; i += F.G * NTHREADS) out[i] = (i < 16) ? V2 : V1; }
#endif
}

extern "C" void kernel_launch(void* const* d_in, const int* in_sizes, int n_in, void* d_out, int out_size, void* d_ws, size_t ws_size, hipStream_t stream) {
    static int grid = 0;
    if (grid == 0) {
        if (n_in != 22 || out_size != NT * DM || ws_size < WS_END) { fprintf(stderr, "kernel_launch: unexpected problem (n_in %d, out %d, ws %zu)\n", n_in, out_size, ws_size); grid = -1; return; }
        int dev = 0, cus = 0, per_cu = 0;
        if (hipGetDevice(&dev) != hipSuccess || hipDeviceGetAttribute(&cus, hipDeviceAttributeMultiprocessorCount, dev) != hipSuccess) { grid = -1; return; }
        if (hipFuncSetAttribute((const void*)fwd_kernel, hipFuncAttributeMaxDynamicSharedMemorySize, LDS_BYTES) != hipSuccess) { grid = -1; return; }
        if (hipOccupancyMaxActiveBlocksPerMultiprocessor(&per_cu, (const void*)fwd_kernel, NTHREADS, LDS_BYTES) != hipSuccess || per_cu < 1) { fprintf(stderr, "kernel_launch: occupancy query reports %d blocks/CU\n", per_cu); (void)hipGetLastError(); grid = -1; return; }
        grid = cus;
    }
    if (grid < 0) return;
    (void)hipMemsetAsync((char*)d_ws + WS_CTL, 0, CTL_ZERO_BYTES, stream);
    Args a{};
    for (int i = 0; i < 22; ++i) a.in[i] = (const float*)d_in[i];
    a.out = (float*)d_out; a.ws = (unsigned char*)d_ws;
    hipLaunchKernelGGL(fwd_kernel, dim3(grid), dim3(NTHREADS), LDS_BYTES, stream, a);
}
```

```cpp
#ifndef PROF
#define PROF 0
#endif
#ifndef DUP
#define DUP 0
#endif
#define REP(k, ...) do { __VA_ARGS__ if (DUP == (k)) { __VA_ARGS__ } } while (0)
#define REPX(k, ...) do { if (DUP == (k)) { __VA_ARGS__ } } while (0)
#ifndef PROF_A
#define PROF_A 1
#endif
#ifndef PROF_B
#define PROF_B 2
#endif
#include <hip/hip_runtime.h>
#include <cstdio>
#include <cstdint>

#define GAS __attribute__((address_space(1)))
#define LAS __attribute__((address_space(3)))
#define DI __device__ __forceinline__
typedef unsigned short bf16;
typedef float f32x4 __attribute__((ext_vector_type(4)));
typedef float f32x16 __attribute__((ext_vector_type(16)));
typedef float f32x2 __attribute__((ext_vector_type(2)));
typedef short bf16x8 __attribute__((ext_vector_type(8)));
typedef short s16x4 __attribute__((ext_vector_type(4)));
typedef __bf16 bf16x2_t __attribute__((ext_vector_type(2)));
typedef unsigned u32x4 __attribute__((ext_vector_type(4)));
typedef unsigned u32x2 __attribute__((ext_vector_type(2)));

constexpr int NT = 16384, DM = 1024, SEQ = 4096, NB = 4;
constexpr int NWAVES = 8, NTHREADS = 512;
constexpr int LDS_BYTES = 147456, RING_BYTES = 131072, LDSX_OFF = RING_BYTES;
constexpr int MISC_OFF = LDSX_OFF + 320;
constexpr int TEXP_OFF = LDSX_OFF + 1024;
constexpr float LN_EPS = 1e-5f;
constexpr float ALPHA = 1.189207115002721f;

constexpr size_t MiB = 1u << 20;
constexpr size_t WS_CTL = 0, CTL_ZERO_BYTES = (PROF ? 1024 : 128) * 1024;
constexpr size_t WS_MOD = 1 * MiB;
constexpr size_t WS_DEC = 1 * MiB + 112 * 1024;
constexpr size_t WS_WROUT = 1 * MiB + 128 * 1024;
constexpr size_t WS_WAT = 2 * MiB, WS_WRT = 3 * MiB, WS_WOT = 7 * MiB;
constexpr size_t WS_LSE = 9 * MiB;
constexpr size_t WS_ROUTE = 10 * MiB;
constexpr int NTP = NT + 576;
constexpr size_t WS_RQ = 12 * MiB, WS_RK = 44 * MiB, WS_RG = 76 * MiB, WS_RVT = 140 * MiB, WS_KFT = 207 * MiB, WS_KBT = 241 * MiB, WS_Y = 275 * MiB;
constexpr size_t WS_AQ = 12 * MiB, WS_O0 = 60 * MiB, WS_AK = 140 * MiB, WS_AVT = 188 * MiB, WS_GA = 238 * MiB, WS_GR = 270 * MiB, WS_O1 = 302 * MiB, WS_O2 = 318 * MiB;
constexpr size_t WS_ATTMIX = 12 * MiB, WS_MERGED = 28 * MiB, WS_W13T = 140 * MiB, WS_W2T = 204 * MiB;
constexpr size_t WS_U2 = 238 * MiB, WS_XG = 12 * MiB, WS_HDN = 92 * MiB, WS_YROWS = 238 * MiB;
constexpr size_t WS_END = 339 * MiB;
static_assert((size_t)2048 * NTP * 2 <= 67 * MiB && (size_t)1024 * NTP * 2 <= 34 * MiB && (size_t)1536 * NTP * 2 <= 50 * MiB, "padded transposed tensors fit their regions");
constexpr size_t OUT_U = 0, OUT_WINT = 32 * MiB;
constexpr int CW_BAR = 4096;
constexpr int CW_CNT = 16384;
constexpr int CW_RANK = 20480;

constexpr int C_AQ = 0, C_AK = 1536, C_AV = 3072, C_RQ = 4608, C_RK = 5632, C_RV = 6656, C_RGT = 8704, C_GA = 10752, C_GR = 11776, C_END = 12800;

#define LDS_WAIT() asm volatile("s_waitcnt lgkmcnt(0)" ::: "memory")
#define VM_WAIT() asm volatile("s_waitcnt vmcnt(0)" ::: "memory")
DI unsigned pk2(float lo, float hi) { f32x2 v = {lo, hi}; bf16x2_t r = __builtin_convertvector(v, bf16x2_t); return __builtin_bit_cast(unsigned, r); }
DI float bf2f(unsigned short b) { return __builtin_bit_cast(float, (unsigned)b << 16); }
DI float bflo(unsigned w) { return __builtin_bit_cast(float, w << 16); }
DI float bfhi(unsigned w) { return __builtin_bit_cast(float, w & 0xffff0000u); }
DI float wave_sum(float v) {
#pragma unroll
    for (int o = 1; o < 64; o <<= 1) v += __shfl_xor(v, o);
    return v;
}
DI float sigmoidf_(float x) { return 1.f / (1.f + __expf(-x)); }
DI float log2_sigmoid(float x) { return -log1pf(expf(-x)) * 1.4426950408889634f; }
#define MFMA32(a, b, c) __builtin_amdgcn_mfma_f32_32x32x16_bf16((a), (b), (c), 0, 0, 0)
DI int crow(int reg, int h) { return (reg & 3) + 8 * (reg >> 2) + 4 * h; }
DI bf16x8 pack_step(const f32x16& x, int s) {
    u32x4 p; p[0] = pk2(x[8 * s], x[8 * s + 1]); p[1] = pk2(x[8 * s + 2], x[8 * s + 3]); p[2] = pk2(x[8 * s + 4], x[8 * s + 5]); p[3] = pk2(x[8 * s + 6], x[8 * s + 7]);
    return __builtin_bit_cast(bf16x8, p);
}
DI bf16x8 ld16(const bf16* p) { return *(const bf16x8*)p; }
DI bf16x8 ld8x2(const bf16* p0, const bf16* p1) { const s16x4 a = *(const s16x4*)p0, b = *(const s16x4*)p1; return __builtin_shufflevector(a, b, 0, 1, 2, 3, 4, 5, 6, 7); }
DI size_t blk_off(int row, int k, int kblocks) { return ((size_t)(row >> 5) * kblocks + (k >> 4)) * 512 + ((k >> 3) & 1) * 256 + (row & 31) * 8; }
DI f32x16 zero16() { f32x16 z; for (int i = 0; i < 16; ++i) z[i] = 0.f; return z; }

#define XB_TMO      128
#define XB_XCNT(j)  (256  + 64 * (j))
#define XB_XSUB(j)  (1280 + 64 * (j))
#define XB_XGEN(j)  (2304 + 64 * (j))
#define XB_TOP      3328
#define XB_TOPGEN   3392
#define XCD_BAR_WORDS 3456
#define XB_SPIN_CAP (1u << 18)
DI unsigned xb_ld(unsigned* p)              { return __hip_atomic_load(p, __ATOMIC_RELAXED, __HIP_MEMORY_SCOPE_AGENT); }
DI unsigned xb_add(unsigned* p, unsigned v) { return __hip_atomic_fetch_add(p, v, __ATOMIC_RELAXED, __HIP_MEMORY_SCOPE_AGENT); }
DI unsigned xb_xcc_id() { return (unsigned)__builtin_amdgcn_s_getreg((3 << 11) | 20) & 0xFu; }
#define XB_SPIN(cond, bar) do { unsigned _sp = 0; while (cond) { __builtin_amdgcn_s_sleep(1); \
    if ((++_sp & 255u) == 0u) { if (xb_ld(&(bar)[XB_TMO])) break; if (_sp > XB_SPIN_CAP) { atomicAdd(&(bar)[XB_TMO], 1u); break; } } } } while (0)
struct XcdBarrier { unsigned* bar; unsigned x; volatile LAS unsigned* st; };
DI XcdBarrier xcd_barrier_post(unsigned* bar, volatile LAS unsigned* st) {
    XcdBarrier b; b.bar = bar; b.x = xb_xcc_id(); b.st = st;
    if (threadIdx.x == 0) (void)xb_add(&bar[XB_XCNT(b.x)], 1u);
    return b;
}
DI void xcd_barrier_complete(unsigned* bar, unsigned x, unsigned& nloc, unsigned& nx) {
    const unsigned G = gridDim.x * gridDim.y * gridDim.z;
    unsigned sum, cnt, mine, sp = 0u;
    for (;;) {
        sum = 0u; cnt = 0u; mine = 0u;
#pragma unroll
        for (unsigned j = 0; j < 16; ++j) { const unsigned c = xb_ld(&bar[XB_XCNT(j)]); sum += c; cnt += (c > 0u) ? 1u : 0u; mine = (j == x) ? c : mine; }
        if (sum == G) break;
        __builtin_amdgcn_s_sleep(1);
        if ((++sp & 255u) == 0u) { if (xb_ld(&bar[XB_TMO])) break; if (sp > XB_SPIN_CAP) { atomicAdd(&bar[XB_TMO], 1u); break; } }
    }
    nloc = mine > 0u ? mine : 1u; nx = cnt > 0u ? cnt : 1u;
}
DI void xcd_barrier(const XcdBarrier& b) {
    asm volatile("s_waitcnt vmcnt(0)" ::: "memory");
    __syncthreads();
    if (threadIdx.x == 0) {
        unsigned* bar = b.bar;
        __builtin_amdgcn_s_waitcnt(0);
        unsigned nloc = b.st[0], nx = b.st[1];
        if (nloc == 0u) { xcd_barrier_complete(bar, b.x, nloc, nx); b.st[0] = nloc; b.st[1] = nx; }
        const unsigned old = xb_add(&bar[XB_XSUB(b.x)], 1u);
        const unsigned gen = old / nloc;
        if (old + 1u == (gen + 1u) * nloc) {
            __builtin_amdgcn_fence(__ATOMIC_RELEASE, "agent");
            asm volatile("s_waitcnt vmcnt(0)" ::: "memory");
            const unsigned og = xb_add(&bar[XB_TOP], 1u);
            const unsigned tg = og / nx;
            if (og + 1u == (tg + 1u) * nx) xb_add(&bar[XB_TOPGEN], 1u);
            else XB_SPIN(xb_ld(&bar[XB_TOPGEN]) == tg, bar);
            __builtin_amdgcn_fence(__ATOMIC_ACQUIRE, "agent");
            xb_add(&bar[XB_XGEN(b.x)], 1u);
            asm volatile("s_waitcnt vmcnt(0)" ::: "memory");
        } else {
            XB_SPIN(xb_ld(&bar[XB_XGEN(b.x)]) == gen, bar);
            __builtin_amdgcn_fence(__ATOMIC_ACQUIRE, "agent");
            asm volatile("s_waitcnt vmcnt(0)" ::: "memory");
        }
    }
    __syncthreads();
}

namespace pg8 {
#define PG8_LAS __attribute__((address_space(3)))
constexpr int BM = 256, BK = 64, HALF = 128, HTB = HALF * BK * 2, STAGE_BYTES = 8 * HTB, NXCD = 8, WGM = 8;
__host__ __device__ __forceinline__ int lds_byte(int r, int c) { const int st = (r >> 4) * 2 + (c >> 5), rr = r & 15, cc = c & 31, ob = rr * 64 + cc * 2; return st * 1024 + (ob ^ (((ob >> 9) & 1) << 5)); }
__host__ __device__ __forceinline__ void stage_rc(int b, int& R, int& C) { const int st = b / 1024, sb = b % 1024, swz = sb ^ (((sb >> 9) & 1) << 5); R = (st >> 1) * 16 + swz / 64; C = (st & 1) * 32 + (swz % 64) / 2; }
__host__ __device__ __forceinline__ int perm32(int rho) { const int n = rho >> 4, i = rho & 15; return 8 * (i >> 2) + 4 * n + (i & 3); }
struct Unit { int pm, pn; };
struct StaticOrder {
    int nM, nN, nwg, G, c;
    __host__ __device__ void init(int nM_, int nN_, int G_, int c_) { nM = nM_; nN = nN_; nwg = nM * nN; G = G_; c = c_; }
    __host__ __device__ bool next(int i, Unit& u) const {
        const long L = (long)i * G + c; if (c < 0 || L >= nwg) return false;
        int wgid = (int)L; { const int q = nwg / NXCD, r = nwg % NXCD, xcd = wgid % NXCD, off = wgid / NXCD; wgid = (xcd < r ? xcd * (q + 1) : r * (q + 1) + (xcd - r) * q) + off; }
        const int nig = WGM * nN, gid = wgid / nig, fm = gid * WGM, gsz = (nM - fm) < WGM ? (nM - fm) : WGM;
        u.pm = fm + ((wgid % nig) % gsz); u.pn = (wgid % nig) / gsz; return true;
    }
};
template <class F> struct EpiV {
    F f;
    __device__ __forceinline__ void operator()(const f32x4 (&acc)[2][2][4][2], const Unit& u, int wr, int wc, int fr, int fq) const {
        const int row0 = u.pm * BM + wr * 64 + fr, col0 = u.pn * BM + wc * 32 + 8 * fq;
#pragma unroll
        for (int ai = 0; ai < 2; ++ai)
#pragma unroll
            for (int m = 0; m < 4; ++m)
#pragma unroll
                for (int bj = 0; bj < 2; ++bj) f(row0 + ai * HALF + m * 16, col0 + bj * HALF, acc[ai][bj][m][0], acc[ai][bj][m][1]);
    }
};
template <class Epi, class Sched, bool ALIGN_EPI = false>
__device__ __forceinline__ void gemm_phase(PG8_LAS unsigned char* lds, const int K, const int lda, const int ldb, const Sched& S, const Epi& E) {
    int tid_ = threadIdx.x; asm volatile("" : "+v"(tid_));
    const int tid = tid_, wid = __builtin_amdgcn_readfirstlane(tid >> 6), lane = tid & 63, wr = wid >> 2, wc = wid & 3, fr = lane & 15, fq = lane >> 4;
    const int nt = K / BK;
    unsigned voffA[2], voffB[2];
#pragma unroll
    for (int i = 0; i < 2; ++i) { int R, C; stage_rc(tid * 16 + i * 8192, R, C); const int Rb = (R & ~31) + perm32(R & 31);
        voffA[i] = (unsigned)(R * lda + C) * 2u; voffB[i] = (unsigned)(Rb * ldb + C) * 2u; }
    const size_t kstep = (size_t)(BK * 2);
    const size_t hstepA = (size_t)HALF * lda * 2, hstepB = (size_t)HALF * ldb * 2;
    const unsigned ldsw = (unsigned)wid * 1024u;
    const int aoff = lds_byte(wr * 64 + fr, fq * 8), boff = lds_byte(wc * 32 + fr, fq * 8);
#define PG8_SA(b, h) (((b) * 2 + (h)) * HTB)
#define PG8_SB(b, h) ((4 + (b) * 2 + (h)) * HTB)
#define PG8_STAGE(bufoff, gbase, voff) do { _Pragma("unroll") for (int _i = 0; _i < 2; ++_i) \
        __builtin_amdgcn_global_load_lds((const unsigned*)((const char*)(gbase) + (voff)[_i]), (PG8_LAS unsigned*)(lds + (bufoff) + ldsw + _i * 8192), 16, 0, 0); } while (0)
#define PG8_LDA(dst, b, h) do { _Pragma("unroll") for (int m = 0; m < 4; ++m) _Pragma("unroll") for (int k = 0; k < 2; ++k) dst[m][k] = *(const PG8_LAS bf16x8*)(lds + PG8_SA(b, h) + aoff + m * 2048 + k * 1024); } while (0)
#define PG8_LDB(dst, b, h) do { _Pragma("unroll") for (int n = 0; n < 2; ++n) _Pragma("unroll") for (int k = 0; k < 2; ++k) dst[n][k] = *(const PG8_LAS bf16x8*)(lds + PG8_SB(b, h) + boff + n * 2048 + k * 1024); } while (0)
#define PG8_MMA(ai, bj, At, Bt) do { __builtin_amdgcn_s_setprio(1); _Pragma("unroll") for (int m = 0; m < 4; ++m) _Pragma("unroll") for (int n = 0; n < 2; ++n) _Pragma("unroll") for (int k = 0; k < 2; ++k) \
        acc[ai][bj][m][n] = __builtin_amdgcn_mfma_f32_16x16x32_bf16(Bt[n][k], At[m][k], acc[ai][bj][m][n], 0, 0, 0); __builtin_amdgcn_s_setprio(0); } while (0)
#define PG8_WAIT_V(n) asm volatile("s_waitcnt vmcnt(" #n ")" ::: "memory")
#define PG8_WAIT_L(n) asm volatile("s_waitcnt lgkmcnt(" #n ")" ::: "memory")
#define PG8_BAR __builtin_amdgcn_s_barrier()
#define PG8_SCHED __builtin_amdgcn_sched_barrier(0)
    Unit cur, nxt; int ui = 0;
    if (!S.next(0, cur)) return;
    f32x4 acc[2][2][4][2];
#pragma unroll
    for (int a = 0; a < 2; ++a)
#pragma unroll
        for (int b = 0; b < 2; ++b)
#pragma unroll
            for (int m = 0; m < 4; ++m)
#pragma unroll
                for (int n = 0; n < 2; ++n) acc[a][b][m][n] = (f32x4){0.f, 0.f, 0.f, 0.f};
    bf16x8 At[4][2], B0[2][2], B1[2][2];
    const char* cA = S.a_base(cur); const char* cB = S.b_base(cur);
    PG8_STAGE(PG8_SB(0, 0), cB, voffB); PG8_STAGE(PG8_SB(0, 1), cB + hstepB, voffB); PG8_STAGE(PG8_SA(0, 0), cA, voffA); PG8_STAGE(PG8_SA(0, 1), cA + hstepA, voffA);
    if (wr == 1) PG8_BAR;
    PG8_WAIT_V(2); PG8_BAR;
    PG8_STAGE(PG8_SB(1, 0), cB + kstep, voffB); PG8_STAGE(PG8_SA(1, 0), cA + kstep, voffA); PG8_STAGE(PG8_SB(1, 1), cB + hstepB + kstep, voffB);
    PG8_WAIT_V(6); PG8_BAR;
    for (;;) {
        const bool has_next = S.next(ui + 1, nxt);
        const char* nA = has_next ? S.a_base(nxt) : cA; const char* nB = has_next ? S.b_base(nxt) : cB;
        for (int t = 0; t < nt; t += 2) {
            const bool last = (t == nt - 2);
            const char* a1 = cA + (size_t)(t + 1) * kstep;
            const char* a2 = last ? nA : cA + (size_t)(t + 2) * kstep; const char* b2 = last ? nB : cB + (size_t)(t + 2) * kstep;
            const char* a3 = a2 + kstep; const char* b3 = b2 + kstep;
            PG8_LDB(B0, 0, 0); PG8_LDB(B1, 0, 1); PG8_SCHED; PG8_LDA(At, 0, 0); PG8_STAGE(PG8_SA(1, 1), a1 + hstepA, voffA);
            PG8_WAIT_V(8); PG8_WAIT_L(0); PG8_BAR; PG8_MMA(0, 0, At, B0); PG8_MMA(0, 1, At, B1); PG8_BAR; PG8_SCHED;
            PG8_LDA(At, 0, 1); PG8_STAGE(PG8_SB(0, 0), b2, voffB); PG8_STAGE(PG8_SB(0, 1), b2 + hstepB, voffB); PG8_STAGE(PG8_SA(0, 0), a2, voffA);
            PG8_WAIT_V(8); PG8_WAIT_L(0); PG8_BAR; PG8_MMA(1, 0, At, B0); PG8_MMA(1, 1, At, B1); PG8_BAR; PG8_SCHED;
            PG8_LDB(B0, 1, 0); PG8_LDB(B1, 1, 1); PG8_SCHED; PG8_LDA(At, 1, 0); PG8_STAGE(PG8_SA(0, 1), a2 + hstepA, voffA);
            PG8_WAIT_V(8); PG8_WAIT_L(0); PG8_BAR; PG8_MMA(0, 0, At, B0); PG8_MMA(0, 1, At, B1); PG8_BAR; PG8_SCHED;
            PG8_LDA(At, 1, 1); PG8_STAGE(PG8_SB(1, 0), b3, voffB); PG8_STAGE(PG8_SB(1, 1), b3 + hstepB, voffB); PG8_STAGE(PG8_SA(1, 0), a3, voffA);
            PG8_WAIT_V(8); PG8_WAIT_L(0); PG8_BAR; PG8_MMA(1, 0, At, B0); PG8_MMA(1, 1, At, B1); PG8_BAR; PG8_SCHED;
        }
        if constexpr (ALIGN_EPI) { if (wr == 0) PG8_BAR; }
        E(acc, cur, wr, wc, fr, fq);
        if (!has_next) break;
#pragma unroll
        for (int a = 0; a < 2; ++a)
#pragma unroll
            for (int b = 0; b < 2; ++b)
#pragma unroll
                for (int m = 0; m < 4; ++m)
#pragma unroll
                    for (int n = 0; n < 2; ++n) acc[a][b][m][n] = (f32x4){0.f, 0.f, 0.f, 0.f};
        cur = nxt; cA = nA; cB = nB; ++ui;
        if constexpr (ALIGN_EPI) { if (wr == 1) PG8_BAR; }
    }
    PG8_WAIT_V(0);
    if constexpr (!ALIGN_EPI) { if (wr == 0) PG8_BAR; }
    PG8_BAR;
#undef PG8_SA
#undef PG8_SB
#undef PG8_STAGE
#undef PG8_LDA
#undef PG8_LDB
#undef PG8_MMA
#undef PG8_WAIT_V
#undef PG8_WAIT_L
#undef PG8_BAR
#undef PG8_SCHED
}
}

struct Frame {
    LAS unsigned char* lds;
    int tid, lane, wave, G, vcu, bx;
    unsigned char* ws; unsigned char* outb;
    const float* in[22];
};
struct Args { const float* in[22]; float* out; unsigned char* ws; };
DI int opaque_lane(const Frame& F) { int l = F.lane; asm volatile("" : "+v"(l)); return l; }

template <class RowMap>
DI void transpose_item(const float* W, int K, int N, bf16* WT, RowMap orow, LAS float* scr, int item, int lane) {
    const int nblk = N / 32, kb = item / nblk, nb = item % nblk, k0 = 64 * kb, n0 = 32 * nb;
#pragma unroll 8
    for (int i = 0; i < 32; ++i) { const int kk = 2 * i + (lane >> 5); scr[kk * 33 + (lane & 31)] = W[(size_t)(k0 + kk) * N + n0 + (lane & 31)]; }
    LDS_WAIT(); asm volatile("" ::: "memory");
    const int c = lane & 7;
#pragma unroll
    for (int j = 0; j < 4; ++j) { const int n = (lane >> 3) + 8 * j; const LAS float* s = scr + (8 * c) * 33 + n;
        u32x4 o; o.x = pk2(s[0 * 33], s[1 * 33]); o.y = pk2(s[2 * 33], s[3 * 33]); o.z = pk2(s[4 * 33], s[5 * 33]); o.w = pk2(s[6 * 33], s[7 * 33]);
        *(u32x4*)(WT + (size_t)orow(n0 + n) * K + k0 + 8 * c) = o; }
    LDS_WAIT(); asm volatile("" ::: "memory");
}
struct RowId { int off; DI int operator()(int n) const { return off + n; } };
struct RowW13 { int add; DI int operator()(int n) const { return ((n >> 2) << 3) + (n & 3) + add; } };

DI void phase0(Frame& F) {
    const int lane_ = F.lane;
    const float* c = F.in[1]; const float* w_ada = F.in[2]; const float* b_ada = F.in[3];
    float* MOD = (float*)(F.ws + WS_MOD);
    if (F.bx < 96) {
        const int j = F.bx * 64 + lane_;
        float a0 = 0.f, a1 = 0.f, a2 = 0.f, a3 = 0.f;
        const int k0 = F.wave * 128;
#pragma unroll 8
        for (int k = k0; k < k0 + 128; ++k) { const float w = w_ada[(size_t)k * 6144 + j]; a0 += c[k] * w; a1 += c[1024 + k] * w; a2 += c[2048 + k] * w; a3 += c[3072 + k] * w; }
        LAS float* red = (LAS float*)F.lds;
        red[(F.wave * 4 + 0) * 64 + lane_] = a0; red[(F.wave * 4 + 1) * 64 + lane_] = a1; red[(F.wave * 4 + 2) * 64 + lane_] = a2; red[(F.wave * 4 + 3) * 64 + lane_] = a3;
        __syncthreads();
        if (F.tid < 256) { const int b = F.tid >> 6, l = F.tid & 63; float s = b_ada[F.bx * 64 + l];
#pragma unroll
            for (int w = 0; w < 8; ++w) s += red[(w * 4 + b) * 64 + l];
            MOD[b * 6144 + F.bx * 64 + l] = s; }
        __syncthreads();
    }
    if (F.bx == 0 && F.tid < 8) ((float*)(F.ws + WS_DEC))[F.tid] = log2_sigmoid(F.tid < 4 ? F.in[6][F.tid] : F.in[7][F.tid - 4]);
    { const int gid = F.bx * NTHREADS + F.tid;
      if (gid < 36 * 1024) { const int o = gid >> 10, k = gid & 1023; float v;
          if (o < 4) v = F.in[13][k * 4 + o]; else { const int g = (o - 4) >> 3, e = (o - 4) & 7; v = F.in[15][((size_t)g * 1024 + k) * 8 + e]; }
          ((float*)(F.ws + WS_WROUT))[gid] = v; } }
    LAS float* scr = (LAS float*)(F.lds + 16384 + F.wave * 12288);
    const int gw = F.bx * NWAVES + F.wave, NGW = F.G * NWAVES;
    constexpr int I_IN = 16 * 400, I_A = 8 * 32, I_R = 32 * 32, I_O = 16 * 32;
    for (int it = gw; it < I_IN + I_A + I_R + I_O; it += NGW) {
        int r = it;
        if (r < I_IN) { transpose_item(F.in[4], 1024, C_END, (bf16*)(F.outb + OUT_WINT), RowId{0}, scr, r, lane_); continue; } r -= I_IN;
        if (r < I_A) { transpose_item(F.in[5], 512, 1024, (bf16*)(F.ws + WS_WAT), RowId{0}, scr, r, lane_); continue; } r -= I_A;
        if (r < I_R) { transpose_item(F.in[9], 2048, 1024, (bf16*)(F.ws + WS_WRT), RowId{0}, scr, r, lane_); continue; } r -= I_R;
        transpose_item(F.in[10], 1024, 1024, (bf16*)(F.ws + WS_WOT), RowId{0}, scr, r, lane_);
    }
}
DI void moe_weight_transposes(Frame& F) {
    const int lane_ = F.lane;
    LAS float* scr = (LAS float*)(F.lds + 16384 + F.wave * 12288);
    const int gw = F.bx * NWAVES + F.wave, NGW = F.G * NWAVES;
    bf16* W13T = (bf16*)(F.ws + WS_W13T); bf16* W2T = (bf16*)(F.ws + WS_W2T);
    for (int it = gw; it < 3 * 8192; it += NGW) {
        const int which = it >> 13, r = it & 8191, e = r >> 8, item = r & 255;
        if (which == 0) transpose_item(F.in[17] + (size_t)e * 1024 * 512, 1024, 512, W13T + (size_t)e * 1024 * 1024, RowW13{0}, scr, item, lane_);
        else if (which == 1) transpose_item(F.in[18] + (size_t)e * 1024 * 512, 1024, 512, W13T + (size_t)e * 1024 * 1024, RowW13{4}, scr, item, lane_);
        else transpose_item(F.in[19] + (size_t)e * 512 * 1024, 512, 1024, W2T + (size_t)e * 1024 * 512, RowId{0}, scr, item, lane_);
    }
}

DI void phase1(Frame& F) {
    const int lane_ = opaque_lane(F);
    const float* x = F.in[0]; const float* MOD = (const float*)(F.ws + WS_MOD); bf16* U = (bf16*)(F.outb + OUT_U);
    const int gw = F.bx * NWAVES + F.wave, NGW = F.G * NWAVES;
    for (int m = gw; m < NT; m += NGW) {
        const f32x4* xr = (const f32x4*)(x + (size_t)m * DM) + lane_; const int b = m >> 12;
        f32x4 v[4]; float s = 0.f;
#pragma unroll
        for (int j = 0; j < 4; ++j) { v[j] = xr[64 * j]; s += (v[j].x + v[j].y) + (v[j].z + v[j].w); }
        const float mean = wave_sum(s) * (1.f / DM); float s2 = 0.f;
#pragma unroll
        for (int j = 0; j < 4; ++j) { v[j] = v[j] - mean; s2 += (v[j].x * v[j].x + v[j].y * v[j].y) + (v[j].z * v[j].z + v[j].w * v[j].w); }
        const float rstd = 1.f / sqrtf(wave_sum(s2) * (1.f / DM) + LN_EPS);
        u32x2* o8 = (u32x2*)(U + (size_t)m * DM) + lane_;
#pragma unroll
        for (int j = 0; j < 4; ++j) { const int col = 256 * j + 4 * lane_;
            const f32x4 sh = *(const f32x4*)(MOD + b * 6144 + col), sc = *(const f32x4*)(MOD + b * 6144 + 1024 + col);
            const f32x4 u = v[j] * rstd * (sc + 1.f) + sh;
            u32x2 w; w.x = pk2(u.x, u.y); w.y = pk2(u.z, u.w); o8[64 * j] = w; }
    }
}

DI u32x4 pack8(f32x4 v0, f32x4 v1) { u32x4 w; w.x = pk2(v0[0], v0[1]); w.y = pk2(v0[2], v0[3]); w.z = pk2(v1[0], v1[1]); w.w = pk2(v1[2], v1[3]); return w; }

struct SchedR1 : pg8::StaticOrder { const char* U; const char* W;
    DI const char* a_base(const pg8::Unit& u) const { return U + (size_t)u.pm * 256 * 2048; }
    DI const char* b_base(const pg8::Unit& u) const { const int r = u.pn < 8 ? C_RQ + 256 * u.pn : C_RGT + 256 * (u.pn - 8); return W + (size_t)r * 2048; } };
struct EpiR1 { bf16 *RQ, *RK, *RG;
    DI void operator()(int row, int col, f32x4 v0, f32x4 v1) const {
        if (col < 1024) *(u32x4*)(RQ + blk_off(row, col, 64)) = pack8(v0, v1);
        else if (col < 2048) *(u32x4*)(RK + blk_off(row, col - 1024, 64)) = pack8(v0 * 0.0625f, v1 * 0.0625f);
        else *(u32x4*)(RG + (size_t)row * 2048 + col - 2048) = pack8(v0, v1); } };
struct SchedR2 : pg8::StaticOrder { const char* U; const char* W;
    DI const char* a_base(const pg8::Unit& u) const { const int r = u.pm < 8 ? C_RV + 256 * u.pm : C_RK + 256 * (u.pm - 8); return W + (size_t)r * 2048; }
    DI const char* b_base(const pg8::Unit& u) const { return U + (size_t)u.pn * 256 * 2048; } };
struct EpiR2 { bf16 *RVT, *KFT, *KBT; const float* DEC;
    DI void operator()(int row, int col, f32x4 v0, f32x4 v1) const {
        if (row < 2048) { *(u32x4*)(RVT + blk_off(row, col, 1024)) = pack8(v0, v1); return; }
        const int f = row - 2048, h = f >> 8; const float p0 = (float)(col & 127);
        const float a = DEC[h], b = DEC[4 + h];
        f32x4 kf0, kf1, kb0, kb1;
#pragma unroll
        for (int e = 0; e < 4; ++e) {
            const float pa = p0 + (float)e, pb = p0 + (float)(e + 4);
            kf0[e] = v0[e] * 0.0625f * __builtin_amdgcn_exp2f(a * (127.f - pa)); kf1[e] = v1[e] * 0.0625f * __builtin_amdgcn_exp2f(a * (127.f - pb));
            kb0[e] = v0[e] * 0.0625f * __builtin_amdgcn_exp2f(b * pa);           kb1[e] = v1[e] * 0.0625f * __builtin_amdgcn_exp2f(b * pb); }
        *(u32x4*)(KFT + blk_off(f, col, 1024)) = pack8(kf0, kf1);
        *(u32x4*)(KBT + blk_off(f, col, 1024)) = pack8(kb0, kb1); } };
struct SchedQK : pg8::StaticOrder { const char* U; const char* W; int g, r, nsub;
    DI const char* a_base(const pg8::Unit& u) const { const int b = u.pm >> 4, v0 = (u.pm & 15) * 256, rho = v0 / nsub, i0 = v0 % nsub; return U + (size_t)(b * SEQ + rho + r * i0) * 2048; }
    DI const char* b_base(const pg8::Unit& u) const { const int rw = (u.pn < 2 ? C_AQ : C_AK) + 512 * g + 256 * (u.pn & 1); return W + (size_t)rw * 2048; } };
struct EpiQK { bf16 *AQ, *AK;
    DI void operator()(int row, int col, f32x4 v0, f32x4 v1) const {
        if (col < 512) *(u32x4*)(AQ + blk_off(row, col, 32)) = pack8(v0, v1);
        else *(u32x4*)(AK + blk_off(row, col - 512, 32)) = pack8(v0, v1); } };
struct SchedGate : pg8::StaticOrder { const char* U; const char* W;
    DI const char* a_base(const pg8::Unit& u) const { return U + (size_t)u.pm * 256 * 2048; }
    DI const char* b_base(const pg8::Unit& u) const { return W + (size_t)(C_GA + 256 * u.pn) * 2048; } };
struct EpiGate { bf16 *GA, *GR;
    DI void operator()(int row, int col, f32x4 v0, f32x4 v1) const {
        f32x4 s0, s1;
#pragma unroll
        for (int e = 0; e < 4; ++e) { s0[e] = sigmoidf_(v0[e]); s1[e] = sigmoidf_(v1[e]); }
        bf16* dst = col < 1024 ? GA + (size_t)row * 1024 + col : GR + (size_t)row * 1024 + col - 1024;
        *(u32x4*)dst = pack8(s0, s1); } };
struct SchedA2 : pg8::StaticOrder { const char* U; const char* W; int g, r, nsub;
    DI const char* a_base(const pg8::Unit& u) const { return W + (size_t)(C_AV + 512 * g + 256 * u.pm) * 2048; }
    DI const char* b_base(const pg8::Unit& u) const { const int b = u.pn >> 4, v0 = (u.pn & 15) * 256, rho = v0 / nsub, i0 = v0 % nsub; return U + (size_t)(b * SEQ + rho + r * i0) * 2048; } };
struct EpiA2 { bf16* AVT;
    DI void operator()(int row, int col, f32x4 v0, f32x4 v1) const { *(u32x4*)(AVT + blk_off(row, col, 1024)) = pack8(v0, v1); } };
struct SchedG : pg8::StaticOrder { const char* A; const char* B; size_t abytes, bbytes;
    DI const char* a_base(const pg8::Unit& u) const { return A + (size_t)u.pm * abytes; }
    DI const char* b_base(const pg8::Unit& u) const { return B + (size_t)u.pn * bbytes; } };
struct EpiG1 { const bf16* GA; bf16* P1;
    DI void operator()(int row, int col, f32x4 v0, f32x4 v1) const {
        const u32x4 g = *(const u32x4*)(GA + (size_t)row * 1024 + col);
        f32x4 o0 = {v0[0] * bflo(g.x), v0[1] * bfhi(g.x), v0[2] * bflo(g.y), v0[3] * bfhi(g.y)}, o1 = {v1[0] * bflo(g.z), v1[1] * bfhi(g.z), v1[2] * bflo(g.w), v1[3] * bfhi(g.w)};
        *(u32x4*)(P1 + (size_t)row * 1024 + col) = pack8(o0, o1); } };
struct EpiG2 { const bf16* GR; const bf16* P1; bf16* MERGED;
    DI void operator()(int row, int col, f32x4 v0, f32x4 v1) const {
        const u32x4 g = *(const u32x4*)(GR + (size_t)row * 1024 + col);
        const u32x4 p = *(const u32x4*)(P1 + (size_t)row * 1024 + col);
        f32x4 o0 = {bflo(p.x) + v0[0] * bflo(g.x), bfhi(p.x) + v0[1] * bfhi(g.x), bflo(p.y) + v0[2] * bflo(g.y), bfhi(p.y) + v0[3] * bfhi(g.y)};
        f32x4 o1 = {bflo(p.z) + v1[0] * bflo(g.z), bfhi(p.z) + v1[1] * bfhi(g.z), bflo(p.w) + v1[2] * bflo(g.w), bfhi(p.w) + v1[3] * bfhi(g.w)};
        *(u32x4*)(MERGED + (size_t)row * 1024 + col) = pack8(o0, o1); } };
struct EpiG3 { const float* x; const float* MOD; float* H;
    DI void operator()(int row, int col, f32x4 v0, f32x4 v1) const {
        const int b = row >> 12; const float* gp = MOD + b * 6144 + 2048 + col; const float* xp = x + (size_t)row * 1024 + col;
        const f32x4 g0 = *(const f32x4*)gp, g1 = *(const f32x4*)(gp + 4), x0 = *(const f32x4*)xp, x1 = *(const f32x4*)(xp + 4);
        *(f32x4*)(H + (size_t)row * 1024 + col) = x0 * ALPHA + g0 * v0; *(f32x4*)(H + (size_t)row * 1024 + col + 4) = x1 * ALPHA + g1 * v1; } };
struct SchedM : pg8::StaticOrder { const char* A; const char* B; size_t abytes, ebytes, bbytes; const LAS int* texp;
    DI const char* a_base(const pg8::Unit& u) const { return A + (size_t)u.pm * abytes; }
    DI const char* b_base(const pg8::Unit& u) const { return B + (size_t)texp[u.pm] * ebytes + (size_t)u.pn * bbytes; } };
struct EpiM3 { bf16* HDN;
    DI void operator()(int row, int col, f32x4 a, f32x4 b) const {
        f32x4 o;
#pragma unroll
        for (int e = 0; e < 4; ++e) o[e] = a[e] * sigmoidf_(a[e]) * b[e];
        u32x2 w; w.x = pk2(o[0], o[1]); w.y = pk2(o[2], o[3]);
        *(u32x2*)(HDN + (size_t)row * 512 + (col >> 1)) = w; } };
struct EpiM4 { bf16* Y;
    DI void operator()(int row, int col, f32x4 v0, f32x4 v1) const { *(u32x4*)(Y + (size_t)row * 1024 + col) = pack8(v0, v1); } };

DI void ret_intra(Frame& F) {
    const int lane_ = F.lane;
    const bf16* RQ = (const bf16*)(F.ws + WS_RQ); const bf16* RK = (const bf16*)(F.ws + WS_RK); const bf16* RVT = (const bf16*)(F.ws + WS_RVT); bf16* Y = (bf16*)(F.ws + WS_Y);
    const float* DEC = (const float*)(F.ws + WS_DEC);
    const int r = lane_ & 31, h = lane_ >> 5;
    const int gw = F.vcu * NWAVES + F.wave, NGW = F.G * NWAVES;
    for (int it = gw; it < 4096; it += NGW) {
        const int dh = it & 1, ntl = (it >> 1) & 3, ch = (it >> 3) & 31, hd = (it >> 8) & 3, b = it >> 10;
        const int tok0 = b * SEQ + ch * 128, rb0 = tok0 >> 5;
        const float lf = DEC[hd], lb = DEC[4 + hd];
        f32x16 pT[4]; for (int i = 0; i < 4; ++i) pT[i] = zero16();
        const bf16* qp = RQ + ((size_t)(rb0 + ntl) * 64 + hd * 16) * 512 + lane_ * 8;
        const bf16* kp = RK + ((size_t)rb0 * 64 + hd * 16) * 512 + lane_ * 8;
#pragma unroll 4
        for (int ks = 0; ks < 16; ++ks) {
            const bf16x8 bq = ld16(qp + ks * 512);
#pragma unroll
            for (int mt = 0; mt < 4; ++mt) { const bf16x8 ak = ld16(kp + (size_t)mt * 64 * 512 + ks * 512); pT[mt] = MFMA32(ak, bq, pT[mt]); }
        }
        bf16x8 pb[4][2];
        const int n = 32 * ntl + r;
#pragma unroll
        for (int mt = 0; mt < 4; ++mt) {
#pragma unroll
            for (int i = 0; i < 16; ++i) { const int m = 32 * mt + crow(i, h); const int d = n - m;
                const float w = d >= 0 ? __builtin_amdgcn_exp2f(lf * (float)d) : __builtin_amdgcn_exp2f(lb * (float)(-d));
                pT[mt][i] *= w; }
            pb[mt][0] = pack_step(pT[mt], 0); pb[mt][1] = pack_step(pT[mt], 1);
        }
#pragma unroll 4
        for (int dt = 0; dt < 8; ++dt) {
            const int dv0 = hd * 512 + dh * 256 + dt * 32;
            const bf16* vp = RVT + ((size_t)(dv0 >> 5) * 1024 + (tok0 >> 4)) * 512 + r * 8 + 4 * h;
            f32x16 acc = zero16();
#pragma unroll
            for (int mt = 0; mt < 4; ++mt)
#pragma unroll
                for (int s2 = 0; s2 < 2; ++s2) { const bf16* bp = vp + (2 * mt + s2) * 512; acc = MFMA32(ld8x2(bp, bp + 256), pb[mt][s2], acc); }
            char* yp = (char*)Y + ((((size_t)(b * 4 + hd) * 32 + ch) * 4 + ntl) * 16 + dh * 8 + dt) * 2048 + lane_ * 32;
            u32x4 w0, w1;
            w0.x = pk2(acc[0], acc[1]); w0.y = pk2(acc[2], acc[3]); w0.z = pk2(acc[4], acc[5]); w0.w = pk2(acc[6], acc[7]);
            w1.x = pk2(acc[8], acc[9]); w1.y = pk2(acc[10], acc[11]); w1.z = pk2(acc[12], acc[13]); w1.w = pk2(acc[14], acc[15]);
            *(u32x4*)yp = w0; *(u32x4*)(yp + 16) = w1;
        }
    }
}
#define SBAR_ __builtin_amdgcn_sched_barrier(0)
constexpr int ST_SZ = 16 * 512, VT_SZ = 8 * 512, VT_OFF = 2 * 2 * ST_SZ;
DI bf16x8 ldg16(const char* base, unsigned off) { return *(const bf16x8*)(base + off); }
template <int VAR> DI void ret_scan(Frame& F) {
    const int lane_ = F.lane;
    const int r = lane_ & 31, h = lane_ >> 5, dir = F.wave >> 2, wg = F.wave & 3;
    LAS bf16* ST = (LAS bf16*)F.lds + dir * (2 * ST_SZ);
    LAS bf16* VT = (LAS bf16*)F.lds + VT_OFF + dir * (2 * VT_SZ);
    const unsigned loff = (unsigned)lane_ * 16u;
    const unsigned voff = (unsigned)(wg * 64 + lane_) * 32u;
    for (int unit = F.vcu; unit < 256; unit += F.G) {
        const int sl = unit & 15, hd = (unit >> 4) & 3, b = unit >> 6;
        const float lg = ((const float*)(F.ws + WS_DEC))[4 * dir + hd];
        const float cd = __builtin_amdgcn_exp2f(lg * 128.f);
        const float p = (float)(32 * wg + r);
        const float qd = dir ? __builtin_amdgcn_exp2f(lg * (128.f - p)) : __builtin_amdgcn_exp2f(lg * (p + 1.f));
        const char* qb = (const char*)(F.ws + WS_RQ) + (((size_t)(b * 128 + wg) * 64) + hd * 16) * 1024;
        const char* kb = (const char*)(F.ws + (dir ? WS_KBT : WS_KFT)) + ((size_t)(hd * 8 + 2 * wg) * 1024 + b * 256) * 1024;
        const char* vb = (const char*)(F.ws + WS_RVT) + ((size_t)(hd * 16 + sl) * 1024 + b * 256) * 1024;
        char* yb = VAR == 0 ? (char*)(F.ws + WS_Y) + ((((size_t)(b * 4 + hd) * 32) * 4 + wg) * 16 + sl) * 2048 : (char*)(F.ws + 339 * MiB) + (size_t)unit * 16384 + (dir * 4 + wg) * 2048;
#ifndef SCAN_SKEW
#define SCAN_SKEW 6
#endif
        if (sl != 0) { for (int z = 0; z < SCAN_SKEW; ++z) __builtin_amdgcn_s_sleep(16); }
        bf16x8 Qf[16], Kf0[8], Kf1[8];
        { const int c0 = dir ? 31 : 0, c1 = dir ? 30 : 1;
          const bf16x8 va = ldg16(vb + c0 * 8192, voff), vb2 = ldg16(vb + c0 * 8192, voff + 16);
#pragma unroll
          for (int ks = 0; ks < 8; ++ks) { Kf0[ks] = ldg16(kb + c0 * 8192, loff + 1024 * ks); Kf1[ks] = ldg16(kb + (size_t)1024 * 1024 + c0 * 8192, loff + 1024 * ks); }
#pragma unroll
          for (int ks = 0; ks < 16; ++ks) Qf[ks] = ldg16(qb + (size_t)c1 * 4 * 65536, loff + 1024 * ks);
          *(LAS bf16x8*)((LAS char*)VT + voff) = va; *(LAS bf16x8*)((LAS char*)VT + voff + 16) = vb2; }
        asm volatile("s_waitcnt lgkmcnt(0)" ::: "memory"); __builtin_amdgcn_s_barrier(); asm volatile("" ::: "memory");
        f32x16 S0 = zero16(), S1 = zero16();
        u32x4 yv0 = {0u, 0u, 0u, 0u}, yv1 = {0u, 0u, 0u, 0u};
#pragma unroll
        for (int step = 0; step < 32; ++step) {
            const int ch = dir ? 31 - step : step;
            int chn = dir ? ch - 1 : ch + 1; chn = chn < 0 ? 0 : (chn > 31 ? 31 : chn);
            const int cur = step & 1;
            char* yp = (VAR == 0 ? yb + (size_t)ch * 4 * 16 * 2048 : yb) + lane_ * 32;
            if ((step == 16 || step == 17) && VAR != 2 && VAR != 5) { yv0 = __builtin_nontemporal_load((const u32x4*)yp); yv1 = __builtin_nontemporal_load((const u32x4*)(yp + 16)); }
            if (step == 0 && VAR == 0) { const u32x4 z = {0u, 0u, 0u, 0u}; *(u32x4*)yp = z; *(u32x4*)(yp + 16) = z; }
            SBAR_;
            if (step > 0) {
                const LAS char* sp = (const LAS char*)(ST + cur * ST_SZ) + loff;
                f32x16 acc = zero16();
#pragma unroll
                for (int kg = 0; kg < 8; ++kg) {
                    bf16x8 as[2];
#pragma unroll
                    for (int k = 0; k < 2; ++k) as[k] = *(const LAS bf16x8*)(sp + 1024 * (2 * kg + k));
#pragma unroll
                    for (int k = 0; k < 2; ++k) acc = MFMA32(as[k], Qf[2 * kg + k], acc);
                    SBAR_;
                }
                u32x4 w0, w1;
#pragma unroll
                for (int k = 0; k < 4; ++k) {
                    if (step <= 15) { w0[k] = pk2(acc[2 * k] * qd, acc[2 * k + 1] * qd); w1[k] = pk2(acc[8 + 2 * k] * qd, acc[8 + 2 * k + 1] * qd); }
                    else { w0[k] = pk2(bflo(yv0[k]) + acc[2 * k] * qd, bfhi(yv0[k]) + acc[2 * k + 1] * qd); w1[k] = pk2(bflo(yv1[k]) + acc[8 + 2 * k] * qd, bfhi(yv1[k]) + acc[8 + 2 * k + 1] * qd); } }
                if (VAR == 2 || VAR == 5) asm volatile("" :: "v"(w0.x), "v"(w0.y), "v"(w0.z), "v"(w0.w), "v"(w1.x), "v"(w1.y), "v"(w1.z), "v"(w1.w)); else { *(u32x4*)yp = w0; *(u32x4*)(yp + 16) = w1; }
                SBAR_;
            }
            if (step < 31 && step + 1 >= 18 && VAR != 2 && VAR != 5) {
                const char* ypn = (VAR == 0 ? yb + (size_t)chn * 4 * 16 * 2048 : yb) + lane_ * 32;
                yv0 = __builtin_nontemporal_load((const u32x4*)ypn); yv1 = __builtin_nontemporal_load((const u32x4*)(ypn + 16)); }
            SBAR_;
            if (step > 0 && VAR != 3 && VAR != 5) {
#pragma unroll
                for (int ks = 0; ks < 16; ++ks) Qf[ks] = ldg16(qb + (size_t)chn * 4 * 65536, loff + 1024 * ks);
            }
            SBAR_;
            const bf16x8 vn0 = ldg16(vb + chn * 8192, voff), vn1 = ldg16(vb + chn * 8192, voff + 16);
            if (step < 31) {
#pragma unroll
                for (int i = 0; i < 16; ++i) { S0[i] *= cd; S1[i] *= cd; }
                const LAS char* vp = (const LAS char*)(VT + cur * VT_SZ) + loff;
#pragma unroll
                for (int kg = 0; kg < 2; ++kg) {
                    bf16x8 bv[4];
#pragma unroll
                    for (int k = 0; k < 4; ++k) bv[k] = *(const LAS bf16x8*)(vp + 1024 * (4 * kg + k));
#pragma unroll
                    for (int k = 0; k < 4; ++k) { S0 = MFMA32(Kf0[4 * kg + k], bv[k], S0); S1 = MFMA32(Kf1[4 * kg + k], bv[k], S1); }
                    SBAR_;
                }
                if (VAR != 4 && VAR != 5) {
#pragma unroll
                for (int ks = 0; ks < 8; ++ks) { Kf0[ks] = ldg16(kb + chn * 8192, loff + 1024 * ks); Kf1[ks] = ldg16(kb + (size_t)1024 * 1024 + chn * 8192, loff + 1024 * ks); } }
                SBAR_;
                LAS char* vw = (LAS char*)(VT + (cur ^ 1) * VT_SZ) + voff;
                *(LAS bf16x8*)vw = vn0; *(LAS bf16x8*)(vw + 16) = vn1;
                LAS bf16* wp = ST + (cur ^ 1) * ST_SZ + (4 * wg) * 512 + r * 8 + 4 * h;
#pragma unroll
                for (int g = 0; g < 4; ++g) {
                    u32x2 w0; w0.x = pk2(S0[4 * g], S0[4 * g + 1]); w0.y = pk2(S0[4 * g + 2], S0[4 * g + 3]); *(LAS u32x2*)(wp + (g >> 1) * 512 + (g & 1) * 256) = w0;
                    u32x2 w1; w1.x = pk2(S1[4 * g], S1[4 * g + 1]); w1.y = pk2(S1[4 * g + 2], S1[4 * g + 3]); *(LAS u32x2*)(wp + (2 + (g >> 1)) * 512 + (g & 1) * 256) = w1; }
            }
            if (step >= 12 && step <= 18) asm volatile("s_waitcnt vmcnt(0)" ::: "memory");
            asm volatile("s_waitcnt lgkmcnt(0)" ::: "memory"); __builtin_amdgcn_s_barrier(); asm volatile("" ::: "memory"); SBAR_;
        }
        VM_WAIT();
    }
}
template <bool DRY> DI void ret_norm(Frame& F) {
    const int lane_ = F.lane;
    char* Y = (char*)(F.ws + WS_Y); bf16* RG = (bf16*)(F.ws + WS_RG); bf16* OUTP = DRY ? (bf16*)(F.ws + WS_RQ) : RG; const float* gain = F.in[8];
    const bf16* RQ = (const bf16*)(F.ws + WS_RQ); const bf16* RK = (const bf16*)(F.ws + WS_RK); const bf16* RVT = (const bf16*)(F.ws + WS_RVT);
    const float* DEC = (const float*)(F.ws + WS_DEC);
    const int r = lane_ & 31, h = lane_ >> 5;
    LAS char* T = (LAS char*)F.lds + F.wave * (32 * 272);
    const int gw = F.vcu * NWAVES + F.wave, NGW = F.G * NWAVES;
    for (int it = gw; it < 2048; it += NGW) {
        const int ntl = it & 3, ch = (it >> 2) & 31, hd = (it >> 7) & 3, b = it >> 9;
        char* yp = Y + ((size_t)it * 16) * 2048 + lane_ * 32;
        const int tokc = b * SEQ + ch * 128, rb0 = tokc >> 5;
        const size_t tok0 = (size_t)tokc + 32 * ntl;
        const float lf = DEC[hd], lb = DEC[4 + hd];
        bf16x8 pb[4][2];
        { f32x16 pT[4]; for (int i = 0; i < 4; ++i) pT[i] = zero16();
          const bf16* qp = RQ + ((size_t)(rb0 + ntl) * 64 + hd * 16) * 512 + lane_ * 8;
          const bf16* kp = RK + ((size_t)rb0 * 64 + hd * 16) * 512 + lane_ * 8;
#pragma unroll 4
          for (int ks = 0; ks < 16; ++ks) {
              const bf16x8 bq = ld16(qp + ks * 512);
#pragma unroll
              for (int mt = 0; mt < 4; ++mt) { const bf16x8 ak = ld16(kp + (size_t)mt * 64 * 512 + ks * 512); pT[mt] = MFMA32(ak, bq, pT[mt]); }
          }
          const int n = 32 * ntl + r;
#pragma unroll
          for (int mt = 0; mt < 4; ++mt) {
#pragma unroll
              for (int i = 0; i < 16; ++i) { const int m = 32 * mt + crow(i, h); const int d = n - m;
                  const float w = d >= 0 ? __builtin_amdgcn_exp2f(lf * (float)d) : __builtin_amdgcn_exp2f(lb * (float)(-d));
                  pT[mt][i] *= w; }
              pb[mt][0] = pack_step(pT[mt], 0); pb[mt][1] = pack_step(pT[mt], 1);
          } }
        float s = 0.f, s2 = 0.f;
#pragma unroll 2
        for (int dvt = 0; dvt < 16; ++dvt) {
            const bf16* vp = RVT + ((size_t)(hd * 16 + dvt) * 1024 + (tokc >> 4)) * 512 + r * 8 + 4 * h;
            const u32x4 a = *(const u32x4*)(yp + dvt * 2048), c = *(const u32x4*)(yp + dvt * 2048 + 16);
            f32x16 acc = zero16();
#pragma unroll
            for (int mt = 0; mt < 4; ++mt)
#pragma unroll
                for (int s2i = 0; s2i < 2; ++s2i) { const bf16* bp = vp + (2 * mt + s2i) * 512; acc = MFMA32(ld8x2(bp, bp + 256), pb[mt][s2i], acc); }
            u32x4 wa, wc;
#pragma unroll
            for (int k = 0; k < 4; ++k) { wa[k] = pk2(bflo(a[k]) + acc[2 * k], bfhi(a[k]) + acc[2 * k + 1]); wc[k] = pk2(bflo(c[k]) + acc[8 + 2 * k], bfhi(c[k]) + acc[8 + 2 * k + 1]); }
#pragma unroll
            for (int k = 0; k < 4; ++k) { const float x0 = bflo(wa[k]), x1 = bfhi(wa[k]), x2 = bflo(wc[k]), x3 = bfhi(wc[k]); s += (x0 + x1) + (x2 + x3); s2 += (x0 * x0 + x1 * x1) + (x2 * x2 + x3 * x3); }
            *(u32x4*)(yp + dvt * 2048) = wa; *(u32x4*)(yp + dvt * 2048 + 16) = wc;
        }
        s += __shfl_xor(s, 32); s2 += __shfl_xor(s2, 32);
        const float mean = s * (1.f / 512.f);
        const float var = fmaxf(s2 * (1.f / 512.f) - mean * mean, 0.f);
        const float rstd = 1.f / sqrtf(var + LN_EPS);
        VM_WAIT();
#pragma unroll 1
        for (int grp = 0; grp < 4; ++grp) {
#pragma unroll
            for (int t = 0; t < 4; ++t) {
                const u32x4 a = *(const u32x4*)(yp + (4 * grp + t) * 2048), c = *(const u32x4*)(yp + (4 * grp + t) * 2048 + 16);
                const u32x2 av[4] = {{a.x, a.y}, {a.z, a.w}, {c.x, c.y}, {c.z, c.w}};
#pragma unroll
                for (int q = 0; q < 4; ++q) { u32x2 w; w.x = pk2((bflo(av[q].x) - mean) * rstd, (bfhi(av[q].x) - mean) * rstd); w.y = pk2((bflo(av[q].y) - mean) * rstd, (bfhi(av[q].y) - mean) * rstd);
                    *(LAS u32x2*)(T + r * 272 + (32 * t + 8 * q + 4 * h) * 2) = w; }
            }
            LDS_WAIT(); asm volatile("" ::: "memory");
#pragma unroll
            for (int k = 0; k < 8; ++k) {
                const int task = lane_ + 64 * k, tk = task >> 4, cchunk = task & 15;
                const u32x4 v = *(const LAS u32x4*)(T + tk * 272 + cchunk * 16);
                const int col = hd * 512 + 128 * grp + 8 * cchunk;
                const size_t off = (tok0 + tk) * 2048 + col;
                const u32x4 gwv = *(const u32x4*)(RG + off); const f32x4 ga = *(const f32x4*)(gain + col), gb = *(const f32x4*)(gain + col + 4);
                float o[8];
#pragma unroll
                for (int e = 0; e < 4; ++e) { const float g0 = bflo(gwv[e]), g1 = bfhi(gwv[e]); const float n0 = e < 2 ? ga[2 * e] : gb[2 * e - 4], n1 = e < 2 ? ga[2 * e + 1] : gb[2 * e - 3];
                    o[2 * e] = g0 * sigmoidf_(g0) * bflo(v[e]) * n0; o[2 * e + 1] = g1 * sigmoidf_(g1) * bfhi(v[e]) * n1; }
                u32x4 w; w.x = pk2(o[0], o[1]); w.y = pk2(o[2], o[3]); w.z = pk2(o[4], o[5]); w.w = pk2(o[6], o[7]);
                *(u32x4*)(OUTP + off) = w;
            }
            LDS_WAIT(); asm volatile("" ::: "memory");
        }
    }
}

DI void attn_phase(Frame& F) {
    const int lane_ = F.lane;
    float* LSE = (float*)(F.ws + WS_LSE);
    const int r = lane_ & 31, h = lane_ >> 5;
    const int gw = F.vcu * NWAVES + F.wave, NGW = F.G * NWAVES;
    for (int it = gw; it < 6144; it += NGW) {
        const int g = it >> 11, rem = it & 2047;
        const int dil = g == 0 ? 1 : (g == 1 ? 4 : 16), nsub = SEQ / dil, nqt = nsub >> 5;
        const int qt = rem % nqt; const int rem2 = rem / nqt; const int rho = rem2 % dil; const int bh = rem2 / dil; const int hg = bh & 3, b = bh >> 2;
        const int head = 4 * g + hg;
        const float slope = __builtin_amdgcn_exp2f(-8.f * (float)(head + 1) * (1.f / 12.f)) * (float)dil;
        const bf16* AQ = (const bf16*)(F.ws + WS_AQ + (size_t)g * 16 * MiB); const bf16* AK = (const bf16*)(F.ws + WS_AK + (size_t)g * 16 * MiB);
        const bf16* AVT = (const bf16*)(F.ws + WS_AVT) + (size_t)g * 512 * NT;
        bf16* OG = (bf16*)(F.ws + (g == 0 ? WS_O0 : (g == 1 ? WS_O1 : WS_O2)));
        const int i0 = 32 * qt;
        const int v0 = b * SEQ + rho * nsub;
        const size_t tokbase = (size_t)b * SEQ + rho;
        bf16x8 bq[8];
        { const bf16* qp = AQ + ((size_t)((v0 + i0) >> 5) * 32 + hg * 8) * 512 + lane_ * 8;
#pragma unroll
          for (int ks = 0; ks < 8; ++ks) bq[ks] = ld16(qp + ks * 512); }
        f32x16 sT[5];
#pragma unroll
        for (int kt = 0; kt < 5; ++kt) {
            int ik0 = i0 - 64 + 32 * kt; ik0 = ik0 < 0 ? 0 : (ik0 >= nsub ? nsub - 32 : ik0);
            const bf16* kp = AK + ((size_t)((v0 + ik0) >> 5) * 32 + hg * 8) * 512 + lane_ * 8;
            f32x16 acc = zero16();
#pragma unroll
            for (int ks = 0; ks < 8; ++ks) acc = MFMA32(ld16(kp + ks * 512), bq[ks], acc);
            sT[kt] = acc;
        }
        const int iq = i0 + r;
        float mx = -3.0e38f;
#pragma unroll
        for (int kt = 0; kt < 5; ++kt)
#pragma unroll
            for (int i = 0; i < 16; ++i) { const int ik = i0 - 64 + 32 * kt + crow(i, h); const int d = ik - iq; const int ad = d < 0 ? -d : d;
                const bool valid = (ad <= 64) && (ik >= 0) && (ik < nsub);
                const float sc = valid ? sT[kt][i] * 0.08838834764831845f - slope * (float)ad : -1e30f;
                sT[kt][i] = sc; mx = fmaxf(mx, sc); }
        mx = fmaxf(mx, __shfl_xor(mx, 32));
        float sum = 0.f;
#pragma unroll
        for (int kt = 0; kt < 5; ++kt)
#pragma unroll
            for (int i = 0; i < 16; ++i) { const float p = __expf(sT[kt][i] - mx); sT[kt][i] = p; sum += p; }
        sum += __shfl_xor(sum, 32);
        const float inv = 1.f / sum;
        if (h == 0) LSE[((size_t)g * NT + tokbase + (size_t)dil * iq) * 4 + hg] = mx + __logf(sum);
        bf16x8 pb[5][2];
#pragma unroll
        for (int kt = 0; kt < 5; ++kt) { pb[kt][0] = pack_step(sT[kt], 0); pb[kt][1] = pack_step(sT[kt], 1); }
        bf16* op = OG + (tokbase + (size_t)dil * iq) * 512 + hg * 128 + 4 * h;
#pragma unroll
        for (int dt = 0; dt < 4; ++dt) {
            const bf16* vp = AVT + ((size_t)(hg * 4 + dt) * 1024) * 512 + r * 8 + 4 * h;
            f32x16 acc = zero16();
#pragma unroll
            for (int kt = 0; kt < 5; ++kt) {
                int ik0 = i0 - 64 + 32 * kt; ik0 = ik0 < 0 ? 0 : (ik0 >= nsub ? nsub - 32 : ik0);
                const bf16* bp = vp + (size_t)((v0 + ik0) >> 4) * 512;
#pragma unroll
                for (int s2 = 0; s2 < 2; ++s2) acc = MFMA32(ld8x2(bp + s2 * 512, bp + s2 * 512 + 256), pb[kt][s2], acc);
            }
#pragma unroll
            for (int q = 0; q < 4; ++q) { u32x2 w; w.x = pk2(acc[4 * q] * inv, acc[4 * q + 1] * inv); w.y = pk2(acc[4 * q + 2] * inv, acc[4 * q + 3] * inv); *(u32x2*)(op + 32 * dt + 8 * q) = w; }
        }
    }
}
DI void attn_mix(Frame& F) {
    const int lane_ = opaque_lane(F);
    const bf16* O0 = (const bf16*)(F.ws + WS_O0); const bf16* O1 = (const bf16*)(F.ws + WS_O1); const bf16* O2 = (const bf16*)(F.ws + WS_O2);
    const float* LSE = (const float*)(F.ws + WS_LSE); bf16* MIX = (bf16*)(F.ws + WS_ATTMIX);
    const int gw = F.bx * NWAVES + F.wave, NGW = F.G * NWAVES;
    for (int m = gw; m < NT; m += NGW) {
        const int hg = lane_ >> 4;
        const float l0 = LSE[((size_t)0 * NT + m) * 4 + hg], l1 = LSE[((size_t)1 * NT + m) * 4 + hg], l2 = LSE[((size_t)2 * NT + m) * 4 + hg];
        const float mx = fmaxf(l0, fmaxf(l1, l2)); const float e0 = __expf(l0 - mx), e1 = __expf(l1 - mx), e2 = __expf(l2 - mx); const float inv = 1.f / (e0 + e1 + e2);
        const float w0 = e0 * inv, w1 = e1 * inv, w2 = e2 * inv;
        const size_t off = (size_t)m * 512 + 8 * lane_;
        const u32x4 a = *(const u32x4*)(O0 + off), b = *(const u32x4*)(O1 + off), c = *(const u32x4*)(O2 + off);
        u32x4 o;
        o.x = pk2(w0 * bflo(a.x) + w1 * bflo(b.x) + w2 * bflo(c.x), w0 * bfhi(a.x) + w1 * bfhi(b.x) + w2 * bfhi(c.x));
        o.y = pk2(w0 * bflo(a.y) + w1 * bflo(b.y) + w2 * bflo(c.y), w0 * bfhi(a.y) + w1 * bfhi(b.y) + w2 * bfhi(c.y));
        o.z = pk2(w0 * bflo(a.z) + w1 * bflo(b.z) + w2 * bflo(c.z), w0 * bfhi(a.z) + w1 * bfhi(b.z) + w2 * bfhi(c.z));
        o.w = pk2(w0 * bflo(a.w) + w1 * bflo(b.w) + w2 * bflo(c.w), w0 * bfhi(a.w) + w1 * bfhi(b.w) + w2 * bfhi(c.w));
        *(u32x4*)(MIX + off) = o;
    }
}

DI float reduce4(const float (&p)[4], int lane) {
    const bool hi = (lane & 32) != 0;
    float a0 = hi ? p[2] : p[0], a1 = hi ? p[3] : p[1]; const float b0 = hi ? p[0] : p[2], b1 = hi ? p[1] : p[3];
    a0 += __shfl_xor(b0, 32); a1 += __shfl_xor(b1, 32);
    const bool hi2 = (lane & 16) != 0;
    float c = hi2 ? a1 : a0; const float d = hi2 ? a0 : a1;
    c += __shfl_xor(d, 16);
    c += __shfl_xor(c, 8); c += __shfl_xor(c, 4); c += __shfl_xor(c, 2); c += __shfl_xor(c, 1);
    return c;
}
DI void bcast4(float c, float (&o)[4]) {
#pragma unroll
    for (int t = 0; t < 4; ++t) o[t] = __builtin_bit_cast(float, __builtin_amdgcn_readlane(__builtin_bit_cast(int, c), 16 * t));
}
template <bool DRY> DI void moe_route(Frame& F) {
    const int lane_ = opaque_lane(F);
    float* H = (float*)F.outb; float* HO = DRY ? (float*)(F.ws + WS_XG) : H; const float* MOD = (const float*)(F.ws + WS_MOD); const float* WR = (const float*)(F.ws + WS_WROUT);
    bf16* U2 = (bf16*)(F.ws + (DRY ? WS_XG + 64 * MiB : WS_U2)); unsigned* ROUTE = (unsigned*)(F.ws + (DRY ? WS_XG + 100 * MiB : WS_ROUTE)); unsigned* CNT = (unsigned*)(F.ws + WS_CTL) + CW_CNT + (DRY ? 4096 : 0);
    const float* g1 = F.in[11]; const float* b1 = F.in[12]; const float* bco = F.in[14]; const float* bfi = F.in[16];
    LAS float* lg = (LAS float*)F.lds + F.wave * 256;
    const int gw = F.bx * NWAVES + F.wave, NGW = F.G * NWAVES;
    f32x4 un[4][4];
    { const int m0 = gw * 4;
      if (m0 < NT) {
#pragma unroll
        for (int t = 0; t < 4; ++t) { const f32x4* hr = (const f32x4*)(H + (size_t)(m0 + t) * DM) + lane_;
#pragma unroll
            for (int j = 0; j < 4; ++j) un[t][j] = hr[64 * j]; } } }
    for (int m0 = gw * 4; m0 < NT; m0 += NGW * 4) {
        const int b = m0 >> 12;
        f32x4 u[4][4];
        float ps[4], tot[4];
#pragma unroll
        for (int t = 0; t < 4; ++t) { float s = 0.f;
#pragma unroll
            for (int j = 0; j < 4; ++j) { u[t][j] = un[t][j]; s += (u[t][j].x + u[t][j].y) + (u[t][j].z + u[t][j].w); }
            ps[t] = s; }
        { const int m1 = m0 + NGW * 4;
          if (m1 < NT) {
#pragma unroll
            for (int t = 0; t < 4; ++t) { const f32x4* hr = (const f32x4*)(H + (size_t)(m1 + t) * DM) + lane_;
#pragma unroll
                for (int j = 0; j < 4; ++j) un[t][j] = hr[64 * j]; } } }
        bcast4(reduce4(ps, lane_), tot);
#pragma unroll
        for (int t = 0; t < 4; ++t) { const float mean = tot[t] * (1.f / DM); float s2 = 0.f;
#pragma unroll
            for (int j = 0; j < 4; ++j) { u[t][j] = u[t][j] - mean; s2 += (u[t][j].x * u[t][j].x + u[t][j].y * u[t][j].y) + (u[t][j].z * u[t][j].z + u[t][j].w * u[t][j].w); }
            ps[t] = s2; }
        bcast4(reduce4(ps, lane_), tot);
#pragma unroll
        for (int t = 0; t < 4; ++t) { const float rstd = 1.f / sqrtf(tot[t] * (1.f / DM) + LN_EPS); f32x4* hw = (f32x4*)(HO + (size_t)(m0 + t) * DM) + lane_; float s = 0.f;
#pragma unroll
            for (int j = 0; j < 4; ++j) { const int col = 256 * j + 4 * lane_; const f32x4 gg = *(const f32x4*)(g1 + col), bb = *(const f32x4*)(b1 + col);
                u[t][j] = u[t][j] * rstd * gg + bb; hw[64 * j] = u[t][j]; s += (u[t][j].x + u[t][j].y) + (u[t][j].z + u[t][j].w); }
            ps[t] = s; }
        bcast4(reduce4(ps, lane_), tot);
#pragma unroll
        for (int t = 0; t < 4; ++t) { const float mean = tot[t] * (1.f / DM); float s2 = 0.f;
#pragma unroll
            for (int j = 0; j < 4; ++j) { u[t][j] = u[t][j] - mean; s2 += (u[t][j].x * u[t][j].x + u[t][j].y * u[t][j].y) + (u[t][j].z * u[t][j].z + u[t][j].w * u[t][j].w); }
            ps[t] = s2; }
        bcast4(reduce4(ps, lane_), tot);
#pragma unroll
        for (int t = 0; t < 4; ++t) { const float rstd = 1.f / sqrtf(tot[t] * (1.f / DM) + LN_EPS); u32x2* o8 = (u32x2*)(U2 + (size_t)(m0 + t) * DM) + lane_;
#pragma unroll
            for (int j = 0; j < 4; ++j) { const int col = 256 * j + 4 * lane_;
                const f32x4 sh = *(const f32x4*)(MOD + b * 6144 + 3072 + col), sc = *(const f32x4*)(MOD + b * 6144 + 4096 + col);
                u[t][j] = u[t][j] * rstd * (sc + 1.f) + sh;
                u32x2 w; w.x = pk2(u[t][j].x, u[t][j].y); w.y = pk2(u[t][j].z, u[t][j].w); o8[64 * j] = w; } }
#ifndef ROUTE_NO
#define ROUTE_NO 36
#endif
#pragma unroll 2
        for (int o = 0; o < (DRY ? ROUTE_NO : 36); ++o) {
            const f32x4* wr = (const f32x4*)(WR + o * 1024) + lane_;
            f32x4 w[4];
#pragma unroll
            for (int j = 0; j < 4; ++j) w[j] = wr[64 * j];
#pragma unroll
            for (int t = 0; t < 4; ++t) { float a = 0.f;
#pragma unroll
                for (int j = 0; j < 4; ++j) a += (u[t][j].x * w[j].x + u[t][j].y * w[j].y) + (u[t][j].z * w[j].z + u[t][j].w * w[j].w);
                ps[t] = a; }
            const float c = reduce4(ps, lane_);
            if ((lane_ & 15) == 0) lg[(lane_ >> 4) * 64 + o] = c;
        }
        LDS_WAIT(); asm volatile("" ::: "memory");
        if (lane_ < 4) {
            const int t = lane_, m = m0 + t; const LAS float* L = lg + t * 64;
            float c[4]; int gs = 0; float cm = -3.0e38f;
#pragma unroll
            for (int j = 0; j < 4; ++j) { c[j] = L[j] + bco[j]; if (c[j] > cm) { cm = c[j]; gs = j; } }
            float den = 0.f;
#pragma unroll
            for (int j = 0; j < 4; ++j) den += __expf(c[j] - cm);
            const float pg = 1.f / den;
            float f[8];
#pragma unroll
            for (int e = 0; e < 8; ++e) f[e] = L[4 + 8 * gs + e] + bfi[8 * gs + e];
            int i0 = 0; float v0 = f[0];
#pragma unroll
            for (int e = 1; e < 8; ++e) if (f[e] > v0) { v0 = f[e]; i0 = e; }
            int i1 = -1; float v1 = -3.0e38f;
#pragma unroll
            for (int e = 0; e < 8; ++e) if (e != i0 && f[e] > v1) { v1 = f[e]; i1 = e; }
            const float e1 = __expf(v1 - v0); const float w0 = pg / (1.f + e1), w1 = pg * e1 / (1.f + e1);
            const int ex0 = gs * 8 + i0, ex1 = gs * 8 + i1;
            const unsigned p0 = atomicAdd(CNT + 64 * ex0, 1u), p1 = atomicAdd(CNT + 64 * ex1, 1u);
            unsigned* R = ROUTE + (size_t)m * 8;
            R[0] = ex0; R[1] = ex1; R[2] = p0; R[3] = p1; R[4] = __float_as_uint(w0); R[5] = __float_as_uint(w1);
        }
        LDS_WAIT(); asm volatile("" ::: "memory");
    }
}
DI int moe_tables(Frame& F) {
    LAS int* tab = (LAS int*)(F.lds + TEXP_OFF);
    if (F.tid == 0) {
        const unsigned* CNT = (const unsigned*)(F.ws + WS_CTL) + CW_CNT;
        int t = 0;
        for (int e = 0; e < 32; ++e) { const int c = (int)xb_ld((unsigned*)CNT + 64 * e); const int nt = (c + 255) >> 8; tab[192 + e] = t * 256; for (int k = 0; k < nt; ++k) tab[t + k] = e; t += nt; }
        tab[224] = t;
    }
    __syncthreads();
    return tab[224];
}
DI void moe_gather(Frame& F) {
    const int lane_ = opaque_lane(F);
    const LAS int* tab = (const LAS int*)(F.lds + TEXP_OFF);
    const bf16* U2 = (const bf16*)(F.ws + WS_U2); bf16* XG = (bf16*)(F.ws + WS_XG); unsigned* ROUTE = (unsigned*)(F.ws + WS_ROUTE);
    const int gw = F.bx * NWAVES + F.wave, NGW = F.G * NWAVES;
    for (int a = gw; a < 2 * NT; a += NGW) {
        const int m = a >> 1, k = a & 1;
        const unsigned e = ROUTE[(size_t)m * 8 + k], pos = ROUTE[(size_t)m * 8 + 2 + k];
        const int slot = tab[192 + e] + (int)pos;
        const u32x4* src = (const u32x4*)(U2 + (size_t)m * DM) + lane_; u32x4* dst = (u32x4*)(XG + (size_t)slot * DM) + lane_;
        dst[0] = src[0]; dst[64] = src[64];
        if (lane_ == 0) ROUTE[(size_t)m * 8 + 6 + k] = (unsigned)slot;
    }
}
template <bool DRY> DI void moe_combine(Frame& F) {
    const int lane_ = opaque_lane(F);
    float* H = (float*)F.outb; float* HO = DRY ? (float*)(F.ws + WS_XG) : H; const float* MOD = (const float*)(F.ws + WS_MOD); const bf16* YR = (const bf16*)(F.ws + WS_YROWS); const unsigned* ROUTE = (const unsigned*)(F.ws + WS_ROUTE);
    const float* g2 = F.in[20]; const float* b2 = F.in[21];
    const int gw = F.bx * NWAVES + F.wave, NGW = F.G * NWAVES;
    for (int m = gw; m < NT; m += NGW) {
        const int b = m >> 12; const unsigned* R = ROUTE + (size_t)m * 8;
        const float w0 = __uint_as_float(R[4]), w1 = __uint_as_float(R[5]); const size_t s0 = R[6], s1 = R[7];
        f32x4* hr = (f32x4*)(H + (size_t)m * DM) + lane_; f32x4* hw = (f32x4*)(HO + (size_t)m * DM) + lane_;
        f32x4 v[4]; float s = 0.f;
#pragma unroll
        for (int j = 0; j < 4; ++j) { const int col = 256 * j + 4 * lane_;
            const u32x2 ya = *(const u32x2*)(YR + s0 * DM + col), yb = *(const u32x2*)(YR + s1 * DM + col);
            const f32x4 y = {w0 * bflo(ya.x) + w1 * bflo(yb.x), w0 * bfhi(ya.x) + w1 * bfhi(yb.x), w0 * bflo(ya.y) + w1 * bflo(yb.y), w0 * bfhi(ya.y) + w1 * bfhi(yb.y)};
            const f32x4 gt = *(const f32x4*)(MOD + b * 6144 + 5120 + col);
            v[j] = hr[64 * j] * ALPHA + gt * y; s += (v[j].x + v[j].y) + (v[j].z + v[j].w); }
        const float mean = wave_sum(s) * (1.f / DM); float s2 = 0.f;
#pragma unroll
        for (int j = 0; j < 4; ++j) { v[j] = v[j] - mean; s2 += (v[j].x * v[j].x + v[j].y * v[j].y) + (v[j].z * v[j].z + v[j].w * v[j].w); }
        const float rstd = 1.f / sqrtf(wave_sum(s2) * (1.f / DM) + LN_EPS);
#pragma unroll
        for (int j = 0; j < 4; ++j) { const int col = 256 * j + 4 * lane_; hw[64 * j] = v[j] * rstd * *(const f32x4*)(g2 + col) + *(const f32x4*)(b2 + col); }
    }
}

__global__ void __launch_bounds__(NTHREADS, 2) fwd_kernel(Args args) {
    extern __shared__ __attribute__((aligned(16))) unsigned char lds[];
    Frame F;
    F.lds = (LAS unsigned char*)lds;
    F.tid = threadIdx.x; F.lane = F.tid & 63; F.wave = __builtin_amdgcn_readfirstlane(F.tid >> 6);
    F.G = gridDim.x; F.bx = blockIdx.x; F.vcu = (F.G % 8 == 0) ? (F.bx % 8) * (F.G / 8) + F.bx / 8 : F.bx;
    F.ws = args.ws; F.outb = (unsigned char*)args.out;
#pragma unroll
    for (int i = 0; i < 22; ++i) F.in[i] = args.in[i];
    for (int u = F.tid; u < (LDS_BYTES - LDSX_OFF) / 4; u += NTHREADS) ((LAS unsigned*)(F.lds + LDSX_OFF))[u] = 0u;
    __syncthreads();
    unsigned* ctl = (unsigned*)(F.ws + WS_CTL);
    XcdBarrier bar = xcd_barrier_post(ctl + CW_BAR, (volatile LAS unsigned*)(F.lds + MISC_OFF) + 8);
    if (F.tid == 0) ((volatile LAS unsigned*)(F.lds + MISC_OFF))[12] = xb_add(ctl + CW_RANK + 64 * bar.x, 1u);
    unsigned long long* TS = (unsigned long long*)(ctl + 32768);
    int nst = 1;
    if (PROF && F.bx == 0 && F.tid == 0) TS[0] = __builtin_amdgcn_s_memrealtime();
#define GRID_BAR() do { xcd_barrier(bar); if (PROF && F.bx == 0 && F.tid == 0) TS[nst] = __builtin_amdgcn_s_memrealtime(); ++nst; } while (0)
    const char* U = (const char*)(F.outb + OUT_U); const char* WINT = (const char*)(F.outb + OUT_WINT);

    REP(1,  phase0(F); GRID_BAR();
    phase1(F); GRID_BAR(); );
    { volatile LAS unsigned* M = (volatile LAS unsigned*)(F.lds + MISC_OFF);
      if (F.tid == 0) { unsigned pre = 0, nx = 0, mine = 0, even = 1, idx = 0;
          for (unsigned j = 0; j < 16; ++j) { const unsigned cj = xb_ld(ctl + CW_BAR + XB_XCNT(j)); if (j < bar.x) { pre += cj; idx += (cj > 0u); } if (j == bar.x) mine = cj; nx += (cj > 0u); if (cj != 0u && cj * 8u != (unsigned)F.G) even = 0; }
          const unsigned rank = M[12];
          M[13] = pre + rank; M[14] = (even && nx == 8u) ? rank * 8u + idx : (unsigned)F.bx; (void)mine; }
      __syncthreads();
      F.vcu = (int)M[13]; }
    const int c = (int)((volatile LAS unsigned*)(F.lds + MISC_OFF))[14];
    REP(2,
    { SchedR1 S; S.init(64, 16, F.G, c); S.U = U; S.W = WINT;
      pg8::EpiV<EpiR1> E{EpiR1{(bf16*)(F.ws + WS_RQ), (bf16*)(F.ws + WS_RK), (bf16*)(F.ws + WS_RG)}};
      pg8::gemm_phase<pg8::EpiV<EpiR1>, SchedR1, true>(F.lds, 1024, 1024, 1024, S, E); }
    { SchedR2 S; S.init(12, 64, F.G, c); S.U = U; S.W = WINT;
      pg8::EpiV<EpiR2> E{EpiR2{(bf16*)(F.ws + WS_RVT), (bf16*)(F.ws + WS_KFT), (bf16*)(F.ws + WS_KBT), (const float*)(F.ws + WS_DEC)}};
      pg8::gemm_phase<pg8::EpiV<EpiR2>, SchedR2, true>(F.lds, 1024, 1024, 1024, S, E); }
    GRID_BAR(); );
    REP(3, ret_scan<0>(F); GRID_BAR(); );
#ifndef SVAR
#define SVAR 1
#endif
    REPX(15, ret_scan<SVAR>(F); GRID_BAR(); );
    ret_norm<false>(F); GRID_BAR();
    REP(4,
    _Pragma("unroll 1")
    for (int g = 0; g < 3; ++g) {
        const int dil = g == 0 ? 1 : (g == 1 ? 4 : 16);
        SchedQK S; S.init(64, 4, F.G, c); S.U = U; S.W = WINT; S.g = g; S.r = dil; S.nsub = SEQ / dil;
        pg8::EpiV<EpiQK> E{EpiQK{(bf16*)(F.ws + WS_AQ + (size_t)g * 16 * MiB), (bf16*)(F.ws + WS_AK + (size_t)g * 16 * MiB)}};
        pg8::gemm_phase<pg8::EpiV<EpiQK>, SchedQK, false>(F.lds, 1024, 1024 * dil, 1024, S, E);
    }
    { SchedGate S; S.init(64, 8, F.G, c); S.U = U; S.W = WINT;
      pg8::EpiV<EpiGate> E{EpiGate{(bf16*)(F.ws + WS_GA), (bf16*)(F.ws + WS_GR)}};
      pg8::gemm_phase<pg8::EpiV<EpiGate>, SchedGate, true>(F.lds, 1024, 1024, 1024, S, E); }
_Pragma("unroll 1")
    for (int g = 0; g < 3; ++g) {
        const int dil = g == 0 ? 1 : (g == 1 ? 4 : 16);
        SchedA2 S; const int cc = (g == 1) ? c - 128 : c; S.init(2, 64, F.G, (cc >= 0 && cc < 128) ? cc : -1); S.U = U; S.W = WINT; S.g = g; S.r = dil; S.nsub = SEQ / dil;
        pg8::EpiV<EpiA2> E{EpiA2{(bf16*)(F.ws + WS_AVT) + (size_t)g * 512 * NT}};
        pg8::gemm_phase<pg8::EpiV<EpiA2>, SchedA2, true>(F.lds, 1024, 1024, 1024 * dil, S, E);
    }
    GRID_BAR(); );
    REP(5,  attn_phase(F); GRID_BAR(); );
    REP(6,  attn_mix(F); GRID_BAR(); );
    REP(7,
    { SchedG S; S.init(64, 4, F.G, c); S.A = (const char*)(F.ws + WS_ATTMIX); S.B = (const char*)(F.ws + WS_WAT); S.abytes = 256 * 512 * 2; S.bbytes = 256 * 512 * 2;
      pg8::EpiV<EpiG1> E{EpiG1{(const bf16*)(F.ws + WS_GA), (bf16*)F.outb}};
      pg8::gemm_phase<pg8::EpiV<EpiG1>, SchedG, false>(F.lds, 512, 512, 512, S, E); }
    { SchedG S; S.init(64, 4, F.G, c); S.A = (const char*)(F.ws + WS_RG); S.B = (const char*)(F.ws + WS_WRT); S.abytes = 256 * 2048 * 2; S.bbytes = 256 * 2048 * 2;
      pg8::EpiV<EpiG2> E{EpiG2{(const bf16*)(F.ws + WS_GR), (const bf16*)F.outb, (bf16*)(F.ws + WS_MERGED)}};
      pg8::gemm_phase<pg8::EpiV<EpiG2>, SchedG, false>(F.lds, 2048, 2048, 2048, S, E); }
    GRID_BAR();
    { SchedG S; S.init(64, 4, F.G, c); S.A = (const char*)(F.ws + WS_MERGED); S.B = (const char*)(F.ws + WS_WOT); S.abytes = 256 * 1024 * 2; S.bbytes = 256 * 1024 * 2;
      pg8::EpiV<EpiG3> E{EpiG3{F.in[0], (const float*)(F.ws + WS_MOD), (float*)F.outb}};
      pg8::gemm_phase<pg8::EpiV<EpiG3>, SchedG, false>(F.lds, 1024, 1024, 1024, S, E); }
    GRID_BAR(); );
    if (F.wave & 1) { moe_weight_transposes(F); moe_route<false>(F); } else { moe_route<false>(F); moe_weight_transposes(F); }
    GRID_BAR();
    REPX(11, moe_route<true>(F); GRID_BAR(); );
    const int ntiles = moe_tables(F);
    REP(8,  moe_gather(F); GRID_BAR(); );
    REP(9,
    { SchedM S; S.init(ntiles, 4, F.G, c); S.A = (const char*)(F.ws + WS_XG); S.B = (const char*)(F.ws + WS_W13T); S.abytes = 256 * 1024 * 2; S.ebytes = (size_t)1024 * 1024 * 2; S.bbytes = 256 * 1024 * 2;
      S.texp = (const LAS int*)(F.lds + TEXP_OFF);
      pg8::EpiV<EpiM3> E{EpiM3{(bf16*)(F.ws + WS_HDN)}};
      pg8::gemm_phase<pg8::EpiV<EpiM3>, SchedM, true>(F.lds, 1024, 1024, 1024, S, E); }
    GRID_BAR();
    { SchedM S; S.init(ntiles, 4, F.G, c); S.A = (const char*)(F.ws + WS_HDN); S.B = (const char*)(F.ws + WS_W2T); S.abytes = 256 * 512 * 2; S.ebytes = (size_t)1024 * 512 * 2; S.bbytes = 256 * 512 * 2;
      S.texp = (const LAS int*)(F.lds + TEXP_OFF);
      pg8::EpiV<EpiM4> E{EpiM4{(bf16*)(F.ws + WS_YROWS)}};
      pg8::gemm_phase<pg8::EpiV<EpiM4>, SchedM, true>(F.lds, 512, 512, 512, S, E); }
    GRID_BAR(); );
    REPX(12, moe_combine<true>(F); GRID_BAR(); );
    REPX(13, GRID_BAR(); GRID_BAR(); GRID_BAR(); GRID_BAR(); GRID_BAR(); GRID_BAR(); GRID_BAR(); GRID_BAR(); GRID_BAR(); GRID_BAR(); );
    moe_combine<false>(F);
#if PROF
    GRID_BAR();
    { const unsigned long long ta0 = __hip_atomic_load(TS + PROF_A - 1, __ATOMIC_RELAXED, __HIP_MEMORY_SCOPE_AGENT), ta1 = __hip_atomic_load(TS + PROF_A, __ATOMIC_RELAXED, __HIP_MEMORY_SCOPE_AGENT);
      const unsigned long long tb0 = __hip_atomic_load(TS + PROF_B - 1, __ATOMIC_RELAXED, __HIP_MEMORY_SCOPE_AGENT), tb1 = __hip_atomic_load(TS + PROF_B, __ATOMIC_RELAXED, __HIP_MEMORY_SCOPE_AGENT);
      const float V1 = (float)(ta1 - ta0) * 0.01f, V2 = (float)(tb1 - tb0) * 0.01f * 20.f;
      float* out = (float*)F.outb;
      for (int i = F.bx * NTHREADS + F.tid; i < NT * DM; i += F.G * NTHREADS) out[i] = (i < 16) ? V2 : V1; }
#endif
}

extern "C" void kernel_launch(void* const* d_in, const int* in_sizes, int n_in, void* d_out, int out_size, void* d_ws, size_t ws_size, hipStream_t stream) {
    static int grid = 0;
    if (grid == 0) {
        if (n_in != 22 || out_size != NT * DM || ws_size < WS_END) { fprintf(stderr, "kernel_launch: unexpected problem (n_in %d, out %d, ws %zu)\n", n_in, out_size, ws_size); grid = -1; return; }
        int dev = 0, cus = 0, per_cu = 0;
        if (hipGetDevice(&dev) != hipSuccess || hipDeviceGetAttribute(&cus, hipDeviceAttributeMultiprocessorCount, dev) != hipSuccess) { grid = -1; return; }
        if (hipFuncSetAttribute((const void*)fwd_kernel, hipFuncAttributeMaxDynamicSharedMemorySize, LDS_BYTES) != hipSuccess) { grid = -1; return; }
        if (hipOccupancyMaxActiveBlocksPerMultiprocessor(&per_cu, (const void*)fwd_kernel, NTHREADS, LDS_BYTES) != hipSuccess || per_cu < 1) { fprintf(stderr, "kernel_launch: occupancy query reports %d blocks/CU\n", per_cu); (void)hipGetLastError(); grid = -1; return; }
        grid = cus;
    }
    if (grid < 0) return;
    (void)hipMemsetAsync((char*)d_ws + WS_CTL, 0, CTL_ZERO_BYTES, stream);
    Args a{};
    for (int i = 0; i < 22; ++i) a.in[i] = (const float*)d_in[i];
    a.out = (float*)d_out; a.ws = (unsigned char*)d_ws;
    hipLaunchKernelGGL(fwd_kernel, dim3(grid), dim3(NTHREADS), LDS_BYTES, stream, a);
}
```

```cpp
#ifndef PROF
#define PROF 0
#endif
#ifndef DUP
#define DUP 0
#endif
#define REP(k, ...) do { __VA_ARGS__ if (DUP == (k)) { __VA_ARGS__ } } while (0)
#define REPX(k, ...) do { if (DUP == (k)) { __VA_ARGS__ } } while (0)
#ifndef PROF_A
#define PROF_A 1
#endif
#ifndef PROF_B
#define PROF_B 2
#endif
#include <hip/hip_runtime.h>
#include <cstdio>
#include <cstdint>

#define GAS __attribute__((address_space(1)))
#define LAS __attribute__((address_space(3)))
#define DI __device__ __forceinline__
typedef unsigned short bf16;
typedef float f32x4 __attribute__((ext_vector_type(4)));
typedef float f32x16 __attribute__((ext_vector_type(16)));
typedef float f32x2 __attribute__((ext_vector_type(2)));
typedef short bf16x8 __attribute__((ext_vector_type(8)));
typedef short s16x4 __attribute__((ext_vector_type(4)));
typedef __bf16 bf16x2_t __attribute__((ext_vector_type(2)));
typedef unsigned u32x4 __attribute__((ext_vector_type(4)));
typedef unsigned u32x2 __attribute__((ext_vector_type(2)));

constexpr int NT = 16384, DM = 1024, SEQ = 4096, NB = 4;
constexpr int NWAVES = 8, NTHREADS = 512;
constexpr int LDS_BYTES = 147456, RING_BYTES = 131072, LDSX_OFF = RING_BYTES;
constexpr int MISC_OFF = LDSX_OFF + 320;
constexpr int TEXP_OFF = LDSX_OFF + 1024;
constexpr float LN_EPS = 1e-5f;
constexpr float ALPHA = 1.189207115002721f;

constexpr size_t MiB = 1u << 20;
constexpr size_t WS_CTL = 0, CTL_ZERO_BYTES = (PROF ? 1024 : 128) * 1024;
constexpr size_t WS_MOD = 1 * MiB;
constexpr size_t WS_DEC = 1 * MiB + 112 * 1024;
constexpr size_t WS_WROUT = 1 * MiB + 128 * 1024;
constexpr size_t WS_WAT = 2 * MiB, WS_WRT = 3 * MiB, WS_WOT = 7 * MiB;
constexpr size_t WS_LSE = 9 * MiB;
constexpr size_t WS_ROUTE = 10 * MiB;
constexpr int NTP = NT + 576;
constexpr size_t WS_RQ = 12 * MiB, WS_RK = 44 * MiB, WS_RG = 76 * MiB, WS_RVT = 140 * MiB, WS_KFT = 207 * MiB, WS_KBT = 241 * MiB, WS_Y = 275 * MiB;
constexpr size_t WS_AQ = 12 * MiB, WS_O0 = 60 * MiB, WS_AK = 140 * MiB, WS_AVT = 188 * MiB, WS_GA = 238 * MiB, WS_GR = 270 * MiB, WS_O1 = 302 * MiB, WS_O2 = 318 * MiB;
constexpr size_t WS_ATTMIX = 12 * MiB, WS_MERGED = 28 * MiB, WS_W13T = 140 * MiB, WS_W2T = 204 * MiB;
constexpr size_t WS_U2 = 238 * MiB, WS_XG = 12 * MiB, WS_HDN = 92 * MiB, WS_YROWS = 238 * MiB;
constexpr size_t WS_END = 339 * MiB;
static_assert((size_t)2048 * NTP * 2 <= 67 * MiB && (size_t)1024 * NTP * 2 <= 34 * MiB && (size_t)1536 * NTP * 2 <= 50 * MiB, "padded transposed tensors fit their regions");
constexpr size_t OUT_U = 0, OUT_WINT = 32 * MiB;
constexpr int CW_BAR = 4096;
constexpr int CW_CNT = 16384;
constexpr int CW_RANK = 20480;

constexpr int C_AQ = 0, C_AK = 1536, C_AV = 3072, C_RQ = 4608, C_RK = 5632, C_RV = 6656, C_RGT = 8704, C_GA = 10752, C_GR = 11776, C_END = 12800;

#define LDS_WAIT() asm volatile("s_waitcnt lgkmcnt(0)" ::: "memory")
#define VM_WAIT() asm volatile("s_waitcnt vmcnt(0)" ::: "memory")
DI unsigned pk2(float lo, float hi) { f32x2 v = {lo, hi}; bf16x2_t r = __builtin_convertvector(v, bf16x2_t); return __builtin_bit_cast(unsigned, r); }
DI float bf2f(unsigned short b) { return __builtin_bit_cast(float, (unsigned)b << 16); }
DI float bflo(unsigned w) { return __builtin_bit_cast(float, w << 16); }
DI float bfhi(unsigned w) { return __builtin_bit_cast(float, w & 0xffff0000u); }
DI float wave_sum(float v) {
#pragma unroll
    for (int o = 1; o < 64; o <<= 1) v += __shfl_xor(v, o);
    return v;
}
DI float sigmoidf_(float x) { return 1.f / (1.f + __expf(-x)); }
DI float log2_sigmoid(float x) { return -log1pf(expf(-x)) * 1.4426950408889634f; }
#define MFMA32(a, b, c) __builtin_amdgcn_mfma_f32_32x32x16_bf16((a), (b), (c), 0, 0, 0)
DI int crow(int reg, int h) { return (reg & 3) + 8 * (reg >> 2) + 4 * h; }
DI bf16x8 pack_step(const f32x16& x, int s) {
    u32x4 p; p[0] = pk2(x[8 * s], x[8 * s + 1]); p[1] = pk2(x[8 * s + 2], x[8 * s + 3]); p[2] = pk2(x[8 * s + 4], x[8 * s + 5]); p[3] = pk2(x[8 * s + 6], x[8 * s + 7]);
    return __builtin_bit_cast(bf16x8, p);
}
DI bf16x8 ld16(const bf16* p) { return *(const bf16x8*)p; }
DI bf16x8 ld8x2(const bf16* p0, const bf16* p1) { const s16x4 a = *(const s16x4*)p0, b = *(const s16x4*)p1; return __builtin_shufflevector(a, b, 0, 1, 2, 3, 4, 5, 6, 7); }
DI size_t blk_off(int row, int k, int kblocks) { return ((size_t)(row >> 5) * kblocks + (k >> 4)) * 512 + ((k >> 3) & 1) * 256 + (row & 31) * 8; }
DI f32x16 zero16() { f32x16 z; for (int i = 0; i < 16; ++i) z[i] = 0.f; return z; }

#define XB_TMO      128
#define XB_XCNT(j)  (256  + 64 * (j))
#define XB_XSUB(j)  (1280 + 64 * (j))
#define XB_XGEN(j)  (2304 + 64 * (j))
#define XB_TOP      3328
#define XB_TOPGEN   3392
#define XCD_BAR_WORDS 3456
#define XB_SPIN_CAP (1u << 18)
DI unsigned xb_ld(unsigned* p)              { return __hip_atomic_load(p, __ATOMIC_RELAXED, __HIP_MEMORY_SCOPE_AGENT); }
DI unsigned xb_add(unsigned* p, unsigned v) { return __hip_atomic_fetch_add(p, v, __ATOMIC_RELAXED, __HIP_MEMORY_SCOPE_AGENT); }
DI unsigned xb_xcc_id() { return (unsigned)__builtin_amdgcn_s_getreg((3 << 11) | 20) & 0xFu; }
#define XB_SPIN(cond, bar) do { unsigned _sp = 0; while (cond) { __builtin_amdgcn_s_sleep(1); \
    if ((++_sp & 255u) == 0u) { if (xb_ld(&(bar)[XB_TMO])) break; if (_sp > XB_SPIN_CAP) { atomicAdd(&(bar)[XB_TMO], 1u); break; } } } } while (0)
struct XcdBarrier { unsigned* bar; unsigned x; volatile LAS unsigned* st; };
DI XcdBarrier xcd_barrier_post(unsigned* bar, volatile LAS unsigned* st) {
    XcdBarrier b; b.bar = bar; b.x = xb_xcc_id(); b.st = st;
    if (threadIdx.x == 0) (void)xb_add(&bar[XB_XCNT(b.x)], 1u);
    return b;
}
DI void xcd_barrier_complete(unsigned* bar, unsigned x, unsigned& nloc, unsigned& nx) {
    const unsigned G = gridDim.x * gridDim.y * gridDim.z;
    unsigned sum, cnt, mine, sp = 0u;
    for (;;) {
        sum = 0u; cnt = 0u; mine = 0u;
#pragma unroll
        for (unsigned j = 0; j < 16; ++j) { const unsigned c = xb_ld(&bar[XB_XCNT(j)]); sum += c; cnt += (c > 0u) ? 1u : 0u; mine = (j == x) ? c : mine; }
        if (sum == G) break;
        __builtin_amdgcn_s_sleep(1);
        if ((++sp & 255u) == 0u) { if (xb_ld(&bar[XB_TMO])) break; if (sp > XB_SPIN_CAP) { atomicAdd(&bar[XB_TMO], 1u); break; } }
    }
    nloc = mine > 0u ? mine : 1u; nx = cnt > 0u ? cnt : 1u;
}
DI void xcd_barrier(const XcdBarrier& b) {
    asm volatile("s_waitcnt vmcnt(0)" ::: "memory");
    __syncthreads();
    if (threadIdx.x == 0) {
        unsigned* bar = b.bar;
        __builtin_amdgcn_s_waitcnt(0);
        unsigned nloc = b.st[0], nx = b.st[1];
        if (nloc == 0u) { xcd_barrier_complete(bar, b.x, nloc, nx); b.st[0] = nloc; b.st[1] = nx; }
        const unsigned old = xb_add(&bar[XB_XSUB(b.x)], 1u);
        const unsigned gen = old / nloc;
        if (old + 1u == (gen + 1u) * nloc) {
            __builtin_amdgcn_fence(__ATOMIC_RELEASE, "agent");
            asm volatile("s_waitcnt vmcnt(0)" ::: "memory");
            const unsigned og = xb_add(&bar[XB_TOP], 1u);
            const unsigned tg = og / nx;
            if (og + 1u == (tg + 1u) * nx) xb_add(&bar[XB_TOPGEN], 1u);
            else XB_SPIN(xb_ld(&bar[XB_TOPGEN]) == tg, bar);
            __builtin_amdgcn_fence(__ATOMIC_ACQUIRE, "agent");
            xb_add(&bar[XB_XGEN(b.x)], 1u);
            asm volatile("s_waitcnt vmcnt(0)" ::: "memory");
        } else {
            XB_SPIN(xb_ld(&bar[XB_XGEN(b.x)]) == gen, bar);
            __builtin_amdgcn_fence(__ATOMIC_ACQUIRE, "agent");
            asm volatile("s_waitcnt vmcnt(0)" ::: "memory");
        }
    }
    __syncthreads();
}

namespace pg8 {
#define PG8_LAS __attribute__((address_space(3)))
constexpr int BM = 256, BK = 64, HALF = 128, HTB = HALF * BK * 2, STAGE_BYTES = 8 * HTB, NXCD = 8, WGM = 8;
__host__ __device__ __forceinline__ int lds_byte(int r, int c) { const int st = (r >> 4) * 2 + (c >> 5), rr = r & 15, cc = c & 31, ob = rr * 64 + cc * 2; return st * 1024 + (ob ^ (((ob >> 9) & 1) << 5)); }
__host__ __device__ __forceinline__ void stage_rc(int b, int& R, int& C) { const int st = b / 1024, sb = b % 1024, swz = sb ^ (((sb >> 9) & 1) << 5); R = (st >> 1) * 16 + swz / 64; C = (st & 1) * 32 + (swz % 64) / 2; }
__host__ __device__ __forceinline__ int perm32(int rho) { const int n = rho >> 4, i = rho & 15; return 8 * (i >> 2) + 4 * n + (i & 3); }
struct Unit { int pm, pn; };
struct StaticOrder {
    int nM, nN, nwg, G, c;
    __host__ __device__ void init(int nM_, int nN_, int G_, int c_) { nM = nM_; nN = nN_; nwg = nM * nN; G = G_; c = c_; }
    __host__ __device__ bool next(int i, Unit& u) const {
        const long L = (long)i * G + c; if (c < 0 || L >= nwg) return false;
        int wgid = (int)L; { const int q = nwg / NXCD, r = nwg % NXCD, xcd = wgid % NXCD, off = wgid / NXCD; wgid = (xcd < r ? xcd * (q + 1) : r * (q + 1) + (xcd - r) * q) + off; }
        const int nig = WGM * nN, gid = wgid / nig, fm = gid * WGM, gsz = (nM - fm) < WGM ? (nM - fm) : WGM;
        u.pm = fm + ((wgid % nig) % gsz); u.pn = (wgid % nig) / gsz; return true;
    }
};
template <class F> struct EpiV {
    F f;
    __device__ __forceinline__ void operator()(const f32x4 (&acc)[2][2][4][2], const Unit& u, int wr, int wc, int fr, int fq) const {
        const int row0 = u.pm * BM + wr * 64 + fr, col0 = u.pn * BM + wc * 32 + 8 * fq;
#pragma unroll
        for (int ai = 0; ai < 2; ++ai)
#pragma unroll
            for (int m = 0; m < 4; ++m)
#pragma unroll
                for (int bj = 0; bj < 2; ++bj) f(row0 + ai * HALF + m * 16, col0 + bj * HALF, acc[ai][bj][m][0], acc[ai][bj][m][1]);
    }
};
template <class Epi, class Sched, bool ALIGN_EPI = false>
__device__ __forceinline__ void gemm_phase(PG8_LAS unsigned char* lds, const int K, const int lda, const int ldb, const Sched& S, const Epi& E) {
    int tid_ = threadIdx.x; asm volatile("" : "+v"(tid_));
    const int tid = tid_, wid = __builtin_amdgcn_readfirstlane(tid >> 6), lane = tid & 63, wr = wid >> 2, wc = wid & 3, fr = lane & 15, fq = lane >> 4;
    const int nt = K / BK;
    unsigned voffA[2], voffB[2];
#pragma unroll
    for (int i = 0; i < 2; ++i) { int R, C; stage_rc(tid * 16 + i * 8192, R, C); const int Rb = (R & ~31) + perm32(R & 31);
        voffA[i] = (unsigned)(R * lda + C) * 2u; voffB[i] = (unsigned)(Rb * ldb + C) * 2u; }
    const size_t kstep = (size_t)(BK * 2);
    const size_t hstepA = (size_t)HALF * lda * 2, hstepB = (size_t)HALF * ldb * 2;
    const unsigned ldsw = (unsigned)wid * 1024u;
    const int aoff = lds_byte(wr * 64 + fr, fq * 8), boff = lds_byte(wc * 32 + fr, fq * 8);
#define PG8_SA(b, h) (((b) * 2 + (h)) * HTB)
#define PG8_SB(b, h) ((4 + (b) * 2 + (h)) * HTB)
#define PG8_STAGE(bufoff, gbase, voff) do { _Pragma("unroll") for (int _i = 0; _i < 2; ++_i) \
        __builtin_amdgcn_global_load_lds((const unsigned*)((const char*)(gbase) + (voff)[_i]), (PG8_LAS unsigned*)(lds + (bufoff) + ldsw + _i * 8192), 16, 0, 0); } while (0)
#define PG8_LDA(dst, b, h) do { _Pragma("unroll") for (int m = 0; m < 4; ++m) _Pragma("unroll") for (int k = 0; k < 2; ++k) dst[m][k] = *(const PG8_LAS bf16x8*)(lds + PG8_SA(b, h) + aoff + m * 2048 + k * 1024); } while (0)
#define PG8_LDB(dst, b, h) do { _Pragma("unroll") for (int n = 0; n < 2; ++n) _Pragma("unroll") for (int k = 0; k < 2; ++k) dst[n][k] = *(const PG8_LAS bf16x8*)(lds + PG8_SB(b, h) + boff + n * 2048 + k * 1024); } while (0)
#define PG8_MMA(ai, bj, At, Bt) do { __builtin_amdgcn_s_setprio(1); _Pragma("unroll") for (int m = 0; m < 4; ++m) _Pragma("unroll") for (int n = 0; n < 2; ++n) _Pragma("unroll") for (int k = 0; k < 2; ++k) \
        acc[ai][bj][m][n] = __builtin_amdgcn_mfma_f32_16x16x32_bf16(Bt[n][k], At[m][k], acc[ai][bj][m][n], 0, 0, 0); __builtin_amdgcn_s_setprio(0); } while (0)
#define PG8_WAIT_V(n) asm volatile("s_waitcnt vmcnt(" #n ")" ::: "memory")
#define PG8_WAIT_L(n) asm volatile("s_waitcnt lgkmcnt(" #n ")" ::: "memory")
#define PG8_BAR __builtin_amdgcn_s_barrier()
#define PG8_SCHED __builtin_amdgcn_sched_barrier(0)
    Unit cur, nxt; int ui = 0;
    if (!S.next(0, cur)) return;
    f32x4 acc[2][2][4][2];
#pragma unroll
    for (int a = 0; a < 2; ++a)
#pragma unroll
        for (int b = 0; b < 2; ++b)
#pragma unroll
            for (int m = 0; m < 4; ++m)
#pragma unroll
                for (int n = 0; n < 2; ++n) acc[a][b][m][n] = (f32x4){0.f, 0.f, 0.f, 0.f};
    bf16x8 At[4][2], B0[2][2], B1[2][2];
    const char* cA = S.a_base(cur); const char* cB = S.b_base(cur);
    PG8_STAGE(PG8_SB(0, 0), cB, voffB); PG8_STAGE(PG8_SB(0, 1), cB + hstepB, voffB); PG8_STAGE(PG8_SA(0, 0), cA, voffA); PG8_STAGE(PG8_SA(0, 1), cA + hstepA, voffA);
    if (wr == 1) PG8_BAR;
    PG8_WAIT_V(2); PG8_BAR;
    PG8_STAGE(PG8_SB(1, 0), cB + kstep, voffB); PG8_STAGE(PG8_SA(1, 0), cA + kstep, voffA); PG8_STAGE(PG8_SB(1, 1), cB + hstepB + kstep, voffB);
    PG8_WAIT_V(6); PG8_BAR;
    for (;;) {
        const bool has_next = S.next(ui + 1, nxt);
        const char* nA = has_next ? S.a_base(nxt) : cA; const char* nB = has_next ? S.b_base(nxt) : cB;
        for (int t = 0; t < nt; t += 2) {
            const bool last = (t == nt - 2);
            const char* a1 = cA + (size_t)(t + 1) * kstep;
            const char* a2 = last ? nA : cA + (size_t)(t + 2) * kstep; const char* b2 = last ? nB : cB + (size_t)(t + 2) * kstep;
            const char* a3 = a2 + kstep; const char* b3 = b2 + kstep;
            PG8_LDB(B0, 0, 0); PG8_LDB(B1, 0, 1); PG8_SCHED; PG8_LDA(At, 0, 0); PG8_STAGE(PG8_SA(1, 1), a1 + hstepA, voffA);
            PG8_WAIT_V(8); PG8_WAIT_L(0); PG8_BAR; PG8_MMA(0, 0, At, B0); PG8_MMA(0, 1, At, B1); PG8_BAR; PG8_SCHED;
            PG8_LDA(At, 0, 1); PG8_STAGE(PG8_SB(0, 0), b2, voffB); PG8_STAGE(PG8_SB(0, 1), b2 + hstepB, voffB); PG8_STAGE(PG8_SA(0, 0), a2, voffA);
            PG8_WAIT_V(8); PG8_WAIT_L(0); PG8_BAR; PG8_MMA(1, 0, At, B0); PG8_MMA(1, 1, At, B1); PG8_BAR; PG8_SCHED;
            PG8_LDB(B0, 1, 0); PG8_LDB(B1, 1, 1); PG8_SCHED; PG8_LDA(At, 1, 0); PG8_STAGE(PG8_SA(0, 1), a2 + hstepA, voffA);
            PG8_WAIT_V(8); PG8_WAIT_L(0); PG8_BAR; PG8_MMA(0, 0, At, B0); PG8_MMA(0, 1, At, B1); PG8_BAR; PG8_SCHED;
            PG8_LDA(At, 1, 1); PG8_STAGE(PG8_SB(1, 0), b3, voffB); PG8_STAGE(PG8_SB(1, 1), b3 + hstepB, voffB); PG8_STAGE(PG8_SA(1, 0), a3, voffA);
            PG8_WAIT_V(8); PG8_WAIT_L(0); PG8_BAR; PG8_MMA(1, 0, At, B0); PG8_MMA(1, 1, At, B1); PG8_BAR; PG8_SCHED;
        }
        if constexpr (ALIGN_EPI) { if (wr == 0) PG8_BAR; }
        E(acc, cur, wr, wc, fr, fq);
        if (!has_next) break;
#pragma unroll
        for (int a = 0; a < 2; ++a)
#pragma unroll
            for (int b = 0; b < 2; ++b)
#pragma unroll
                for (int m = 0; m < 4; ++m)
#pragma unroll
                    for (int n = 0; n < 2; ++n) acc[a][b][m][n] = (f32x4){0.f, 0.f, 0.f, 0.f};
        cur = nxt; cA = nA; cB = nB; ++ui;
        if constexpr (ALIGN_EPI) { if (wr == 1) PG8_BAR; }
    }
    PG8_WAIT_V(0);
    if constexpr (!ALIGN_EPI) { if (wr == 0) PG8_BAR; }
    PG8_BAR;
#undef PG8_SA
#undef PG8_SB
#undef PG8_STAGE
#undef PG8_LDA
#undef PG8_LDB
#undef PG8_MMA
#undef PG8_WAIT_V
#undef PG8_WAIT_L
#undef PG8_BAR
#undef PG8_SCHED
}
}

struct Frame {
    LAS unsigned char* lds;
    int tid, lane, wave, G, vcu, bx;
    unsigned char* ws; unsigned char* outb;
    const float* in[22];
};
struct Args { const float* in[22]; float* out; unsigned char* ws; };
DI int opaque_lane(const Frame& F) { int l = F.lane; asm volatile("" : "+v"(l)); return l; }

template <class RowMap>
DI void transpose_item(const float* W, int K, int N, bf16* WT, RowMap orow, LAS float* scr, int item, int lane) {
    const int nblk = N / 32, kb = item / nblk, nb = item % nblk, k0 = 64 * kb, n0 = 32 * nb;
#pragma unroll 8
    for (int i = 0; i < 32; ++i) { const int kk = 2 * i + (lane >> 5); scr[kk * 33 + (lane & 31)] = W[(size_t)(k0 + kk) * N + n0 + (lane & 31)]; }
    LDS_WAIT(); asm volatile("" ::: "memory");
    const int c = lane & 7;
#pragma unroll
    for (int j = 0; j < 4; ++j) { const int n = (lane >> 3) + 8 * j; const LAS float* s = scr + (8 * c) * 33 + n;
        u32x4 o; o.x = pk2(s[0 * 33], s[1 * 33]); o.y = pk2(s[2 * 33], s[3 * 33]); o.z = pk2(s[4 * 33], s[5 * 33]); o.w = pk2(s[6 * 33], s[7 * 33]);
        *(u32x4*)(WT + (size_t)orow(n0 + n) * K + k0 + 8 * c) = o; }
    LDS_WAIT(); asm volatile("" ::: "memory");
}
struct RowId { int off; DI int operator()(int n) const { return off + n; } };
struct RowW13 { int add; DI int operator()(int n) const { return ((n >> 2) << 3) + (n & 3) + add; } };

DI void phase0(Frame& F) {
    const int lane_ = F.lane;
    const float* c = F.in[1]; const float* w_ada = F.in[2]; const float* b_ada = F.in[3];
    float* MOD = (float*)(F.ws + WS_MOD);
    if (F.bx < 96) {
        const int j = F.bx * 64 + lane_;
        float a0 = 0.f, a1 = 0.f, a2 = 0.f, a3 = 0.f;
        const int k0 = F.wave * 128;
#pragma unroll 8
        for (int k = k0; k < k0 + 128; ++k) { const float w = w_ada[(size_t)k * 6144 + j]; a0 += c[k] * w; a1 += c[1024 + k] * w; a2 += c[2048 + k] * w; a3 += c[3072 + k] * w; }
        LAS float* red = (LAS float*)F.lds;
        red[(F.wave * 4 + 0) * 64 + lane_] = a0; red[(F.wave * 4 + 1) * 64 + lane_] = a1; red[(F.wave * 4 + 2) * 64 + lane_] = a2; red[(F.wave * 4 + 3) * 64 + lane_] = a3;
        __syncthreads();
        if (F.tid < 256) { const int b = F.tid >> 6, l = F.tid & 63; float s = b_ada[F.bx * 64 + l];
#pragma unroll
            for (int w = 0; w < 8; ++w) s += red[(w * 4 + b) * 64 + l];
            MOD[b * 6144 + F.bx * 64 + l] = s; }
        __syncthreads();
    }
    if (F.bx == 0 && F.tid < 8) ((float*)(F.ws + WS_DEC))[F.tid] = log2_sigmoid(F.tid < 4 ? F.in[6][F.tid] : F.in[7][F.tid - 4]);
    { const int gid = F.bx * NTHREADS + F.tid;
      if (gid < 36 * 1024) { const int o = gid >> 10, k = gid & 1023; float v;
          if (o < 4) v = F.in[13][k * 4 + o]; else { const int g = (o - 4) >> 3, e = (o - 4) & 7; v = F.in[15][((size_t)g * 1024 + k) * 8 + e]; }
          ((float*)(F.ws + WS_WROUT))[gid] = v; } }
    LAS float* scr = (LAS float*)(F.lds + 16384 + F.wave * 12288);
    const int gw = F.bx * NWAVES + F.wave, NGW = F.G * NWAVES;
    constexpr int I_IN = 16 * 400, I_A = 8 * 32, I_R = 32 * 32, I_O = 16 * 32;
    for (int it = gw; it < I_IN + I_A + I_R + I_O; it += NGW) {
        int r = it;
        if (r < I_IN) { transpose_item(F.in[4], 1024, C_END, (bf16*)(F.outb + OUT_WINT), RowId{0}, scr, r, lane_); continue; } r -= I_IN;
        if (r < I_A) { transpose_item(F.in[5], 512, 1024, (bf16*)(F.ws + WS_WAT), RowId{0}, scr, r, lane_); continue; } r -= I_A;
        if (r < I_R) { transpose_item(F.in[9], 2048, 1024, (bf16*)(F.ws + WS_WRT), RowId{0}, scr, r, lane_); continue; } r -= I_R;
        transpose_item(F.in[10], 1024, 1024, (bf16*)(F.ws + WS_WOT), RowId{0}, scr, r, lane_);
    }
}
DI void moe_weight_transposes(Frame& F) {
    const int lane_ = F.lane;
    LAS float* scr = (LAS float*)(F.lds + 16384 + F.wave * 12288);
    const int gw = F.bx * NWAVES + F.wave, NGW = F.G * NWAVES;
    bf16* W13T = (bf16*)(F.ws + WS_W13T); bf16* W2T = (bf16*)(F.ws + WS_W2T);
    for (int it = gw; it < 3 * 8192; it += NGW) {
        const int which = it >> 13, r = it & 8191, e = r >> 8, item = r & 255;
        if (which == 0) transpose_item(F.in[17] + (size_t)e * 1024 * 512, 1024, 512, W13T + (size_t)e * 1024 * 1024, RowW13{0}, scr, item, lane_);
        else if (which == 1) transpose_item(F.in[18] + (size_t)e * 1024 * 512, 1024, 512, W13T + (size_t)e * 1024 * 1024, RowW13{4}, scr, item, lane_);
        else transpose_item(F.in[19] + (size_t)e * 512 * 1024, 512, 1024, W2T + (size_t)e * 1024 * 512, RowId{0}, scr, item, lane_);
    }
}

DI void phase1(Frame& F) {
    const int lane_ = opaque_lane(F);
    const float* x = F.in[0]; const float* MOD = (const float*)(F.ws + WS_MOD); bf16* U = (bf16*)(F.outb + OUT_U);
    const int gw = F.bx * NWAVES + F.wave, NGW = F.G * NWAVES;
    for (int m = gw; m < NT; m += NGW) {
        const f32x4* xr = (const f32x4*)(x + (size_t)m * DM) + lane_; const int b = m >> 12;
        f32x4 v[4]; float s = 0.f;
#pragma unroll
        for (int j = 0; j < 4; ++j) { v[j] = xr[64 * j]; s += (v[j].x + v[j].y) + (v[j].z + v[j].w); }
        const float mean = wave_sum(s) * (1.f / DM); float s2 = 0.f;
#pragma unroll
        for (int j = 0; j < 4; ++j) { v[j] = v[j] - mean; s2 += (v[j].x * v[j].x + v[j].y * v[j].y) + (v[j].z * v[j].z + v[j].w * v[j].w); }
        const float rstd = 1.f / sqrtf(wave_sum(s2) * (1.f / DM) + LN_EPS);
        u32x2* o8 = (u32x2*)(U + (size_t)m * DM) + lane_;
#pragma unroll
        for (int j = 0; j < 4; ++j) { const int col = 256 * j + 4 * lane_;
            const f32x4 sh = *(const f32x4*)(MOD + b * 6144 + col), sc = *(const f32x4*)(MOD + b * 6144 + 1024 + col);
            const f32x4 u = v[j] * rstd * (sc + 1.f) + sh;
            u32x2 w; w.x = pk2(u.x, u.y); w.y = pk2(u.z, u.w); o8[64 * j] = w; }
    }
}

DI u32x4 pack8(f32x4 v0, f32x4 v1) { u32x4 w; w.x = pk2(v0[0], v0[1]); w.y = pk2(v0[2], v0[3]); w.z = pk2(v1[0], v1[1]); w.w = pk2(v1[2], v1[3]); return w; }

struct SchedR1 : pg8::StaticOrder { const char* U; const char* W;
    DI const char* a_base(const pg8::Unit& u) const { return U + (size_t)u.pm * 256 * 2048; }
    DI const char* b_base(const pg8::Unit& u) const { const int r = u.pn < 8 ? C_RQ + 256 * u.pn : C_RGT + 256 * (u.pn - 8); return W + (size_t)r * 2048; } };
struct EpiR1 { bf16 *RQ, *RK, *RG;
    DI void operator()(int row, int col, f32x4 v0, f32x4 v1) const {
        if (col < 1024) *(u32x4*)(RQ + blk_off(row, col, 64)) = pack8(v0, v1);
        else if (col < 2048) *(u32x4*)(RK + blk_off(row, col - 1024, 64)) = pack8(v0 * 0.0625f, v1 * 0.0625f);
        else *(u32x4*)(RG + (size_t)row * 2048 + col - 2048) = pack8(v0, v1); } };
struct SchedR2 : pg8::StaticOrder { const char* U; const char* W;
    DI const char* a_base(const pg8::Unit& u) const { const int r = u.pm < 8 ? C_RV + 256 * u.pm : C_RK + 256 * (u.pm - 8); return W + (size_t)r * 2048; }
    DI const char* b_base(const pg8::Unit& u) const { return U + (size_t)u.pn * 256 * 2048; } };
struct EpiR2 { bf16 *RVT, *KFT, *KBT; const float* DEC;
    DI void operator()(int row, int col, f32x4 v0, f32x4 v1) const {
        if (row < 2048) { *(u32x4*)(RVT + blk_off(row, col, 1024)) = pack8(v0, v1); return; }
        const int f = row - 2048, h = f >> 8; const float p0 = (float)(col & 127);
        const float a = DEC[h], b = DEC[4 + h];
        f32x4 kf0, kf1, kb0, kb1;
#pragma unroll
        for (int e = 0; e < 4; ++e) {
            const float pa = p0 + (float)e, pb = p0 + (float)(e + 4);
            kf0[e] = v0[e] * 0.0625f * __builtin_amdgcn_exp2f(a * (127.f - pa)); kf1[e] = v1[e] * 0.0625f * __builtin_amdgcn_exp2f(a * (127.f - pb));
            kb0[e] = v0[e] * 0.0625f * __builtin_amdgcn_exp2f(b * pa);           kb1[e] = v1[e] * 0.0625f * __builtin_amdgcn_exp2f(b * pb); }
        *(u32x4*)(KFT + blk_off(f, col, 1024)) = pack8(kf0, kf1);
        *(u32x4*)(KBT + blk_off(f, col, 1024)) = pack8(kb0, kb1); } };
struct SchedQK : pg8::StaticOrder { const char* U; const char* W; int g, r, nsub;
    DI const char* a_base(const pg8::Unit& u) const { const int b = u.pm >> 4, v0 = (u.pm & 15) * 256, rho = v0 / nsub, i0 = v0 % nsub; return U + (size_t)(b * SEQ + rho + r * i0) * 2048; }
    DI const char* b_base(const pg8::Unit& u) const { const int rw = (u.pn < 2 ? C_AQ : C_AK) + 512 * g + 256 * (u.pn & 1); return W + (size_t)rw * 2048; } };
struct EpiQK { bf16 *AQ, *AK;
    DI void operator()(int row, int col, f32x4 v0, f32x4 v1) const {
        if (col < 512) *(u32x4*)(AQ + blk_off(row, col, 32)) = pack8(v0, v1);
        else *(u32x4*)(AK + blk_off(row, col - 512, 32)) = pack8(v0, v1); } };
struct SchedGate : pg8::StaticOrder { const char* U; const char* W;
    DI const char* a_base(const pg8::Unit& u) const { return U + (size_t)u.pm * 256 * 2048; }
    DI const char* b_base(const pg8::Unit& u) const { return W + (size_t)(C_GA + 256 * u.pn) * 2048; } };
struct EpiGate { bf16 *GA, *GR;
    DI void operator()(int row, int col, f32x4 v0, f32x4 v1) const {
        f32x4 s0, s1;
#pragma unroll
        for (int e = 0; e < 4; ++e) { s0[e] = sigmoidf_(v0[e]); s1[e] = sigmoidf_(v1[e]); }
        bf16* dst = col < 1024 ? GA + (size_t)row * 1024 + col : GR + (size_t)row * 1024 + col - 1024;
        *(u32x4*)dst = pack8(s0, s1); } };
struct SchedA2 : pg8::StaticOrder { const char* U; const char* W; int g, r, nsub;
    DI const char* a_base(const pg8::Unit& u) const { return W + (size_t)(C_AV + 512 * g + 256 * u.pm) * 2048; }
    DI const char* b_base(const pg8::Unit& u) const { const int b = u.pn >> 4, v0 = (u.pn & 15) * 256, rho = v0 / nsub, i0 = v0 % nsub; return U + (size_t)(b * SEQ + rho + r * i0) * 2048; } };
struct EpiA2 { bf16* AVT;
    DI void operator()(int row, int col, f32x4 v0, f32x4 v1) const { *(u32x4*)(AVT + blk_off(row, col, 1024)) = pack8(v0, v1); } };
struct SchedG : pg8::StaticOrder { const char* A; const char* B; size_t abytes, bbytes;
    DI const char* a_base(const pg8::Unit& u) const { return A + (size_t)u.pm * abytes; }
    DI const char* b_base(const pg8::Unit& u) const { return B + (size_t)u.pn * bbytes; } };
struct EpiG1 { const bf16* GA; bf16* P1;
    DI void operator()(int row, int col, f32x4 v0, f32x4 v1) const {
        const u32x4 g = *(const u32x4*)(GA + (size_t)row * 1024 + col);
        f32x4 o0 = {v0[0] * bflo(g.x), v0[1] * bfhi(g.x), v0[2] * bflo(g.y), v0[3] * bfhi(g.y)}, o1 = {v1[0] * bflo(g.z), v1[1] * bfhi(g.z), v1[2] * bflo(g.w), v1[3] * bfhi(g.w)};
        *(u32x4*)(P1 + (size_t)row * 1024 + col) = pack8(o0, o1); } };
struct EpiG2 { const bf16* GR; const bf16* P1; bf16* MERGED;
    DI void operator()(int row, int col, f32x4 v0, f32x4 v1) const {
        const u32x4 g = *(const u32x4*)(GR + (size_t)row * 1024 + col);
        const u32x4 p = *(const u32x4*)(P1 + (size_t)row * 1024 + col);
        f32x4 o0 = {bflo(p.x) + v0[0] * bflo(g.x), bfhi(p.x) + v0[1] * bfhi(g.x), bflo(p.y) + v0[2] * bflo(g.y), bfhi(p.y) + v0[3] * bfhi(g.y)};
        f32x4 o1 = {bflo(p.z) + v1[0] * bflo(g.z), bfhi(p.z) + v1[1] * bfhi(g.z), bflo(p.w) + v1[2] * bflo(g.w), bfhi(p.w) + v1[3] * bfhi(g.w)};
        *(u32x4*)(MERGED + (size_t)row * 1024 + col) = pack8(o0, o1); } };
struct EpiG3 { const float* x; const float* MOD; float* H;
    DI void operator()(int row, int col, f32x4 v0, f32x4 v1) const {
        const int b = row >> 12; const float* gp = MOD + b * 6144 + 2048 + col; const float* xp = x + (size_t)row * 1024 + col;
        const f32x4 g0 = *(const f32x4*)gp, g1 = *(const f32x4*)(gp + 4), x0 = *(const f32x4*)xp, x1 = *(const f32x4*)(xp + 4);
        *(f32x4*)(H + (size_t)row * 1024 + col) = x0 * ALPHA + g0 * v0; *(f32x4*)(H + (size_t)row * 1024 + col + 4) = x1 * ALPHA + g1 * v1; } };
struct SchedM : pg8::StaticOrder { const char* A; const char* B; size_t abytes, ebytes, bbytes; const LAS int* texp;
    DI const char* a_base(const pg8::Unit& u) const { return A + (size_t)u.pm * abytes; }
    DI const char* b_base(const pg8::Unit& u) const { return B + (size_t)texp[u.pm] * ebytes + (size_t)u.pn * bbytes; } };
struct EpiM3 { bf16* HDN;
    DI void operator()(int row, int col, f32x4 a, f32x4 b) const {
        f32x4 o;
#pragma unroll
        for (int e = 0; e < 4; ++e) o[e] = a[e] * sigmoidf_(a[e]) * b[e];
        u32x2 w; w.x = pk2(o[0], o[1]); w.y = pk2(o[2], o[3]);
        *(u32x2*)(HDN + (size_t)row * 512 + (col >> 1)) = w; } };
struct EpiM4 { bf16* Y;
    DI void operator()(int row, int col, f32x4 v0, f32x4 v1) const { *(u32x4*)(Y + (size_t)row * 1024 + col) = pack8(v0, v1); } };

DI void ret_intra(Frame& F) {
    const int lane_ = F.lane;
    const bf16* RQ = (const bf16*)(F.ws + WS_RQ); const bf16* RK = (const bf16*)(F.ws + WS_RK); const bf16* RVT = (const bf16*)(F.ws + WS_RVT); bf16* Y = (bf16*)(F.ws + WS_Y);
    const float* DEC = (const float*)(F.ws + WS_DEC);
    const int r = lane_ & 31, h = lane_ >> 5;
    const int gw = F.vcu * NWAVES + F.wave, NGW = F.G * NWAVES;
    for (int it = gw; it < 4096; it += NGW) {
        const int dh = it & 1, ntl = (it >> 1) & 3, ch = (it >> 3) & 31, hd = (it >> 8) & 3, b = it >> 10;
        const int tok0 = b * SEQ + ch * 128, rb0 = tok0 >> 5;
        const float lf = DEC[hd], lb = DEC[4 + hd];
        f32x16 pT[4]; for (int i = 0; i < 4; ++i) pT[i] = zero16();
        const bf16* qp = RQ + ((size_t)(rb0 + ntl) * 64 + hd * 16) * 512 + lane_ * 8;
        const bf16* kp = RK + ((size_t)rb0 * 64 + hd * 16) * 512 + lane_ * 8;
#pragma unroll 4
        for (int ks = 0; ks < 16; ++ks) {
            const bf16x8 bq = ld16(qp + ks * 512);
#pragma unroll
            for (int mt = 0; mt < 4; ++mt) { const bf16x8 ak = ld16(kp + (size_t)mt * 64 * 512 + ks * 512); pT[mt] = MFMA32(ak, bq, pT[mt]); }
        }
        bf16x8 pb[4][2];
        const int n = 32 * ntl + r;
#pragma unroll
        for (int mt = 0; mt < 4; ++mt) {
#pragma unroll
            for (int i = 0; i < 16; ++i) { const int m = 32 * mt + crow(i, h); const int d = n - m;
                const float w = d >= 0 ? __builtin_amdgcn_exp2f(lf * (float)d) : __builtin_amdgcn_exp2f(lb * (float)(-d));
                pT[mt][i] *= w; }
            pb[mt][0] = pack_step(pT[mt], 0); pb[mt][1] = pack_step(pT[mt], 1);
        }
#pragma unroll 4
        for (int dt = 0; dt < 8; ++dt) {
            const int dv0 = hd * 512 + dh * 256 + dt * 32;
            const bf16* vp = RVT + ((size_t)(dv0 >> 5) * 1024 + (tok0 >> 4)) * 512 + r * 8 + 4 * h;
            f32x16 acc = zero16();
#pragma unroll
            for (int mt = 0; mt < 4; ++mt)
#pragma unroll
                for (int s2 = 0; s2 < 2; ++s2) { const bf16* bp = vp + (2 * mt + s2) * 512; acc = MFMA32(ld8x2(bp, bp + 256), pb[mt][s2], acc); }
            char* yp = (char*)Y + ((((size_t)(b * 4 + hd) * 32 + ch) * 4 + ntl) * 16 + dh * 8 + dt) * 2048 + lane_ * 32;
            u32x4 w0, w1;
            w0.x = pk2(acc[0], acc[1]); w0.y = pk2(acc[2], acc[3]); w0.z = pk2(acc[4], acc[5]); w0.w = pk2(acc[6], acc[7]);
            w1.x = pk2(acc[8], acc[9]); w1.y = pk2(acc[10], acc[11]); w1.z = pk2(acc[12], acc[13]); w1.w = pk2(acc[14], acc[15]);
            *(u32x4*)yp = w0; *(u32x4*)(yp + 16) = w1;
        }
    }
}
#define SBAR_ __builtin_amdgcn_sched_barrier(0)
constexpr int ST_SZ = 16 * 512, VT_SZ = 8 * 512, VT_OFF = 2 * 2 * ST_SZ;
DI bf16x8 ldg16(const char* base, unsigned off) { return *(const bf16x8*)(base + off); }
template <int VAR> DI void ret_scan(Frame& F) {
    const int lane_ = F.lane;
    const int r = lane_ & 31, h = lane_ >> 5, dir = F.wave >> 2, wg = F.wave & 3;
    LAS bf16* ST = (LAS bf16*)F.lds + dir * (2 * ST_SZ);
    LAS bf16* VT = (LAS bf16*)F.lds + VT_OFF + dir * (2 * VT_SZ);
    const unsigned loff = (unsigned)lane_ * 16u;
    const unsigned voff = (unsigned)(wg * 64 + lane_) * 32u;
    for (int unit = F.vcu; unit < 256; unit += F.G) {
        const int sl = unit & 15, hd = (unit >> 4) & 3, b = unit >> 6;
        const float lg = ((const float*)(F.ws + WS_DEC))[4 * dir + hd];
        const float cd = __builtin_amdgcn_exp2f(lg * 128.f);
        const float p = (float)(32 * wg + r);
        const float qd = dir ? __builtin_amdgcn_exp2f(lg * (128.f - p)) : __builtin_amdgcn_exp2f(lg * (p + 1.f));
        const char* qb = (const char*)(F.ws + WS_RQ) + (((size_t)(b * 128 + wg) * 64) + hd * 16) * 1024;
        const char* kb = (const char*)(F.ws + (dir ? WS_KBT : WS_KFT)) + ((size_t)(hd * 8 + 2 * wg) * 1024 + b * 256) * 1024;
        const char* vb = (const char*)(F.ws + WS_RVT) + ((size_t)(hd * 16 + sl) * 1024 + b * 256) * 1024;
        char* yb = VAR == 0 ? (char*)(F.ws + WS_Y) + ((((size_t)(b * 4 + hd) * 32) * 4 + wg) * 16 + sl) * 2048 : (char*)(F.ws + 339 * MiB) + (size_t)unit * 16384 + (dir * 4 + wg) * 2048;
#ifndef SCAN_SKEW
#define SCAN_SKEW 6
#endif
        if (sl != 0) { for (int z = 0; z < SCAN_SKEW; ++z) __builtin_amdgcn_s_sleep(16); }
        bf16x8 Qf[16], Kf0[8], Kf1[8];
        { const int c0 = dir ? 31 : 0, c1 = dir ? 30 : 1;
          const bf16x8 va = ldg16(vb + c0 * 8192, voff), vb2 = ldg16(vb + c0 * 8192, voff + 16);
#pragma unroll
          for (int ks = 0; ks < 8; ++ks) { Kf0[ks] = ldg16(kb + c0 * 8192, loff + 1024 * ks); Kf1[ks] = ldg16(kb + (size_t)1024 * 1024 + c0 * 8192, loff + 1024 * ks); }
#pragma unroll
          for (int ks = 0; ks < 16; ++ks) Qf[ks] = ldg16(qb + (size_t)c1 * 4 * 65536, loff + 1024 * ks);
          *(LAS bf16x8*)((LAS char*)VT + voff) = va; *(LAS bf16x8*)((LAS char*)VT + voff + 16) = vb2; }
        asm volatile("s_waitcnt lgkmcnt(0)" ::: "memory"); __builtin_amdgcn_s_barrier(); asm volatile("" ::: "memory");
        f32x16 S0 = zero16(), S1 = zero16();
        u32x4 yv0 = {0u, 0u, 0u, 0u}, yv1 = {0u, 0u, 0u, 0u};
#pragma unroll
        for (int step = 0; step < 32; ++step) {
            const int ch = dir ? 31 - step : step;
            int chn = dir ? ch - 1 : ch + 1; chn = chn < 0 ? 0 : (chn > 31 ? 31 : chn);
            const int cur = step & 1;
            char* yp = (VAR == 0 ? yb + (size_t)ch * 4 * 16 * 2048 : yb) + lane_ * 32;
            if ((step == 16 || step == 17) && VAR != 2 && VAR != 5) { yv0 = __builtin_nontemporal_load((const u32x4*)yp); yv1 = __builtin_nontemporal_load((const u32x4*)(yp + 16)); }
            if (step == 0 && VAR == 0) { const u32x4 z = {0u, 0u, 0u, 0u}; *(u32x4*)yp = z; *(u32x4*)(yp + 16) = z; }
            SBAR_;
            if (step > 0) {
                const LAS char* sp = (const LAS char*)(ST + cur * ST_SZ) + loff;
                f32x16 acc = zero16();
#pragma unroll
                for (int kg = 0; kg < 8; ++kg) {
                    bf16x8 as[2];
#pragma unroll
                    for (int k = 0; k < 2; ++k) as[k] = *(const LAS bf16x8*)(sp + 1024 * (2 * kg + k));
#pragma unroll
                    for (int k = 0; k < 2; ++k) acc = MFMA32(as[k], Qf[2 * kg + k], acc);
                    SBAR_;
                }
                u32x4 w0, w1;
#pragma unroll
                for (int k = 0; k < 4; ++k) {
                    if (step <= 15) { w0[k] = pk2(acc[2 * k] * qd, acc[2 * k + 1] * qd); w1[k] = pk2(acc[8 + 2 * k] * qd, acc[8 + 2 * k + 1] * qd); }
                    else { w0[k] = pk2(bflo(yv0[k]) + acc[2 * k] * qd, bfhi(yv0[k]) + acc[2 * k + 1] * qd); w1[k] = pk2(bflo(yv1[k]) + acc[8 + 2 * k] * qd, bfhi(yv1[k]) + acc[8 + 2 * k + 1] * qd); } }
                if (VAR == 2 || VAR == 5) asm volatile("" :: "v"(w0.x), "v"(w0.y), "v"(w0.z), "v"(w0.w), "v"(w1.x), "v"(w1.y), "v"(w1.z), "v"(w1.w)); else { *(u32x4*)yp = w0; *(u32x4*)(yp + 16) = w1; }
                SBAR_;
            }
            if (step < 31 && step + 1 >= 18 && VAR != 2 && VAR != 5) {
                const char* ypn = (VAR == 0 ? yb + (size_t)chn * 4 * 16 * 2048 : yb) + lane_ * 32;
                yv0 = __builtin_nontemporal_load((const u32x4*)ypn); yv1 = __builtin_nontemporal_load((const u32x4*)(ypn + 16)); }
            SBAR_;
            if (step > 0 && VAR != 3 && VAR != 5) {
#pragma unroll
                for (int ks = 0; ks < 16; ++ks) Qf[ks] = ldg16(qb + (size_t)chn * 4 * 65536, loff + 1024 * ks);
            }
            SBAR_;
            const bf16x8 vn0 = ldg16(vb + chn * 8192, voff), vn1 = ldg16(vb + chn * 8192, voff + 16);
            if (step < 31) {
#pragma unroll
                for (int i = 0; i < 16; ++i) { S0[i] *= cd; S1[i] *= cd; }
                const LAS char* vp = (const LAS char*)(VT + cur * VT_SZ) + loff;
#pragma unroll
                for (int kg = 0; kg < 2; ++kg) {
                    bf16x8 bv[4];
#pragma unroll
                    for (int k = 0; k < 4; ++k) bv[k] = *(const LAS bf16x8*)(vp + 1024 * (4 * kg + k));
#pragma unroll
                    for (int k = 0; k < 4; ++k) { S0 = MFMA32(Kf0[4 * kg + k], bv[k], S0); S1 = MFMA32(Kf1[4 * kg + k], bv[k], S1); }
                    SBAR_;
                }
                if (VAR != 4 && VAR != 5) {
#pragma unroll
                for (int ks = 0; ks < 8; ++ks) { Kf0[ks] = ldg16(kb + chn * 8192, loff + 1024 * ks); Kf1[ks] = ldg16(kb + (size_t)1024 * 1024 + chn * 8192, loff + 1024 * ks); } }
                SBAR_;
                LAS char* vw = (LAS char*)(VT + (cur ^ 1) * VT_SZ) + voff;
                *(LAS bf16x8*)vw = vn0; *(LAS bf16x8*)(vw + 16) = vn1;
                LAS bf16* wp = ST + (cur ^ 1) * ST_SZ + (4 * wg) * 512 + r * 8 + 4 * h;
#pragma unroll
                for (int g = 0; g < 4; ++g) {
                    u32x2 w0; w0.x = pk2(S0[4 * g], S0[4 * g + 1]); w0.y = pk2(S0[4 * g + 2], S0[4 * g + 3]); *(LAS u32x2*)(wp + (g >> 1) * 512 + (g & 1) * 256) = w0;
                    u32x2 w1; w1.x = pk2(S1[4 * g], S1[4 * g + 1]); w1.y = pk2(S1[4 * g + 2], S1[4 * g + 3]); *(LAS u32x2*)(wp + (2 + (g >> 1)) * 512 + (g & 1) * 256) = w1; }
            }
            if (step >= 12 && step <= 18) asm volatile("s_waitcnt vmcnt(0)" ::: "memory");
            asm volatile("s_waitcnt lgkmcnt(0)" ::: "memory"); __builtin_amdgcn_s_barrier(); asm volatile("" ::: "memory"); SBAR_;
        }
        VM_WAIT();
    }
}
template <bool DRY> DI void ret_norm(Frame& F) {
    const int lane_ = F.lane;
    char* Y = (char*)(F.ws + WS_Y); bf16* RG = (bf16*)(F.ws + WS_RG); bf16* OUTP = DRY ? (bf16*)(F.ws + WS_RQ) : RG; const float* gain = F.in[8];
    const bf16* RQ = (const bf16*)(F.ws + WS_RQ); const bf16* RK = (const bf16*)(F.ws + WS_RK); const bf16* RVT = (const bf16*)(F.ws + WS_RVT);
    const float* DEC = (const float*)(F.ws + WS_DEC);
    const int r = lane_ & 31, h = lane_ >> 5;
    LAS char* T = (LAS char*)F.lds + F.wave * (32 * 272);
    const int gw = F.vcu * NWAVES + F.wave, NGW = F.G * NWAVES;
    for (int it = gw; it < 2048; it += NGW) {
        const int ntl = it & 3, ch = (it >> 2) & 31, hd = (it >> 7) & 3, b = it >> 9;
        char* yp = Y + ((size_t)it * 16) * 2048 + lane_ * 32;
        const int tokc = b * SEQ + ch * 128, rb0 = tokc >> 5;
        const size_t tok0 = (size_t)tokc + 32 * ntl;
        const float lf = DEC[hd], lb = DEC[4 + hd];
        bf16x8 pb[4][2];
        { f32x16 pT[4]; for (int i = 0; i < 4; ++i) pT[i] = zero16();
          const bf16* qp = RQ + ((size_t)(rb0 + ntl) * 64 + hd * 16) * 512 + lane_ * 8;
          const bf16* kp = RK + ((size_t)rb0 * 64 + hd * 16) * 512 + lane_ * 8;
#pragma unroll 4
          for (int ks = 0; ks < 16; ++ks) {
              const bf16x8 bq = ld16(qp + ks * 512);
#pragma unroll
              for (int mt = 0; mt < 4; ++mt) { const bf16x8 ak = ld16(kp + (size_t)mt * 64 * 512 + ks * 512); pT[mt] = MFMA32(ak, bq, pT[mt]); }
          }
          const int n = 32 * ntl + r;
#pragma unroll
          for (int mt = 0; mt < 4; ++mt) {
#pragma unroll
              for (int i = 0; i < 16; ++i) { const int m = 32 * mt + crow(i, h); const int d = n - m;
                  const float w = d >= 0 ? __builtin_amdgcn_exp2f(lf * (float)d) : __builtin_amdgcn_exp2f(lb * (float)(-d));
                  pT[mt][i] *= w; }
              pb[mt][0] = pack_step(pT[mt], 0); pb[mt][1] = pack_step(pT[mt], 1);
          } }
        float s = 0.f, s2 = 0.f;
#pragma unroll 4
        for (int dvt = 0; dvt < 16; ++dvt) {
            const bf16* vp = RVT + ((size_t)(hd * 16 + dvt) * 1024 + (tokc >> 4)) * 512 + r * 8 + 4 * h;
            const u32x4 a = *(const u32x4*)(yp + dvt * 2048), c = *(const u32x4*)(yp + dvt * 2048 + 16);
            f32x16 acc = zero16();
#pragma unroll
            for (int mt = 0; mt < 4; ++mt)
#pragma unroll
                for (int s2i = 0; s2i < 2; ++s2i) { const bf16* bp = vp + (2 * mt + s2i) * 512; acc = MFMA32(ld8x2(bp, bp + 256), pb[mt][s2i], acc); }
            u32x4 wa, wc;
#pragma unroll
            for (int k = 0; k < 4; ++k) { wa[k] = pk2(bflo(a[k]) + acc[2 * k], bfhi(a[k]) + acc[2 * k + 1]); wc[k] = pk2(bflo(c[k]) + acc[8 + 2 * k], bfhi(c[k]) + acc[8 + 2 * k + 1]); }
#pragma unroll
            for (int k = 0; k < 4; ++k) { const float x0 = bflo(wa[k]), x1 = bfhi(wa[k]), x2 = bflo(wc[k]), x3 = bfhi(wc[k]); s += (x0 + x1) + (x2 + x3); s2 += (x0 * x0 + x1 * x1) + (x2 * x2 + x3 * x3); }
            *(u32x4*)(yp + dvt * 2048) = wa; *(u32x4*)(yp + dvt * 2048 + 16) = wc;
        }
        s += __shfl_xor(s, 32); s2 += __shfl_xor(s2, 32);
        const float mean = s * (1.f / 512.f);
        const float var = fmaxf(s2 * (1.f / 512.f) - mean * mean, 0.f);
        const float rstd = 1.f / sqrtf(var + LN_EPS);
        VM_WAIT();
#pragma unroll 1
        for (int grp = 0; grp < 4; ++grp) {
#pragma unroll
            for (int t = 0; t < 4; ++t) {
                const u32x4 a = *(const u32x4*)(yp + (4 * grp + t) * 2048), c = *(const u32x4*)(yp + (4 * grp + t) * 2048 + 16);
                const u32x2 av[4] = {{a.x, a.y}, {a.z, a.w}, {c.x, c.y}, {c.z, c.w}};
#pragma unroll
                for (int q = 0; q < 4; ++q) { u32x2 w; w.x = pk2((bflo(av[q].x) - mean) * rstd, (bfhi(av[q].x) - mean) * rstd); w.y = pk2((bflo(av[q].y) - mean) * rstd, (bfhi(av[q].y) - mean) * rstd);
                    *(LAS u32x2*)(T + r * 272 + (32 * t + 8 * q + 4 * h) * 2) = w; }
            }
            LDS_WAIT(); asm volatile("" ::: "memory");
#pragma unroll
            for (int k = 0; k < 8; ++k) {
                const int task = lane_ + 64 * k, tk = task >> 4, cchunk = task & 15;
                const u32x4 v = *(const LAS u32x4*)(T + tk * 272 + cchunk * 16);
                const int col = hd * 512 + 128 * grp + 8 * cchunk;
                const size_t off = (tok0 + tk) * 2048 + col;
                const u32x4 gwv = *(const u32x4*)(RG + off); const f32x4 ga = *(const f32x4*)(gain + col), gb = *(const f32x4*)(gain + col + 4);
                float o[8];
#pragma unroll
                for (int e = 0; e < 4; ++e) { const float g0 = bflo(gwv[e]), g1 = bfhi(gwv[e]); const float n0 = e < 2 ? ga[2 * e] : gb[2 * e - 4], n1 = e < 2 ? ga[2 * e + 1] : gb[2 * e - 3];
                    o[2 * e] = g0 * sigmoidf_(g0) * bflo(v[e]) * n0; o[2 * e + 1] = g1 * sigmoidf_(g1) * bfhi(v[e]) * n1; }
                u32x4 w; w.x = pk2(o[0], o[1]); w.y = pk2(o[2], o[3]); w.z = pk2(o[4], o[5]); w.w = pk2(o[6], o[7]);
                *(u32x4*)(OUTP + off) = w;
            }
            LDS_WAIT(); asm volatile("" ::: "memory");
        }
    }
}

DI void attn_phase(Frame& F) {
    const int lane_ = F.lane;
    float* LSE = (float*)(F.ws + WS_LSE);
    const int r = lane_ & 31, h = lane_ >> 5;
    const int gw = F.vcu * NWAVES + F.wave, NGW = F.G * NWAVES;
    for (int it = gw; it < 6144; it += NGW) {
        const int g = it >> 11, rem = it & 2047;
        const int dil = g == 0 ? 1 : (g == 1 ? 4 : 16), nsub = SEQ / dil, nqt = nsub >> 5;
        const int qt = rem % nqt; const int rem2 = rem / nqt; const int rho = rem2 % dil; const int bh = rem2 / dil; const int hg = bh & 3, b = bh >> 2;
        const int head = 4 * g + hg;
        const float slope = __builtin_amdgcn_exp2f(-8.f * (float)(head + 1) * (1.f / 12.f)) * (float)dil;
        const bf16* AQ = (const bf16*)(F.ws + WS_AQ + (size_t)g * 16 * MiB); const bf16* AK = (const bf16*)(F.ws + WS_AK + (size_t)g * 16 * MiB);
        const bf16* AVT = (const bf16*)(F.ws + WS_AVT) + (size_t)g * 512 * NT;
        bf16* OG = (bf16*)(F.ws + (g == 0 ? WS_O0 : (g == 1 ? WS_O1 : WS_O2)));
        const int i0 = 32 * qt;
        const int v0 = b * SEQ + rho * nsub;
        const size_t tokbase = (size_t)b * SEQ + rho;
        bf16x8 bq[8];
        { const bf16* qp = AQ + ((size_t)((v0 + i0) >> 5) * 32 + hg * 8) * 512 + lane_ * 8;
#pragma unroll
          for (int ks = 0; ks < 8; ++ks) bq[ks] = ld16(qp + ks * 512); }
        f32x16 sT[5];
#pragma unroll
        for (int kt = 0; kt < 5; ++kt) {
            int ik0 = i0 - 64 + 32 * kt; ik0 = ik0 < 0 ? 0 : (ik0 >= nsub ? nsub - 32 : ik0);
            const bf16* kp = AK + ((size_t)((v0 + ik0) >> 5) * 32 + hg * 8) * 512 + lane_ * 8;
            f32x16 acc = zero16();
#pragma unroll
            for (int ks = 0; ks < 8; ++ks) acc = MFMA32(ld16(kp + ks * 512), bq[ks], acc);
            sT[kt] = acc;
        }
        const int iq = i0 + r;
        float mx = -3.0e38f;
#pragma unroll
        for (int kt = 0; kt < 5; ++kt)
#pragma unroll
            for (int i = 0; i < 16; ++i) { const int ik = i0 - 64 + 32 * kt + crow(i, h); const int d = ik - iq; const int ad = d < 0 ? -d : d;
                const bool valid = (ad <= 64) && (ik >= 0) && (ik < nsub);
                const float sc = valid ? sT[kt][i] * 0.08838834764831845f - slope * (float)ad : -1e30f;
                sT[kt][i] = sc; mx = fmaxf(mx, sc); }
        mx = fmaxf(mx, __shfl_xor(mx, 32));
        float sum = 0.f;
#pragma unroll
        for (int kt = 0; kt < 5; ++kt)
#pragma unroll
            for (int i = 0; i < 16; ++i) { const float p = __expf(sT[kt][i] - mx); sT[kt][i] = p; sum += p; }
        sum += __shfl_xor(sum, 32);
        const float inv = 1.f / sum;
        if (h == 0) LSE[((size_t)g * NT + tokbase + (size_t)dil * iq) * 4 + hg] = mx + __logf(sum);
        bf16x8 pb[5][2];
#pragma unroll
        for (int kt = 0; kt < 5; ++kt) { pb[kt][0] = pack_step(sT[kt], 0); pb[kt][1] = pack_step(sT[kt], 1); }
        bf16* op = OG + (tokbase + (size_t)dil * iq) * 512 + hg * 128 + 4 * h;
#pragma unroll
        for (int dt = 0; dt < 4; ++dt) {
            const bf16* vp = AVT + ((size_t)(hg * 4 + dt) * 1024) * 512 + r * 8 + 4 * h;
            f32x16 acc = zero16();
#pragma unroll
            for (int kt = 0; kt < 5; ++kt) {
                int ik0 = i0 - 64 + 32 * kt; ik0 = ik0 < 0 ? 0 : (ik0 >= nsub ? nsub - 32 : ik0);
                const bf16* bp = vp + (size_t)((v0 + ik0) >> 4) * 512;
#pragma unroll
                for (int s2 = 0; s2 < 2; ++s2) acc = MFMA32(ld8x2(bp + s2 * 512, bp + s2 * 512 + 256), pb[kt][s2], acc);
            }
#pragma unroll
            for (int q = 0; q < 4; ++q) { u32x2 w; w.x = pk2(acc[4 * q] * inv, acc[4 * q + 1] * inv); w.y = pk2(acc[4 * q + 2] * inv, acc[4 * q + 3] * inv); *(u32x2*)(op + 32 * dt + 8 * q) = w; }
        }
    }
}
DI void attn_mix(Frame& F) {
    const int lane_ = opaque_lane(F);
    const bf16* O0 = (const bf16*)(F.ws + WS_O0); const bf16* O1 = (const bf16*)(F.ws + WS_O1); const bf16* O2 = (const bf16*)(F.ws + WS_O2);
    const float* LSE = (const float*)(F.ws + WS_LSE); bf16* MIX = (bf16*)(F.ws + WS_ATTMIX);
    const int gw = F.bx * NWAVES + F.wave, NGW = F.G * NWAVES;
    for (int m = gw; m < NT; m += NGW) {
        const int hg = lane_ >> 4;
        const float l0 = LSE[((size_t)0 * NT + m) * 4 + hg], l1 = LSE[((size_t)1 * NT + m) * 4 + hg], l2 = LSE[((size_t)2 * NT + m) * 4 + hg];
        const float mx = fmaxf(l0, fmaxf(l1, l2)); const float e0 = __expf(l0 - mx), e1 = __expf(l1 - mx), e2 = __expf(l2 - mx); const float inv = 1.f / (e0 + e1 + e2);
        const float w0 = e0 * inv, w1 = e1 * inv, w2 = e2 * inv;
        const size_t off = (size_t)m * 512 + 8 * lane_;
        const u32x4 a = *(const u32x4*)(O0 + off), b = *(const u32x4*)(O1 + off), c = *(const u32x4*)(O2 + off);
        u32x4 o;
        o.x = pk2(w0 * bflo(a.x) + w1 * bflo(b.x) + w2 * bflo(c.x), w0 * bfhi(a.x) + w1 * bfhi(b.x) + w2 * bfhi(c.x));
        o.y = pk2(w0 * bflo(a.y) + w1 * bflo(b.y) + w2 * bflo(c.y), w0 * bfhi(a.y) + w1 * bfhi(b.y) + w2 * bfhi(c.y));
        o.z = pk2(w0 * bflo(a.z) + w1 * bflo(b.z) + w2 * bflo(c.z), w0 * bfhi(a.z) + w1 * bfhi(b.z) + w2 * bfhi(c.z));
        o.w = pk2(w0 * bflo(a.w) + w1 * bflo(b.w) + w2 * bflo(c.w), w0 * bfhi(a.w) + w1 * bfhi(b.w) + w2 * bfhi(c.w));
        *(u32x4*)(MIX + off) = o;
    }
}

DI float reduce4(const float (&p)[4], int lane) {
    const bool hi = (lane & 32) != 0;
    float a0 = hi ? p[2] : p[0], a1 = hi ? p[3] : p[1]; const float b0 = hi ? p[0] : p[2], b1 = hi ? p[1] : p[3];
    a0 += __shfl_xor(b0, 32); a1 += __shfl_xor(b1, 32);
    const bool hi2 = (lane & 16) != 0;
    float c = hi2 ? a1 : a0; const float d = hi2 ? a0 : a1;
    c += __shfl_xor(d, 16);
    c += __shfl_xor(c, 8); c += __shfl_xor(c, 4); c += __shfl_xor(c, 2); c += __shfl_xor(c, 1);
    return c;
}
DI void bcast4(float c, float (&o)[4]) {
#pragma unroll
    for (int t = 0; t < 4; ++t) o[t] = __builtin_bit_cast(float, __builtin_amdgcn_readlane(__builtin_bit_cast(int, c), 16 * t));
}
template <bool DRY> DI void moe_route(Frame& F) {
    const int lane_ = opaque_lane(F);
    float* H = (float*)F.outb; float* HO = DRY ? (float*)(F.ws + WS_XG) : H; const float* MOD = (const float*)(F.ws + WS_MOD); const float* WR = (const float*)(F.ws + WS_WROUT);
    bf16* U2 = (bf16*)(F.ws + (DRY ? WS_XG + 64 * MiB : WS_U2)); unsigned* ROUTE = (unsigned*)(F.ws + (DRY ? WS_XG + 100 * MiB : WS_ROUTE)); unsigned* CNT = (unsigned*)(F.ws + WS_CTL) + CW_CNT + (DRY ? 4096 : 0);
    const float* g1 = F.in[11]; const float* b1 = F.in[12]; const float* bco = F.in[14]; const float* bfi = F.in[16];
    LAS float* lg = (LAS float*)F.lds + F.wave * 256;
    const int gw = F.bx * NWAVES + F.wave, NGW = F.G * NWAVES;
    f32x4 un[4][4];
    { const int m0 = gw * 4;
      if (m0 < NT) {
#pragma unroll
        for (int t = 0; t < 4; ++t) { const f32x4* hr = (const f32x4*)(H + (size_t)(m0 + t) * DM) + lane_;
#pragma unroll
            for (int j = 0; j < 4; ++j) un[t][j] = hr[64 * j]; } } }
    for (int m0 = gw * 4; m0 < NT; m0 += NGW * 4) {
        const int b = m0 >> 12;
        f32x4 u[4][4];
        float ps[4], tot[4];
#pragma unroll
        for (int t = 0; t < 4; ++t) { float s = 0.f;
#pragma unroll
            for (int j = 0; j < 4; ++j) { u[t][j] = un[t][j]; s += (u[t][j].x + u[t][j].y) + (u[t][j].z + u[t][j].w); }
            ps[t] = s; }
        { const int m1 = m0 + NGW * 4;
          if (m1 < NT) {
#pragma unroll
            for (int t = 0; t < 4; ++t) { const f32x4* hr = (const f32x4*)(H + (size_t)(m1 + t) * DM) + lane_;
#pragma unroll
                for (int j = 0; j < 4; ++j) un[t][j] = hr[64 * j]; } } }
        bcast4(reduce4(ps, lane_), tot);
#pragma unroll
        for (int t = 0; t < 4; ++t) { const float mean = tot[t] * (1.f / DM); float s2 = 0.f;
#pragma unroll
            for (int j = 0; j < 4; ++j) { u[t][j] = u[t][j] - mean; s2 += (u[t][j].x * u[t][j].x + u[t][j].y * u[t][j].y) + (u[t][j].z * u[t][j].z + u[t][j].w * u[t][j].w); }
            ps[t] = s2; }
        bcast4(reduce4(ps, lane_), tot);
#pragma unroll
        for (int t = 0; t < 4; ++t) { const float rstd = 1.f / sqrtf(tot[t] * (1.f / DM) + LN_EPS); f32x4* hw = (f32x4*)(HO + (size_t)(m0 + t) * DM) + lane_; float s = 0.f;
#pragma unroll
            for (int j = 0; j < 4; ++j) { const int col = 256 * j + 4 * lane_; const f32x4 gg = *(const f32x4*)(g1 + col), bb = *(const f32x4*)(b1 + col);
                u[t][j] = u[t][j] * rstd * gg + bb; hw[64 * j] = u[t][j]; s += (u[t][j].x + u[t][j].y) + (u[t][j].z + u[t][j].w); }
            ps[t] = s; }
        bcast4(reduce4(ps, lane_), tot);
#pragma unroll
        for (int t = 0; t < 4; ++t) { const float mean = tot[t] * (1.f / DM); float s2 = 0.f;
#pragma unroll
            for (int j = 0; j < 4; ++j) { u[t][j] = u[t][j] - mean; s2 += (u[t][j].x * u[t][j].x + u[t][j].y * u[t][j].y) + (u[t][j].z * u[t][j].z + u[t][j].w * u[t][j].w); }
            ps[t] = s2; }
        bcast4(reduce4(ps, lane_), tot);
#pragma unroll
        for (int t = 0; t < 4; ++t) { const float rstd = 1.f / sqrtf(tot[t] * (1.f / DM) + LN_EPS); u32x2* o8 = (u32x2*)(U2 + (size_t)(m0 + t) * DM) + lane_;
#pragma unroll
            for (int j = 0; j < 4; ++j) { const int col = 256 * j + 4 * lane_;
                const f32x4 sh = *(const f32x4*)(MOD + b * 6144 + 3072 + col), sc = *(const f32x4*)(MOD + b * 6144 + 4096 + col);
                u[t][j] = u[t][j] * rstd * (sc + 1.f) + sh;
                u32x2 w; w.x = pk2(u[t][j].x, u[t][j].y); w.y = pk2(u[t][j].z, u[t][j].w); o8[64 * j] = w; } }
#ifndef ROUTE_NO
#define ROUTE_NO 36
#endif
#pragma unroll 2
        for (int o = 0; o < (DRY ? ROUTE_NO : 36); ++o) {
            const f32x4* wr = (const f32x4*)(WR + o * 1024) + lane_;
            f32x4 w[4];
#pragma unroll
            for (int j = 0; j < 4; ++j) w[j] = wr[64 * j];
#pragma unroll
            for (int t = 0; t < 4; ++t) { float a = 0.f;
#pragma unroll
                for (int j = 0; j < 4; ++j) a += (u[t][j].x * w[j].x + u[t][j].y * w[j].y) + (u[t][j].z * w[j].z + u[t][j].w * w[j].w);
                ps[t] = a; }
            const float c = reduce4(ps, lane_);
            if ((lane_ & 15) == 0) lg[(lane_ >> 4) * 64 + o] = c;
        }
        LDS_WAIT(); asm volatile("" ::: "memory");
        if (lane_ < 4) {
            const int t = lane_, m = m0 + t; const LAS float* L = lg + t * 64;
            float c[4]; int gs = 0; float cm = -3.0e38f;
#pragma unroll
            for (int j = 0; j < 4; ++j) { c[j] = L[j] + bco[j]; if (c[j] > cm) { cm = c[j]; gs = j; } }
            float den = 0.f;
#pragma unroll
            for (int j = 0; j < 4; ++j) den += __expf(c[j] - cm);
            const float pg = 1.f / den;
            float f[8];
#pragma unroll
            for (int e = 0; e < 8; ++e) f[e] = L[4 + 8 * gs + e] + bfi[8 * gs + e];
            int i0 = 0; float v0 = f[0];
#pragma unroll
            for (int e = 1; e < 8; ++e) if (f[e] > v0) { v0 = f[e]; i0 = e; }
            int i1 = -1; float v1 = -3.0e38f;
#pragma unroll
            for (int e = 0; e < 8; ++e) if (e != i0 && f[e] > v1) { v1 = f[e]; i1 = e; }
            const float e1 = __expf(v1 - v0); const float w0 = pg / (1.f + e1), w1 = pg * e1 / (1.f + e1);
            const int ex0 = gs * 8 + i0, ex1 = gs * 8 + i1;
            const unsigned p0 = atomicAdd(CNT + 64 * ex0, 1u), p1 = atomicAdd(CNT + 64 * ex1, 1u);
            unsigned* R = ROUTE + (size_t)m * 8;
            R[0] = ex0; R[1] = ex1; R[2] = p0; R[3] = p1; R[4] = __float_as_uint(w0); R[5] = __float_as_uint(w1);
        }
        LDS_WAIT(); asm volatile("" ::: "memory");
    }
}
DI int moe_tables(Frame& F) {
    LAS int* tab = (LAS int*)(F.lds + TEXP_OFF);
    if (F.tid == 0) {
        const unsigned* CNT = (const unsigned*)(F.ws + WS_CTL) + CW_CNT;
        int t = 0;
        for (int e = 0; e < 32; ++e) { const int c = (int)xb_ld((unsigned*)CNT + 64 * e); const int nt = (c + 255) >> 8; tab[192 + e] = t * 256; for (int k = 0; k < nt; ++k) tab[t + k] = e; t += nt; }
        tab[224] = t;
    }
    __syncthreads();
    return tab[224];
}
DI void moe_gather(Frame& F) {
    const int lane_ = opaque_lane(F);
    const LAS int* tab = (const LAS int*)(F.lds + TEXP_OFF);
    const bf16* U2 = (const bf16*)(F.ws + WS_U2); bf16* XG = (bf16*)(F.ws + WS_XG); unsigned* ROUTE = (unsigned*)(F.ws + WS_ROUTE);
    const int gw = F.bx * NWAVES + F.wave, NGW = F.G * NWAVES;
    for (int a = gw; a < 2 * NT; a += NGW) {
        const int m = a >> 1, k = a & 1;
        const unsigned e = ROUTE[(size_t)m * 8 + k], pos = ROUTE[(size_t)m * 8 + 2 + k];
        const int slot = tab[192 + e] + (int)pos;
        const u32x4* src = (const u32x4*)(U2 + (size_t)m * DM) + lane_; u32x4* dst = (u32x4*)(XG + (size_t)slot * DM) + lane_;
        dst[0] = src[0]; dst[64] = src[64];
        if (lane_ == 0) ROUTE[(size_t)m * 8 + 6 + k] = (unsigned)slot;
    }
}
template <bool DRY> DI void moe_combine(Frame& F) {
    const int lane_ = opaque_lane(F);
    float* H = (float*)F.outb; float* HO = DRY ? (float*)(F.ws + WS_XG) : H; const float* MOD = (const float*)(F.ws + WS_MOD); const bf16* YR = (const bf16*)(F.ws + WS_YROWS); const unsigned* ROUTE = (const unsigned*)(F.ws + WS_ROUTE);
    const float* g2 = F.in[20]; const float* b2 = F.in[21];
    const int gw = F.bx * NWAVES + F.wave, NGW = F.G * NWAVES;
    for (int m = gw; m < NT; m += NGW) {
        const int b = m >> 12; const unsigned* R = ROUTE + (size_t)m * 8;
        const float w0 = __uint_as_float(R[4]), w1 = __uint_as_float(R[5]); const size_t s0 = R[6], s1 = R[7];
        f32x4* hr = (f32x4*)(H + (size_t)m * DM) + lane_; f32x4* hw = (f32x4*)(HO + (size_t)m * DM) + lane_;
        f32x4 v[4]; float s = 0.f;
#pragma unroll
        for (int j = 0; j < 4; ++j) { const int col = 256 * j + 4 * lane_;
            const u32x2 ya = *(const u32x2*)(YR + s0 * DM + col), yb = *(const u32x2*)(YR + s1 * DM + col);
            const f32x4 y = {w0 * bflo(ya.x) + w1 * bflo(yb.x), w0 * bfhi(ya.x) + w1 * bfhi(yb.x), w0 * bflo(ya.y) + w1 * bflo(yb.y), w0 * bfhi(ya.y) + w1 * bfhi(yb.y)};
            const f32x4 gt = *(const f32x4*)(MOD + b * 6144 + 5120 + col);
            v[j] = hr[64 * j] * ALPHA + gt * y; s += (v[j].x + v[j].y) + (v[j].z + v[j].w); }
        const float mean = wave_sum(s) * (1.f / DM); float s2 = 0.f;
#pragma unroll
        for (int j = 0; j < 4; ++j) { v[j] = v[j] - mean; s2 += (v[j].x * v[j].x + v[j].y * v[j].y) + (v[j].z * v[j].z + v[j].w * v[j].w); }
        const float rstd = 1.f / sqrtf(wave_sum(s2) * (1.f / DM) + LN_EPS);
#pragma unroll
        for (int j = 0; j < 4; ++j) { const int col = 256 * j + 4 * lane_; hw[64 * j] = v[j] * rstd * *(const f32x4*)(g2 + col) + *(const f32x4*)(b2 + col); }
    }
}

__global__ void __launch_bounds__(NTHREADS, 2) fwd_kernel(Args args) {
    extern __shared__ __attribute__((aligned(16))) unsigned char lds[];
    Frame F;
    F.lds = (LAS unsigned char*)lds;
    F.tid = threadIdx.x; F.lane = F.tid & 63; F.wave = __builtin_amdgcn_readfirstlane(F.tid >> 6);
    F.G = gridDim.x; F.bx = blockIdx.x; F.vcu = (F.G % 8 == 0) ? (F.bx % 8) * (F.G / 8) + F.bx / 8 : F.bx;
    F.ws = args.ws; F.outb = (unsigned char*)args.out;
#pragma unroll
    for (int i = 0; i < 22; ++i) F.in[i] = args.in[i];
    for (int u = F.tid; u < (LDS_BYTES - LDSX_OFF) / 4; u += NTHREADS) ((LAS unsigned*)(F.lds + LDSX_OFF))[u] = 0u;
    __syncthreads();
    unsigned* ctl = (unsigned*)(F.ws + WS_CTL);
    XcdBarrier bar = xcd_barrier_post(ctl + CW_BAR, (volatile LAS unsigned*)(F.lds + MISC_OFF) + 8);
    if (F.tid == 0) ((volatile LAS unsigned*)(F.lds + MISC_OFF))[12] = xb_add(ctl + CW_RANK + 64 * bar.x, 1u);
    unsigned long long* TS = (unsigned long long*)(ctl + 32768);
    int nst = 1;
    if (PROF && F.bx == 0 && F.tid == 0) TS[0] = __builtin_amdgcn_s_memrealtime();
#define GRID_BAR() do { xcd_barrier(bar); if (PROF && F.bx == 0 && F.tid == 0) TS[nst] = __builtin_amdgcn_s_memrealtime(); ++nst; } while (0)
    const char* U = (const char*)(F.outb + OUT_U); const char* WINT = (const char*)(F.outb + OUT_WINT);

    REP(1,  phase0(F); GRID_BAR();
    phase1(F); GRID_BAR(); );
    { volatile LAS unsigned* M = (volatile LAS unsigned*)(F.lds + MISC_OFF);
      if (F.tid == 0) { unsigned pre = 0, nx = 0, mine = 0, even = 1, idx = 0;
          for (unsigned j = 0; j < 16; ++j) { const unsigned cj = xb_ld(ctl + CW_BAR + XB_XCNT(j)); if (j < bar.x) { pre += cj; idx += (cj > 0u); } if (j == bar.x) mine = cj; nx += (cj > 0u); if (cj != 0u && cj * 8u != (unsigned)F.G) even = 0; }
          const unsigned rank = M[12];
          M[13] = pre + rank; M[14] = (even && nx == 8u) ? rank * 8u + idx : (unsigned)F.bx; (void)mine; }
      __syncthreads();
      F.vcu = (int)M[13]; }
    const int c = (int)((volatile LAS unsigned*)(F.lds + MISC_OFF))[14];
    REP(2,
    { SchedR1 S; S.init(64, 16, F.G, c); S.U = U; S.W = WINT;
      pg8::EpiV<EpiR1> E{EpiR1{(bf16*)(F.ws + WS_RQ), (bf16*)(F.ws + WS_RK), (bf16*)(F.ws + WS_RG)}};
      pg8::gemm_phase<pg8::EpiV<EpiR1>, SchedR1, true>(F.lds, 1024, 1024, 1024, S, E); }
    { SchedR2 S; S.init(12, 64, F.G, c); S.U = U; S.W = WINT;
      pg8::EpiV<EpiR2> E{EpiR2{(bf16*)(F.ws + WS_RVT), (bf16*)(F.ws + WS_KFT), (bf16*)(F.ws + WS_KBT), (const float*)(F.ws + WS_DEC)}};
      pg8::gemm_phase<pg8::EpiV<EpiR2>, SchedR2, true>(F.lds, 1024, 1024, 1024, S, E); }
    GRID_BAR(); );
    REP(3, ret_scan<0>(F); GRID_BAR(); );
#ifndef SVAR
#define SVAR 1
#endif
    REPX(15, ret_scan<SVAR>(F); GRID_BAR(); );
    ret_norm<false>(F); GRID_BAR();
    REP(4,
    _Pragma("unroll 1")
    for (int g = 0; g < 3; ++g) {
        const int dil = g == 0 ? 1 : (g == 1 ? 4 : 16);
        SchedQK S; S.init(64, 4, F.G, c); S.U = U; S.W = WINT; S.g = g; S.r = dil; S.nsub = SEQ / dil;
        pg8::EpiV<EpiQK> E{EpiQK{(bf16*)(F.ws + WS_AQ + (size_t)g * 16 * MiB), (bf16*)(F.ws + WS_AK + (size_t)g * 16 * MiB)}};
        pg8::gemm_phase<pg8::EpiV<EpiQK>, SchedQK, true>(F.lds, 1024, 1024 * dil, 1024, S, E);
    }
    { SchedGate S; S.init(64, 8, F.G, c); S.U = U; S.W = WINT;
      pg8::EpiV<EpiGate> E{EpiGate{(bf16*)(F.ws + WS_GA), (bf16*)(F.ws + WS_GR)}};
      pg8::gemm_phase<pg8::EpiV<EpiGate>, SchedGate, true>(F.lds, 1024, 1024, 1024, S, E); }
_Pragma("unroll 1")
    for (int g = 0; g < 3; ++g) {
        const int dil = g == 0 ? 1 : (g == 1 ? 4 : 16);
        SchedA2 S; const int cc = (g == 1) ? c - 128 : c; S.init(2, 64, F.G, (cc >= 0 && cc < 128) ? cc : -1); S.U = U; S.W = WINT; S.g = g; S.r = dil; S.nsub = SEQ / dil;
        pg8::EpiV<EpiA2> E{EpiA2{(bf16*)(F.ws + WS_AVT) + (size_t)g * 512 * NT}};
        pg8::gemm_phase<pg8::EpiV<EpiA2>, SchedA2, true>(F.lds, 1024, 1024, 1024 * dil, S, E);
    }
    GRID_BAR(); );
    REP(5,  attn_phase(F); GRID_BAR(); );
    REP(6,  attn_mix(F); GRID_BAR(); );
    REP(7,
    { SchedG S; S.init(64, 4, F.G, c); S.A = (const char*)(F.ws + WS_ATTMIX); S.B = (const char*)(F.ws + WS_WAT); S.abytes = 256 * 512 * 2; S.bbytes = 256 * 512 * 2;
      pg8::EpiV<EpiG1> E{EpiG1{(const bf16*)(F.ws + WS_GA), (bf16*)F.outb}};
      pg8::gemm_phase<pg8::EpiV<EpiG1>, SchedG, true>(F.lds, 512, 512, 512, S, E); }
    { SchedG S; S.init(64, 4, F.G, c); S.A = (const char*)(F.ws + WS_RG); S.B = (const char*)(F.ws + WS_WRT); S.abytes = 256 * 2048 * 2; S.bbytes = 256 * 2048 * 2;
      pg8::EpiV<EpiG2> E{EpiG2{(const bf16*)(F.ws + WS_GR), (const bf16*)F.outb, (bf16*)(F.ws + WS_MERGED)}};
      pg8::gemm_phase<pg8::EpiV<EpiG2>, SchedG, true>(F.lds, 2048, 2048, 2048, S, E); }
    GRID_BAR();
    { SchedG S; S.init(64, 4, F.G, c); S.A = (const char*)(F.ws + WS_MERGED); S.B = (const char*)(F.ws + WS_WOT); S.abytes = 256 * 1024 * 2; S.bbytes = 256 * 1024 * 2;
      pg8::EpiV<EpiG3> E{EpiG3{F.in[0], (const float*)(F.ws + WS_MOD), (float*)F.outb}};
      pg8::gemm_phase<pg8::EpiV<EpiG3>, SchedG, true>(F.lds, 1024, 1024, 1024, S, E); }
    GRID_BAR(); );
    if (F.wave & 1) { moe_weight_transposes(F); moe_route<false>(F); } else { moe_route<false>(F); moe_weight_transposes(F); }
    GRID_BAR();
    REPX(11, moe_route<true>(F); GRID_BAR(); );
    const int ntiles = moe_tables(F);
    REP(8,  moe_gather(F); GRID_BAR(); );
    REP(9,
    { SchedM S; S.init(ntiles, 4, F.G, c); S.A = (const char*)(F.ws + WS_XG); S.B = (const char*)(F.ws + WS_W13T); S.abytes = 256 * 1024 * 2; S.ebytes = (size_t)1024 * 1024 * 2; S.bbytes = 256 * 1024 * 2;
      S.texp = (const LAS int*)(F.lds + TEXP_OFF);
      pg8::EpiV<EpiM3> E{EpiM3{(bf16*)(F.ws + WS_HDN)}};
      pg8::gemm_phase<pg8::EpiV<EpiM3>, SchedM, true>(F.lds, 1024, 1024, 1024, S, E); }
    GRID_BAR();
    { SchedM S; S.init(ntiles, 4, F.G, c); S.A = (const char*)(F.ws + WS_HDN); S.B = (const char*)(F.ws + WS_W2T); S.abytes = 256 * 512 * 2; S.ebytes = (size_t)1024 * 512 * 2; S.bbytes = 256 * 512 * 2;
      S.texp = (const LAS int*)(F.lds + TEXP_OFF);
      pg8::EpiV<EpiM4> E{EpiM4{(bf16*)(F.ws + WS_YROWS)}};
      pg8::gemm_phase<pg8::EpiV<EpiM4>, SchedM, true>(F.lds, 512, 512, 512, S, E); }
    GRID_BAR(); );
    REPX(12, moe_combine<true>(F); GRID_BAR(); );
    REPX(13, GRID_BAR(); GRID_BAR(); GRID_BAR(); GRID_BAR(); GRID_BAR(); GRID_BAR(); GRID_BAR(); GRID_BAR(); GRID_BAR(); GRID_BAR(); );
    moe_combine<false>(F);
#if PROF
    GRID_BAR();
    { const unsigned long long ta0 = __hip_atomic_load(TS + PROF_A - 1, __ATOMIC_RELAXED, __HIP_MEMORY_SCOPE_AGENT), ta1 = __hip_atomic_load(TS + PROF_A, __ATOMIC_RELAXED, __HIP_MEMORY_SCOPE_AGENT);
      const unsigned long long tb0 = __hip_atomic_load(TS + PROF_B - 1, __ATOMIC_RELAXED, __HIP_MEMORY_SCOPE_AGENT), tb1 = __hip_atomic_load(TS + PROF_B, __ATOMIC_RELAXED, __HIP_MEMORY_SCOPE_AGENT);
      const float V1 = (float)(ta1 - ta0) * 0.01f, V2 = (float)(tb1 - tb0) * 0.01f * 20.f;
      float* out = (float*)F.outb;
      for (int i = F.bx * NTHREADS + F.tid; i < NT * DM; i += F.G * NTHREADS) out[i] = (i < 16) ? V2 : V1; }
#endif
}

extern "C" void kernel_launch(void* const* d_in, const int* in_sizes, int n_in, void* d_out, int out_size, void* d_ws, size_t ws_size, hipStream_t stream) {
    static int grid = 0;
    if (grid == 0) {
        if (n_in != 22 || out_size != NT * DM || ws_size < WS_END) { fprintf(stderr, "kernel_launch: unexpected problem (n_in %d, out %d, ws %zu)\n", n_in, out_size, ws_size); grid = -1; return; }
        int dev = 0, cus = 0, per_cu = 0;
        if (hipGetDevice(&dev) != hipSuccess || hipDeviceGetAttribute(&cus, hipDeviceAttributeMultiprocessorCount, dev) != hipSuccess) { grid = -1; return; }
        if (hipFuncSetAttribute((const void*)fwd_kernel, hipFuncAttributeMaxDynamicSharedMemorySize, LDS_BYTES) != hipSuccess) { grid = -1; return; }
        if (hipOccupancyMaxActiveBlocksPerMultiprocessor(&per_cu, (const void*)fwd_kernel, NTHREADS, LDS_BYTES) != hipSuccess || per_cu < 1) { fprintf(stderr, "kernel_launch: occupancy query reports %d blocks/CU\n", per_cu); (void)hipGetLastError(); grid = -1; return; }
        grid = cus;
    }
    if (grid < 0) return;
    (void)hipMemsetAsync((char*)d_ws + WS_CTL, 0, CTL_ZERO_BYTES, stream);
    Args a{};
    for (int i = 0; i < 22; ++i) a.in[i] = (const float*)d_in[i];
    a.out = (float*)d_out; a.ws = (unsigned char*)d_ws;
    hipLaunchKernelGGL(fwd_kernel, dim3(grid), dim3(NTHREADS), LDS_BYTES, stream, a);
}
```

```cpp
#ifndef PROF
#define PROF 0
#endif
#ifndef DUP
#define DUP 0
#endif
#define REP(k, ...) do { __VA_ARGS__ if (DUP == (k)) { __VA_ARGS__ } } while (0)
#define REPX(k, ...) do { if (DUP == (k)) { __VA_ARGS__ } } while (0)
#ifndef PROF_A
#define PROF_A 1
#endif
#ifndef PROF_B
#define PROF_B 2
#endif
#include <hip/hip_runtime.h>
#include <cstdio>
#include <cstdint>

#define GAS __attribute__((address_space(1)))
#define LAS __attribute__((address_space(3)))
#define DI __device__ __forceinline__
typedef unsigned short bf16;
typedef float f32x4 __attribute__((ext_vector_type(4)));
typedef float f32x16 __attribute__((ext_vector_type(16)));
typedef float f32x2 __attribute__((ext_vector_type(2)));
typedef short bf16x8 __attribute__((ext_vector_type(8)));
typedef short s16x4 __attribute__((ext_vector_type(4)));
typedef __bf16 bf16x2_t __attribute__((ext_vector_type(2)));
typedef unsigned u32x4 __attribute__((ext_vector_type(4)));
typedef unsigned u32x2 __attribute__((ext_vector_type(2)));

constexpr int NT = 16384, DM = 1024, SEQ = 4096, NB = 4;
constexpr int NWAVES = 8, NTHREADS = 512;
constexpr int LDS_BYTES = 147456, RING_BYTES = 131072, LDSX_OFF = RING_BYTES;
constexpr int MISC_OFF = LDSX_OFF + 320;
constexpr int TEXP_OFF = LDSX_OFF + 1024;
constexpr float LN_EPS = 1e-5f;
constexpr float ALPHA = 1.189207115002721f;

constexpr size_t MiB = 1u << 20;
constexpr size_t WS_CTL = 0, CTL_ZERO_BYTES = (PROF ? 1024 : 128) * 1024;
constexpr size_t WS_MOD = 1 * MiB;
constexpr size_t WS_DEC = 1 * MiB + 112 * 1024;
constexpr size_t WS_WROUT = 1 * MiB + 128 * 1024;
constexpr size_t WS_WAT = 2 * MiB, WS_WRT = 3 * MiB, WS_WOT = 7 * MiB;
constexpr size_t WS_LSE = 9 * MiB;
constexpr size_t WS_ROUTE = 10 * MiB;
constexpr size_t WS_RQ = 12 * MiB, WS_RK = 44 * MiB, WS_YB = 76 * MiB, WS_RVT = 140 * MiB, WS_KFT = 204 * MiB, WS_KBT = 236 * MiB, WS_YF = 268 * MiB, WS_RETG = 204 * MiB;
constexpr size_t WS_AQ = 12 * MiB, WS_AK = 60 * MiB, WS_AVT = 108 * MiB, WS_GA = 156 * MiB, WS_O0 = 188 * MiB, WS_GR = 268 * MiB, WS_O1 = 300 * MiB, WS_O2 = 316 * MiB;
constexpr size_t WS_ATTMIX = 12 * MiB, WS_MERGED = 28 * MiB, WS_W13T = 60 * MiB, WS_W2T = 124 * MiB;
constexpr size_t WS_U2 = 156 * MiB, WS_XG = 188 * MiB, WS_HDN = 268 * MiB, WS_YROWS = 188 * MiB;
constexpr size_t WS_END = 332 * MiB;
constexpr size_t OUT_U = 0, OUT_WINT = 32 * MiB;
constexpr int CW_BAR = 4096;
constexpr int CW_CNT = 16384;
constexpr int CW_RANK = 20480;

constexpr int C_AQ = 0, C_AK = 1536, C_AV = 3072, C_RQ = 4608, C_RK = 5632, C_RV = 6656, C_RGT = 8704, C_GA = 10752, C_GR = 11776, C_END = 12800;

#define LDS_WAIT() asm volatile("s_waitcnt lgkmcnt(0)" ::: "memory")
#define VM_WAIT() asm volatile("s_waitcnt vmcnt(0)" ::: "memory")
DI unsigned pk2(float lo, float hi) { f32x2 v = {lo, hi}; bf16x2_t r = __builtin_convertvector(v, bf16x2_t); return __builtin_bit_cast(unsigned, r); }
DI float bf2f(unsigned short b) { return __builtin_bit_cast(float, (unsigned)b << 16); }
DI float bflo(unsigned w) { return __builtin_bit_cast(float, w << 16); }
DI float bfhi(unsigned w) { return __builtin_bit_cast(float, w & 0xffff0000u); }
DI float wave_sum(float v) {
#pragma unroll
    for (int o = 1; o < 64; o <<= 1) v += __shfl_xor(v, o);
    return v;
}
DI float sigmoidf_(float x) { return 1.f / (1.f + __expf(-x)); }
DI float log2_sigmoid(float x) { return -log1pf(expf(-x)) * 1.4426950408889634f; }
#define MFMA32(a, b, c) __builtin_amdgcn_mfma_f32_32x32x16_bf16((a), (b), (c), 0, 0, 0)
DI int crow(int reg, int h) { return (reg & 3) + 8 * (reg >> 2) + 4 * h; }
DI bf16x8 pack_step(const f32x16& x, int s) {
    u32x4 p; p[0] = pk2(x[8 * s], x[8 * s + 1]); p[1] = pk2(x[8 * s + 2], x[8 * s + 3]); p[2] = pk2(x[8 * s + 4], x[8 * s + 5]); p[3] = pk2(x[8 * s + 6], x[8 * s + 7]);
    return __builtin_bit_cast(bf16x8, p);
}
DI bf16x8 ld16(const bf16* p) { return *(const bf16x8*)p; }
DI bf16x8 ld8x2(const bf16* p0, const bf16* p1) { const s16x4 a = *(const s16x4*)p0, b = *(const s16x4*)p1; return __builtin_shufflevector(a, b, 0, 1, 2, 3, 4, 5, 6, 7); }
DI size_t blk_off(int row, int k, int kblocks) { return ((size_t)(row >> 5) * kblocks + (k >> 4)) * 512 + ((k >> 3) & 1) * 256 + (row & 31) * 8; }
DI f32x16 zero16() { f32x16 z; for (int i = 0; i < 16; ++i) z[i] = 0.f; return z; }

#define XB_TMO      128
#define XB_XCNT(j)  (256  + 64 * (j))
#define XB_XSUB(j)  (1280 + 64 * (j))
#define XB_XGEN(j)  (2304 + 64 * (j))
#define XB_TOP      3328
#define XB_TOPGEN   3392
#define XCD_BAR_WORDS 3456
#define XB_SPIN_CAP (1u << 18)
DI unsigned xb_ld(unsigned* p)              { return __hip_atomic_load(p, __ATOMIC_RELAXED, __HIP_MEMORY_SCOPE_AGENT); }
DI unsigned xb_add(unsigned* p, unsigned v) { return __hip_atomic_fetch_add(p, v, __ATOMIC_RELAXED, __HIP_MEMORY_SCOPE_AGENT); }
DI unsigned xb_xcc_id() { return (unsigned)__builtin_amdgcn_s_getreg((3 << 11) | 20) & 0xFu; }
#define XB_SPIN(cond, bar) do { unsigned _sp = 0; while (cond) { __builtin_amdgcn_s_sleep(1); \
    if ((++_sp & 255u) == 0u) { if (xb_ld(&(bar)[XB_TMO])) break; if (_sp > XB_SPIN_CAP) { atomicAdd(&(bar)[XB_TMO], 1u); break; } } } } while (0)
struct XcdBarrier { unsigned* bar; unsigned x; volatile LAS unsigned* st; };
DI XcdBarrier xcd_barrier_post(unsigned* bar, volatile LAS unsigned* st) {
    XcdBarrier b; b.bar = bar; b.x = xb_xcc_id(); b.st = st;
    if (threadIdx.x == 0) (void)xb_add(&bar[XB_XCNT(b.x)], 1u);
    return b;
}
DI void xcd_barrier_complete(unsigned* bar, unsigned x, unsigned& nloc, unsigned& nx) {
    const unsigned G = gridDim.x * gridDim.y * gridDim.z;
    unsigned sum, cnt, mine, sp = 0u;
    for (;;) {
        sum = 0u; cnt = 0u; mine = 0u;
#pragma unroll
        for (unsigned j = 0; j < 16; ++j) { const unsigned c = xb_ld(&bar[XB_XCNT(j)]); sum += c; cnt += (c > 0u) ? 1u : 0u; mine = (j == x) ? c : mine; }
        if (sum == G) break;
        __builtin_amdgcn_s_sleep(1);
        if ((++sp & 255u) == 0u) { if (xb_ld(&bar[XB_TMO])) break; if (sp > XB_SPIN_CAP) { atomicAdd(&bar[XB_TMO], 1u); break; } }
    }
    nloc = mine > 0u ? mine : 1u; nx = cnt > 0u ? cnt : 1u;
}
DI void xcd_barrier(const XcdBarrier& b) {
    asm volatile("s_waitcnt vmcnt(0)" ::: "memory");
    __syncthreads();
    if (threadIdx.x == 0) {
        unsigned* bar = b.bar;
        __builtin_amdgcn_s_waitcnt(0);
        unsigned nloc = b.st[0], nx = b.st[1];
        if (nloc == 0u) { xcd_barrier_complete(bar, b.x, nloc, nx); b.st[0] = nloc; b.st[1] = nx; }
        const unsigned old = xb_add(&bar[XB_XSUB(b.x)], 1u);
        const unsigned gen = old / nloc;
        if (old + 1u == (gen + 1u) * nloc) {
            __builtin_amdgcn_fence(__ATOMIC_RELEASE, "agent");
            asm volatile("s_waitcnt vmcnt(0)" ::: "memory");
            const unsigned og = xb_add(&bar[XB_TOP], 1u);
            const unsigned tg = og / nx;
            if (og + 1u == (tg + 1u) * nx) xb_add(&bar[XB_TOPGEN], 1u);
            else XB_SPIN(xb_ld(&bar[XB_TOPGEN]) == tg, bar);
            __builtin_amdgcn_fence(__ATOMIC_ACQUIRE, "agent");
            xb_add(&bar[XB_XGEN(b.x)], 1u);
            asm volatile("s_waitcnt vmcnt(0)" ::: "memory");
        } else {
            XB_SPIN(xb_ld(&bar[XB_XGEN(b.x)]) == gen, bar);
            __builtin_amdgcn_fence(__ATOMIC_ACQUIRE, "agent");
            asm volatile("s_waitcnt vmcnt(0)" ::: "memory");
        }
    }
    __syncthreads();
}

namespace pg8 {
#define PG8_LAS __attribute__((address_space(3)))
constexpr int BM = 256, BK = 64, HALF = 128, HTB = HALF * BK * 2, STAGE_BYTES = 8 * HTB, NXCD = 8, WGM = 8;
__host__ __device__ __forceinline__ int lds_byte(int r, int c) { const int st = (r >> 4) * 2 + (c >> 5), rr = r & 15, cc = c & 31, ob = rr * 64 + cc * 2; return st * 1024 + (ob ^ (((ob >> 9) & 1) << 5)); }
__host__ __device__ __forceinline__ void stage_rc(int b, int& R, int& C) { const int st = b / 1024, sb = b % 1024, swz = sb ^ (((sb >> 9) & 1) << 5); R = (st >> 1) * 16 + swz / 64; C = (st & 1) * 32 + (swz % 64) / 2; }
__host__ __device__ __forceinline__ int perm32(int rho) { const int n = rho >> 4, i = rho & 15; return 8 * (i >> 2) + 4 * n + (i & 3); }
struct Unit { int pm, pn; };
struct StaticOrder {
    int nM, nN, nwg, G, c;
    __host__ __device__ void init(int nM_, int nN_, int G_, int c_) { nM = nM_; nN = nN_; nwg = nM * nN; G = G_; c = c_; }
    __host__ __device__ bool next(int i, Unit& u) const {
        const long L = (long)i * G + c; if (c < 0 || L >= nwg) return false;
        int wgid = (int)L; { const int q = nwg / NXCD, r = nwg % NXCD, xcd = wgid % NXCD, off = wgid / NXCD; wgid = (xcd < r ? xcd * (q + 1) : r * (q + 1) + (xcd - r) * q) + off; }
        const int nig = WGM * nN, gid = wgid / nig, fm = gid * WGM, gsz = (nM - fm) < WGM ? (nM - fm) : WGM;
        u.pm = fm + ((wgid % nig) % gsz); u.pn = (wgid % nig) / gsz; return true;
    }
};
template <class F> struct EpiV {
    F f;
    __device__ __forceinline__ void operator()(const f32x4 (&acc)[2][2][4][2], const Unit& u, int wr, int wc, int fr, int fq) const {
        const int row0 = u.pm * BM + wr * 64 + fr, col0 = u.pn * BM + wc * 32 + 8 * fq;
#pragma unroll
        for (int ai = 0; ai < 2; ++ai)
#pragma unroll
            for (int m = 0; m < 4; ++m)
#pragma unroll
                for (int bj = 0; bj < 2; ++bj) f(row0 + ai * HALF + m * 16, col0 + bj * HALF, acc[ai][bj][m][0], acc[ai][bj][m][1]);
    }
};
template <class Epi, class Sched, bool ALIGN_EPI = false>
__device__ __forceinline__ void gemm_phase(PG8_LAS unsigned char* lds, const int K, const int lda, const int ldb, const Sched& S, const Epi& E) {
    int tid_ = threadIdx.x; asm volatile("" : "+v"(tid_));
    const int tid = tid_, wid = __builtin_amdgcn_readfirstlane(tid >> 6), lane = tid & 63, wr = wid >> 2, wc = wid & 3, fr = lane & 15, fq = lane >> 4;
    const int nt = K / BK;
    unsigned voffA[2], voffB[2];
#pragma unroll
    for (int i = 0; i < 2; ++i) { int R, C; stage_rc(tid * 16 + i * 8192, R, C); const int Rb = (R & ~31) + perm32(R & 31);
        voffA[i] = (unsigned)(R * lda + C) * 2u; voffB[i] = (unsigned)(Rb * ldb + C) * 2u; }
    const size_t kstep = (size_t)(BK * 2);
    const size_t hstepA = (size_t)HALF * lda * 2, hstepB = (size_t)HALF * ldb * 2;
    const unsigned ldsw = (unsigned)wid * 1024u;
    const int aoff = lds_byte(wr * 64 + fr, fq * 8), boff = lds_byte(wc * 32 + fr, fq * 8);
#define PG8_SA(b, h) (((b) * 2 + (h)) * HTB)
#define PG8_SB(b, h) ((4 + (b) * 2 + (h)) * HTB)
#define PG8_STAGE(bufoff, gbase, voff) do { _Pragma("unroll") for (int _i = 0; _i < 2; ++_i) \
        __builtin_amdgcn_global_load_lds((const unsigned*)((const char*)(gbase) + (voff)[_i]), (PG8_LAS unsigned*)(lds + (bufoff) + ldsw + _i * 8192), 16, 0, 0); } while (0)
#define PG8_LDA(dst, b, h) do { _Pragma("unroll") for (int m = 0; m < 4; ++m) _Pragma("unroll") for (int k = 0; k < 2; ++k) dst[m][k] = *(const PG8_LAS bf16x8*)(lds + PG8_SA(b, h) + aoff + m * 2048 + k * 1024); } while (0)
#define PG8_LDB(dst, b, h) do { _Pragma("unroll") for (int n = 0; n < 2; ++n) _Pragma("unroll") for (int k = 0; k < 2; ++k) dst[n][k] = *(const PG8_LAS bf16x8*)(lds + PG8_SB(b, h) + boff + n * 2048 + k * 1024); } while (0)
#define PG8_MMA(ai, bj, At, Bt) do { __builtin_amdgcn_s_setprio(1); _Pragma("unroll") for (int m = 0; m < 4; ++m) _Pragma("unroll") for (int n = 0; n < 2; ++n) _Pragma("unroll") for (int k = 0; k < 2; ++k) \
        acc[ai][bj][m][n] = __builtin_amdgcn_mfma_f32_16x16x32_bf16(Bt[n][k], At[m][k], acc[ai][bj][m][n], 0, 0, 0); __builtin_amdgcn_s_setprio(0); } while (0)
#define PG8_WAIT_V(n) asm volatile("s_waitcnt vmcnt(" #n ")" ::: "memory")
#define PG8_WAIT_L(n) asm volatile("s_waitcnt lgkmcnt(" #n ")" ::: "memory")
#define PG8_BAR __builtin_amdgcn_s_barrier()
#define PG8_SCHED __builtin_amdgcn_sched_barrier(0)
    Unit cur, nxt; int ui = 0;
    if (!S.next(0, cur)) return;
    f32x4 acc[2][2][4][2];
#pragma unroll
    for (int a = 0; a < 2; ++a)
#pragma unroll
        for (int b = 0; b < 2; ++b)
#pragma unroll
            for (int m = 0; m < 4; ++m)
#pragma unroll
                for (int n = 0; n < 2; ++n) acc[a][b][m][n] = (f32x4){0.f, 0.f, 0.f, 0.f};
    bf16x8 At[4][2], B0[2][2], B1[2][2];
    const char* cA = S.a_base(cur); const char* cB = S.b_base(cur);
    PG8_STAGE(PG8_SB(0, 0), cB, voffB); PG8_STAGE(PG8_SB(0, 1), cB + hstepB, voffB); PG8_STAGE(PG8_SA(0, 0), cA, voffA); PG8_STAGE(PG8_SA(0, 1), cA + hstepA, voffA);
    if (wr == 1) PG8_BAR;
    PG8_WAIT_V(2); PG8_BAR;
    PG8_STAGE(PG8_SB(1, 0), cB + kstep, voffB); PG8_STAGE(PG8_SA(1, 0), cA + kstep, voffA); PG8_STAGE(PG8_SB(1, 1), cB + hstepB + kstep, voffB);
    PG8_WAIT_V(6); PG8_BAR;
    for (;;) {
        const bool has_next = S.next(ui + 1, nxt);
        const char* nA = has_next ? S.a_base(nxt) : cA; const char* nB = has_next ? S.b_base(nxt) : cB;
        for (int t = 0; t < nt; t += 2) {
            const bool last = (t == nt - 2);
            const char* a1 = cA + (size_t)(t + 1) * kstep;
            const char* a2 = last ? nA : cA + (size_t)(t + 2) * kstep; const char* b2 = last ? nB : cB + (size_t)(t + 2) * kstep;
            const char* a3 = a2 + kstep; const char* b3 = b2 + kstep;
            PG8_LDB(B0, 0, 0); PG8_LDB(B1, 0, 1); PG8_SCHED; PG8_LDA(At, 0, 0); PG8_STAGE(PG8_SA(1, 1), a1 + hstepA, voffA);
            PG8_WAIT_V(8); PG8_WAIT_L(0); PG8_BAR; PG8_MMA(0, 0, At, B0); PG8_MMA(0, 1, At, B1); PG8_BAR; PG8_SCHED;
            PG8_LDA(At, 0, 1); PG8_STAGE(PG8_SB(0, 0), b2, voffB); PG8_STAGE(PG8_SB(0, 1), b2 + hstepB, voffB); PG8_STAGE(PG8_SA(0, 0), a2, voffA);
            PG8_WAIT_V(8); PG8_WAIT_L(0); PG8_BAR; PG8_MMA(1, 0, At, B0); PG8_MMA(1, 1, At, B1); PG8_BAR; PG8_SCHED;
            PG8_LDB(B0, 1, 0); PG8_LDB(B1, 1, 1); PG8_SCHED; PG8_LDA(At, 1, 0); PG8_STAGE(PG8_SA(0, 1), a2 + hstepA, voffA);
            PG8_WAIT_V(8); PG8_WAIT_L(0); PG8_BAR; PG8_MMA(0, 0, At, B0); PG8_MMA(0, 1, At, B1); PG8_BAR; PG8_SCHED;
            PG8_LDA(At, 1, 1); PG8_STAGE(PG8_SB(1, 0), b3, voffB); PG8_STAGE(PG8_SB(1, 1), b3 + hstepB, voffB); PG8_STAGE(PG8_SA(1, 0), a3, voffA);
            PG8_WAIT_V(8); PG8_WAIT_L(0); PG8_BAR; PG8_MMA(1, 0, At, B0); PG8_MMA(1, 1, At, B1); PG8_BAR; PG8_SCHED;
        }
        if constexpr (ALIGN_EPI) { if (wr == 0) PG8_BAR; }
        E(acc, cur, wr, wc, fr, fq);
        if (!has_next) break;
#pragma unroll
        for (int a = 0; a < 2; ++a)
#pragma unroll
            for (int b = 0; b < 2; ++b)
#pragma unroll
                for (int m = 0; m < 4; ++m)
#pragma unroll
                    for (int n = 0; n < 2; ++n) acc[a][b][m][n] = (f32x4){0.f, 0.f, 0.f, 0.f};
        cur = nxt; cA = nA; cB = nB; ++ui;
        if constexpr (ALIGN_EPI) { if (wr == 1) PG8_BAR; }
    }
    PG8_WAIT_V(0);
    if constexpr (!ALIGN_EPI) { if (wr == 0) PG8_BAR; }
    PG8_BAR;
#undef PG8_SA
#undef PG8_SB
#undef PG8_STAGE
#undef PG8_LDA
#undef PG8_LDB
#undef PG8_MMA
#undef PG8_WAIT_V
#undef PG8_WAIT_L
#undef PG8_BAR
#undef PG8_SCHED
}
}

struct Frame {
    LAS unsigned char* lds;
    int tid, lane, wave, G, vcu, bx;
    unsigned char* ws; unsigned char* outb;
    const float* in[22];
};
struct Args { const float* in[22]; float* out; unsigned char* ws; };
DI int opaque_lane(const Frame& F) { int l = F.lane; asm volatile("" : "+v"(l)); return l; }

template <class RowMap>
DI void transpose_item(const float* W, int K, int N, bf16* WT, RowMap orow, LAS float* scr, int item, int lane) {
    const int nblk = N / 32, kb = item / nblk, nb = item % nblk, k0 = 64 * kb, n0 = 32 * nb;
#pragma unroll 8
    for (int i = 0; i < 32; ++i) { const int kk = 2 * i + (lane >> 5); scr[kk * 33 + (lane & 31)] = W[(size_t)(k0 + kk) * N + n0 + (lane & 31)]; }
    LDS_WAIT(); asm volatile("" ::: "memory");
    const int c = lane & 7;
#pragma unroll
    for (int j = 0; j < 4; ++j) { const int n = (lane >> 3) + 8 * j; const LAS float* s = scr + (8 * c) * 33 + n;
        u32x4 o; o.x = pk2(s[0 * 33], s[1 * 33]); o.y = pk2(s[2 * 33], s[3 * 33]); o.z = pk2(s[4 * 33], s[5 * 33]); o.w = pk2(s[6 * 33], s[7 * 33]);
        *(u32x4*)(WT + (size_t)orow(n0 + n) * K + k0 + 8 * c) = o; }
    LDS_WAIT(); asm volatile("" ::: "memory");
}
struct RowId { int off; DI int operator()(int n) const { return off + n; } };
struct RowW13 { int add; DI int operator()(int n) const { return ((n >> 2) << 3) + (n & 3) + add; } };

DI void phase0(Frame& F) {
    const int lane_ = F.lane;
    const float* c = F.in[1]; const float* w_ada = F.in[2]; const float* b_ada = F.in[3];
    float* MOD = (float*)(F.ws + WS_MOD);
    if (F.bx < 96) {
        const int j = F.bx * 64 + lane_;
        float a0 = 0.f, a1 = 0.f, a2 = 0.f, a3 = 0.f;
        const int k0 = F.wave * 128;
#pragma unroll 8
        for (int k = k0; k < k0 + 128; ++k) { const float w = w_ada[(size_t)k * 6144 + j]; a0 += c[k] * w; a1 += c[1024 + k] * w; a2 += c[2048 + k] * w; a3 += c[3072 + k] * w; }
        LAS float* red = (LAS float*)F.lds;
        red[(F.wave * 4 + 0) * 64 + lane_] = a0; red[(F.wave * 4 + 1) * 64 + lane_] = a1; red[(F.wave * 4 + 2) * 64 + lane_] = a2; red[(F.wave * 4 + 3) * 64 + lane_] = a3;
        __syncthreads();
        if (F.tid < 256) { const int b = F.tid >> 6, l = F.tid & 63; float s = b_ada[F.bx * 64 + l];
#pragma unroll
            for (int w = 0; w < 8; ++w) s += red[(w * 4 + b) * 64 + l];
            MOD[b * 6144 + F.bx * 64 + l] = s; }
        __syncthreads();
    }
    if (F.bx == 0 && F.tid < 8) ((float*)(F.ws + WS_DEC))[F.tid] = log2_sigmoid(F.tid < 4 ? F.in[6][F.tid] : F.in[7][F.tid - 4]);
    { const int gid = F.bx * NTHREADS + F.tid;
      if (gid < 36 * 1024) { const int o = gid >> 10, k = gid & 1023; float v;
          if (o < 4) v = F.in[13][k * 4 + o]; else { const int g = (o - 4) >> 3, e = (o - 4) & 7; v = F.in[15][((size_t)g * 1024 + k) * 8 + e]; }
          ((float*)(F.ws + WS_WROUT))[gid] = v; } }
    LAS float* scr = (LAS float*)(F.lds + 16384 + F.wave * 12288);
    const int gw = F.bx * NWAVES + F.wave, NGW = F.G * NWAVES;
    constexpr int I_IN = 16 * 400, I_A = 8 * 32, I_R = 32 * 32, I_O = 16 * 32;
    for (int it = gw; it < I_IN + I_A + I_R + I_O; it += NGW) {
        int r = it;
        if (r < I_IN) { transpose_item(F.in[4], 1024, C_END, (bf16*)(F.outb + OUT_WINT), RowId{0}, scr, r, lane_); continue; } r -= I_IN;
        if (r < I_A) { transpose_item(F.in[5], 512, 1024, (bf16*)(F.ws + WS_WAT), RowId{0}, scr, r, lane_); continue; } r -= I_A;
        if (r < I_R) { transpose_item(F.in[9], 2048, 1024, (bf16*)(F.ws + WS_WRT), RowId{0}, scr, r, lane_); continue; } r -= I_R;
        transpose_item(F.in[10], 1024, 1024, (bf16*)(F.ws + WS_WOT), RowId{0}, scr, r, lane_);
    }
}
DI void moe_weight_transposes(Frame& F) {
    const int lane_ = F.lane;
    LAS float* scr = (LAS float*)(F.lds + 16384 + F.wave * 12288);
    const int gw = F.bx * NWAVES + F.wave, NGW = F.G * NWAVES;
    bf16* W13T = (bf16*)(F.ws + WS_W13T); bf16* W2T = (bf16*)(F.ws + WS_W2T);
    for (int it = gw; it < 3 * 8192; it += NGW) {
        const int which = it >> 13, r = it & 8191, e = r >> 8, item = r & 255;
        if (which == 0) transpose_item(F.in[17] + (size_t)e * 1024 * 512, 1024, 512, W13T + (size_t)e * 1024 * 1024, RowW13{0}, scr, item, lane_);
        else if (which == 1) transpose_item(F.in[18] + (size_t)e * 1024 * 512, 1024, 512, W13T + (size_t)e * 1024 * 1024, RowW13{4}, scr, item, lane_);
        else transpose_item(F.in[19] + (size_t)e * 512 * 1024, 512, 1024, W2T + (size_t)e * 1024 * 512, RowId{0}, scr, item, lane_);
    }
}

DI void phase1(Frame& F) {
    const int lane_ = opaque_lane(F);
    const float* x = F.in[0]; const float* MOD = (const float*)(F.ws + WS_MOD); bf16* U = (bf16*)(F.outb + OUT_U);
    const int gw = F.bx * NWAVES + F.wave, NGW = F.G * NWAVES;
    for (int m = gw; m < NT; m += NGW) {
        const f32x4* xr = (const f32x4*)(x + (size_t)m * DM) + lane_; const int b = m >> 12;
        f32x4 v[4]; float s = 0.f;
#pragma unroll
        for (int j = 0; j < 4; ++j) { v[j] = xr[64 * j]; s += (v[j].x + v[j].y) + (v[j].z + v[j].w); }
        const float mean = wave_sum(s) * (1.f / DM); float s2 = 0.f;
#pragma unroll
        for (int j = 0; j < 4; ++j) { v[j] = v[j] - mean; s2 += (v[j].x * v[j].x + v[j].y * v[j].y) + (v[j].z * v[j].z + v[j].w * v[j].w); }
        const float rstd = 1.f / sqrtf(wave_sum(s2) * (1.f / DM) + LN_EPS);
        u32x2* o8 = (u32x2*)(U + (size_t)m * DM) + lane_;
#pragma unroll
        for (int j = 0; j < 4; ++j) { const int col = 256 * j + 4 * lane_;
            const f32x4 sh = *(const f32x4*)(MOD + b * 6144 + col), sc = *(const f32x4*)(MOD + b * 6144 + 1024 + col);
            const f32x4 u = v[j] * rstd * (sc + 1.f) + sh;
            u32x2 w; w.x = pk2(u.x, u.y); w.y = pk2(u.z, u.w); o8[64 * j] = w; }
    }
}

DI u32x4 pack8(f32x4 v0, f32x4 v1) { u32x4 w; w.x = pk2(v0[0], v0[1]); w.y = pk2(v0[2], v0[3]); w.z = pk2(v1[0], v1[1]); w.w = pk2(v1[2], v1[3]); return w; }

struct SchedR1 : pg8::StaticOrder { const char* U; const char* W;
    DI const char* a_base(const pg8::Unit& u) const { return U + (size_t)u.pm * 256 * 2048; }
    DI const char* b_base(const pg8::Unit& u) const { return W + (size_t)(C_RQ + 256 * u.pn) * 2048; } };
struct EpiR1 { bf16 *RQ, *RK;
    DI void operator()(int row, int col, f32x4 v0, f32x4 v1) const {
        if (col < 1024) *(u32x4*)(RQ + blk_off(row, col, 64)) = pack8(v0, v1);
        else *(u32x4*)(RK + blk_off(row, col - 1024, 64)) = pack8(v0 * 0.0625f, v1 * 0.0625f); } };
struct SchedR2 : pg8::StaticOrder { const char* U; const char* W;
    DI const char* a_base(const pg8::Unit& u) const { const int r = u.pm < 8 ? C_RV + 256 * u.pm : C_RK + 256 * (u.pm - 8); return W + (size_t)r * 2048; }
    DI const char* b_base(const pg8::Unit& u) const { return U + (size_t)u.pn * 256 * 2048; } };
struct EpiR2 { bf16 *RVT, *KFT, *KBT; const float* DEC;
    DI void operator()(int row, int col, f32x4 v0, f32x4 v1) const {
        if (row < 2048) { *(u32x4*)(RVT + blk_off(row, col, 1024)) = pack8(v0, v1); return; }
        const int f = row - 2048, h = f >> 8; const float p0 = (float)(col & 127);
        const float a = DEC[h], b = DEC[4 + h];
        f32x4 kf0, kf1, kb0, kb1;
#pragma unroll
        for (int e = 0; e < 4; ++e) {
            const float pa = p0 + (float)e, pb = p0 + (float)(e + 4);
            kf0[e] = v0[e] * 0.0625f * __builtin_amdgcn_exp2f(a * (127.f - pa)); kf1[e] = v1[e] * 0.0625f * __builtin_amdgcn_exp2f(a * (127.f - pb));
            kb0[e] = v0[e] * 0.0625f * __builtin_amdgcn_exp2f(b * pa);           kb1[e] = v1[e] * 0.0625f * __builtin_amdgcn_exp2f(b * pb); }
        *(u32x4*)(KFT + blk_off(f, col, 1024)) = pack8(kf0, kf1);
        *(u32x4*)(KBT + blk_off(f, col, 1024)) = pack8(kb0, kb1); } };
struct SchedQK : pg8::StaticOrder { const char* U; const char* W; int g, r, nsub;
    DI const char* a_base(const pg8::Unit& u) const { const int b = u.pm >> 4, v0 = (u.pm & 15) * 256, rho = v0 / nsub, i0 = v0 % nsub; return U + (size_t)(b * SEQ + rho + r * i0) * 2048; }
    DI const char* b_base(const pg8::Unit& u) const { const int rw = (u.pn < 2 ? C_AQ : C_AK) + 512 * g + 256 * (u.pn & 1); return W + (size_t)rw * 2048; } };
struct EpiQK { bf16 *AQ, *AK;
    DI void operator()(int row, int col, f32x4 v0, f32x4 v1) const {
        if (col < 512) *(u32x4*)(AQ + blk_off(row, col, 32)) = pack8(v0, v1);
        else *(u32x4*)(AK + blk_off(row, col - 512, 32)) = pack8(v0, v1); } };
struct SchedGate : pg8::StaticOrder { const char* U; const char* W;
    DI const char* a_base(const pg8::Unit& u) const { return U + (size_t)u.pm * 256 * 2048; }
    DI const char* b_base(const pg8::Unit& u) const { return W + (size_t)(C_RGT + 256 * u.pn) * 2048; } };
struct EpiGate { bf16 *RETG, *GA, *GR;
    DI void operator()(int row, int col, f32x4 v0, f32x4 v1) const {
        if (col < 2048) { bf16* p = RETG + (size_t)row * 2048 + col; const u32x4 n = *(const u32x4*)p;
            f32x4 o0 = {v0[0] * sigmoidf_(v0[0]) * bflo(n.x), v0[1] * sigmoidf_(v0[1]) * bfhi(n.x), v0[2] * sigmoidf_(v0[2]) * bflo(n.y), v0[3] * sigmoidf_(v0[3]) * bfhi(n.y)};
            f32x4 o1 = {v1[0] * sigmoidf_(v1[0]) * bflo(n.z), v1[1] * sigmoidf_(v1[1]) * bfhi(n.z), v1[2] * sigmoidf_(v1[2]) * bflo(n.w), v1[3] * sigmoidf_(v1[3]) * bfhi(n.w)};
            *(u32x4*)p = pack8(o0, o1); return; }
        f32x4 s0, s1;
#pragma unroll
        for (int e = 0; e < 4; ++e) { s0[e] = sigmoidf_(v0[e]); s1[e] = sigmoidf_(v1[e]); }
        bf16* dst = col < 3072 ? GA + (size_t)row * 1024 + col - 2048 : GR + (size_t)row * 1024 + col - 3072;
        *(u32x4*)dst = pack8(s0, s1); } };
struct SchedA2 : pg8::StaticOrder { const char* U; const char* W; int g, r, nsub;
    DI const char* a_base(const pg8::Unit& u) const { return W + (size_t)(C_AV + 512 * g + 256 * u.pm) * 2048; }
    DI const char* b_base(const pg8::Unit& u) const { const int b = u.pn >> 4, v0 = (u.pn & 15) * 256, rho = v0 / nsub, i0 = v0 % nsub; return U + (size_t)(b * SEQ + rho + r * i0) * 2048; } };
struct EpiA2 { bf16* AVT;
    DI void operator()(int row, int col, f32x4 v0, f32x4 v1) const { *(u32x4*)(AVT + blk_off(row, col, 1024)) = pack8(v0, v1); } };
struct SchedG : pg8::StaticOrder { const char* A; const char* B; size_t abytes, bbytes;
    DI const char* a_base(const pg8::Unit& u) const { return A + (size_t)u.pm * abytes; }
    DI const char* b_base(const pg8::Unit& u) const { return B + (size_t)u.pn * bbytes; } };
struct EpiG1 { const bf16* GA; bf16* P1;
    DI void operator()(int row, int col, f32x4 v0, f32x4 v1) const {
        const u32x4 g = *(const u32x4*)(GA + (size_t)row * 1024 + col);
        f32x4 o0 = {v0[0] * bflo(g.x), v0[1] * bfhi(g.x), v0[2] * bflo(g.y), v0[3] * bfhi(g.y)}, o1 = {v1[0] * bflo(g.z), v1[1] * bfhi(g.z), v1[2] * bflo(g.w), v1[3] * bfhi(g.w)};
        *(u32x4*)(P1 + (size_t)row * 1024 + col) = pack8(o0, o1); } };
struct EpiG2 { const bf16* GR; const bf16* P1; bf16* MERGED;
    DI void operator()(int row, int col, f32x4 v0, f32x4 v1) const {
        const u32x4 g = *(const u32x4*)(GR + (size_t)row * 1024 + col);
        const u32x4 p = *(const u32x4*)(P1 + (size_t)row * 1024 + col);
        f32x4 o0 = {bflo(p.x) + v0[0] * bflo(g.x), bfhi(p.x) + v0[1] * bfhi(g.x), bflo(p.y) + v0[2] * bflo(g.y), bfhi(p.y) + v0[3] * bfhi(g.y)};
        f32x4 o1 = {bflo(p.z) + v1[0] * bflo(g.z), bfhi(p.z) + v1[1] * bfhi(g.z), bflo(p.w) + v1[2] * bflo(g.w), bfhi(p.w) + v1[3] * bfhi(g.w)};
        *(u32x4*)(MERGED + (size_t)row * 1024 + col) = pack8(o0, o1); } };
struct EpiG3 { const float* x; const float* MOD; float* H;
    DI void operator()(int row, int col, f32x4 v0, f32x4 v1) const {
        const int b = row >> 12; const float* gp = MOD + b * 6144 + 2048 + col; const float* xp = x + (size_t)row * 1024 + col;
        const f32x4 g0 = *(const f32x4*)gp, g1 = *(const f32x4*)(gp + 4), x0 = *(const f32x4*)xp, x1 = *(const f32x4*)(xp + 4);
        *(f32x4*)(H + (size_t)row * 1024 + col) = x0 * ALPHA + g0 * v0; *(f32x4*)(H + (size_t)row * 1024 + col + 4) = x1 * ALPHA + g1 * v1; } };
struct SchedM : pg8::StaticOrder { const char* A; const char* B; size_t abytes, ebytes, bbytes; const LAS int* texp;
    DI const char* a_base(const pg8::Unit& u) const { return A + (size_t)u.pm * abytes; }
    DI const char* b_base(const pg8::Unit& u) const { return B + (size_t)texp[u.pm] * ebytes + (size_t)u.pn * bbytes; } };
struct EpiM3 { bf16* HDN;
    DI void operator()(int row, int col, f32x4 a, f32x4 b) const {
        f32x4 o;
#pragma unroll
        for (int e = 0; e < 4; ++e) o[e] = a[e] * sigmoidf_(a[e]) * b[e];
        u32x2 w; w.x = pk2(o[0], o[1]); w.y = pk2(o[2], o[3]);
        *(u32x2*)(HDN + (size_t)row * 512 + (col >> 1)) = w; } };
struct EpiM4 { bf16* Y;
    DI void operator()(int row, int col, f32x4 v0, f32x4 v1) const { *(u32x4*)(Y + (size_t)row * 1024 + col) = pack8(v0, v1); } };

#define SBAR_ __builtin_amdgcn_sched_barrier(0)
typedef __amdgpu_buffer_rsrc_t rsrc_t;
DI bf16x8 bld16(rsrc_t rs, unsigned voff, unsigned soff) { return __builtin_bit_cast(bf16x8, __builtin_amdgcn_raw_buffer_load_b128(rs, voff, soff, 0)); }
DI void bst16(u32x4 v, rsrc_t rs, unsigned voff, unsigned soff) { __builtin_amdgcn_raw_buffer_store_b128(v, rs, voff, soff, 0); }
constexpr int ST_BYTES = 32 * 1024, VT_BYTES = 16 * 1024, VT_BASE = 2 * ST_BYTES;
DI void ret_scan(Frame& F) {
    const int lane_ = F.lane;
    const int r = lane_ & 31, h = lane_ >> 5;
    const int role = F.wave >> 2, wq = F.wave & 3;
    const rsrc_t rs = __builtin_amdgcn_make_buffer_rsrc((void*)F.ws, 0, (unsigned)WS_END, 0x00020000);
    const unsigned loff = (unsigned)lane_ * 16u, yoff = (unsigned)lane_ * 32u;
    LAS char* L = (LAS char*)F.lds;
    for (int unit = __builtin_amdgcn_readfirstlane(F.vcu); unit < 256; unit += F.G) {
        const int sl = unit & 7, dir = (unit >> 3) & 1, hd = (unit >> 4) & 3, b = unit >> 6;
        const float lg = ((const float*)(F.ws + WS_DEC))[4 * dir + hd];
        const int c0 = dir ? 31 : 0, cstep = dir ? -1 : 1;
        if (role == 0) {
            const float p = (float)(32 * wq + r);
            const float qd = dir ? __builtin_amdgcn_exp2f(lg * (128.f - p)) : __builtin_amdgcn_exp2f(lg * (p + 1.f));
            const unsigned qb = (unsigned)WS_RQ + (unsigned)((((b * 128 + wq) * 64) + hd * 16) * 1024);
            const unsigned yb = (unsigned)(dir ? WS_YB : WS_YF) + (unsigned)((((b * 4 + hd) * 32 * 4 + wq) * 16 + 2 * sl) * 2048);
            bf16x8 Qf[16];
#pragma unroll
            for (int ks = 0; ks < 16; ++ks) Qf[ks] = bld16(rs, loff, qb + (unsigned)(c0 + cstep) * 4 * 65536 + 1024 * ks);
            { const u32x4 z = {0u, 0u, 0u, 0u}; const unsigned yp = yb + (unsigned)c0 * 4 * 16 * 2048;
              bst16(z, rs, yoff, yp); bst16(z, rs, yoff + 16, yp); bst16(z, rs, yoff, yp + 2048); bst16(z, rs, yoff + 16, yp + 2048); }
            asm volatile("s_waitcnt lgkmcnt(0)" ::: "memory"); __builtin_amdgcn_s_barrier(); asm volatile("" ::: "memory");
#pragma unroll
            for (int step = 0; step < 32; ++step) {
                const int ch = c0 + cstep * step;
                int chn = ch + cstep; chn = chn < 0 ? 0 : (chn > 31 ? 31 : chn);
                if (step > 0) {
                    const LAS char* sp = L + (step & 1) * ST_BYTES + loff;
                    const unsigned qn = qb + (unsigned)chn * 4 * 65536;
                    f32x16 a0 = zero16(), a1 = zero16();
#pragma unroll
                    for (int kg = 0; kg < 8; ++kg) {
                        bf16x8 s0[2], s1[2];
#pragma unroll
                        for (int k = 0; k < 2; ++k) { s0[k] = *(const LAS bf16x8*)(sp + 1024 * (2 * kg + k)); s1[k] = *(const LAS bf16x8*)(sp + 16384 + 1024 * (2 * kg + k)); }
#pragma unroll
                        for (int k = 0; k < 2; ++k) { a0 = MFMA32(s0[k], Qf[2 * kg + k], a0); a1 = MFMA32(s1[k], Qf[2 * kg + k], a1); }
                        SBAR_;
#pragma unroll
                        for (int k = 0; k < 2; ++k) Qf[2 * kg + k] = bld16(rs, loff, qn + 1024 * (2 * kg + k));
                        SBAR_;
                    }
                    const unsigned yp = yb + (unsigned)ch * 4 * 16 * 2048;
                    u32x4 w0, w1, w2, w3;
#pragma unroll
                    for (int k = 0; k < 4; ++k) { w0[k] = pk2(a0[2 * k] * qd, a0[2 * k + 1] * qd); w1[k] = pk2(a0[8 + 2 * k] * qd, a0[8 + 2 * k + 1] * qd);
                                                  w2[k] = pk2(a1[2 * k] * qd, a1[2 * k + 1] * qd); w3[k] = pk2(a1[8 + 2 * k] * qd, a1[8 + 2 * k + 1] * qd); }
                    bst16(w0, rs, yoff, yp); bst16(w1, rs, yoff + 16, yp); bst16(w2, rs, yoff, yp + 2048); bst16(w3, rs, yoff + 16, yp + 2048);
                }
                asm volatile("s_waitcnt lgkmcnt(0)" ::: "memory"); __builtin_amdgcn_s_barrier(); asm volatile("" ::: "memory");
            }
        } else {
            const float cd = __builtin_amdgcn_exp2f(lg * 128.f);
            const unsigned kb = (unsigned)(dir ? WS_KBT : WS_KFT) + (unsigned)(((hd * 8 + 2 * wq) * 1024 + b * 256) * 1024);
            const unsigned vb = (unsigned)WS_RVT + (unsigned)(((hd * 16 + 2 * sl) * 1024 + b * 256) * 1024);
            const unsigned vo = (unsigned)(wq * 64 + lane_) * 64u;
            const unsigned vsrc = (vo >> 13) * (1024u * 1024u) + (vo & 8191u);
            bf16x8 Kf0[8], Kf1[8];
#pragma unroll
            for (int ks = 0; ks < 8; ++ks) { Kf0[ks] = bld16(rs, loff, kb + (unsigned)c0 * 8192 + 1024 * ks); Kf1[ks] = bld16(rs, loff, kb + 1024 * 1024 + (unsigned)c0 * 8192 + 1024 * ks); }
            { bf16x8 v[4];
#pragma unroll
              for (int k = 0; k < 4; ++k) v[k] = bld16(rs, vsrc + 16 * k, vb + (unsigned)c0 * 8192);
#pragma unroll
              for (int k = 0; k < 4; ++k) *(LAS bf16x8*)(L + VT_BASE + vo + 16 * k) = v[k]; }
            asm volatile("s_waitcnt lgkmcnt(0)" ::: "memory"); __builtin_amdgcn_s_barrier(); asm volatile("" ::: "memory");
            f32x16 S00 = zero16(), S01 = zero16(), S10 = zero16(), S11 = zero16();
#pragma unroll
            for (int step = 0; step < 32; ++step) {
                const int ch = c0 + cstep * step;
                int chn = ch + cstep; chn = chn < 0 ? 0 : (chn > 31 ? 31 : chn);
                if (step < 31) {
                    const int cur = step & 1;
                    bf16x8 vn[4];
#pragma unroll
                    for (int k = 0; k < 4; ++k) vn[k] = bld16(rs, vsrc + 16 * k, vb + (unsigned)chn * 8192);
#pragma unroll
                    for (int i = 0; i < 16; ++i) { S00[i] *= cd; S01[i] *= cd; S10[i] *= cd; S11[i] *= cd; }
                    const LAS char* vp = L + VT_BASE + cur * VT_BYTES + loff;
                    const unsigned kn = kb + (unsigned)chn * 8192;
#pragma unroll
                    for (int kg = 0; kg < 4; ++kg) {
                        bf16x8 b0[2], b1[2];
#pragma unroll
                        for (int k = 0; k < 2; ++k) { b0[k] = *(const LAS bf16x8*)(vp + 1024 * (2 * kg + k)); b1[k] = *(const LAS bf16x8*)(vp + 8192 + 1024 * (2 * kg + k)); }
#pragma unroll
                        for (int k = 0; k < 2; ++k) { S00 = MFMA32(Kf0[2 * kg + k], b0[k], S00); S01 = MFMA32(Kf0[2 * kg + k], b1[k], S01); S10 = MFMA32(Kf1[2 * kg + k], b0[k], S10); S11 = MFMA32(Kf1[2 * kg + k], b1[k], S11); }
                        SBAR_;
#pragma unroll
                        for (int k = 0; k < 2; ++k) { Kf0[2 * kg + k] = bld16(rs, loff, kn + 1024 * (2 * kg + k)); Kf1[2 * kg + k] = bld16(rs, loff, kn + 1024 * 1024 + 1024 * (2 * kg + k)); }
                        SBAR_;
                    }
                    LAS char* wp = L + (cur ^ 1) * ST_BYTES + (4 * wq) * 1024 + (r * 8 + 4 * h) * 2;
#pragma unroll
                    for (int g = 0; g < 4; ++g) {
                        const int o = ((g >> 1) * 512 + (g & 1) * 256) * 2;
                        u32x2 w; w.x = pk2(S00[4 * g], S00[4 * g + 1]); w.y = pk2(S00[4 * g + 2], S00[4 * g + 3]); *(LAS u32x2*)(wp + o) = w;
                        w.x = pk2(S10[4 * g], S10[4 * g + 1]); w.y = pk2(S10[4 * g + 2], S10[4 * g + 3]); *(LAS u32x2*)(wp + 2048 + o) = w;
                        w.x = pk2(S01[4 * g], S01[4 * g + 1]); w.y = pk2(S01[4 * g + 2], S01[4 * g + 3]); *(LAS u32x2*)(wp + 16384 + o) = w;
                        w.x = pk2(S11[4 * g], S11[4 * g + 1]); w.y = pk2(S11[4 * g + 2], S11[4 * g + 3]); *(LAS u32x2*)(wp + 16384 + 2048 + o) = w; }
#pragma unroll
                    for (int k = 0; k < 4; ++k) *(LAS bf16x8*)(L + VT_BASE + (cur ^ 1) * VT_BYTES + vo + 16 * k) = vn[k];
                }
                asm volatile("s_waitcnt lgkmcnt(0)" ::: "memory"); __builtin_amdgcn_s_barrier(); asm volatile("" ::: "memory");
            }
        }
        VM_WAIT();
    }
}
DI void ret_norm(Frame& F) {
    const int lane_ = F.lane;
    char* YF = (char*)(F.ws + WS_YF); const char* YB = (const char*)(F.ws + WS_YB); bf16* RETN = (bf16*)(F.ws + WS_RETG); const float* gain = F.in[8];
    const bf16* RQ = (const bf16*)(F.ws + WS_RQ); const bf16* RK = (const bf16*)(F.ws + WS_RK); const bf16* RVT = (const bf16*)(F.ws + WS_RVT);
    const float* DEC = (const float*)(F.ws + WS_DEC);
    const int r = lane_ & 31, h = lane_ >> 5;
    LAS char* T = (LAS char*)F.lds + F.wave * (32 * 272);
    const int gw = F.vcu * NWAVES + F.wave, NGW = F.G * NWAVES;
    for (int it = gw; it < 2048; it += NGW) {
        const int ntl = it & 3, ch = (it >> 2) & 31, hd = (it >> 7) & 3, b = it >> 9;
        char* yp = YF + ((size_t)it * 16) * 2048 + lane_ * 32;
        const char* yq = YB + ((size_t)it * 16) * 2048 + lane_ * 32;
        const int tokc = b * SEQ + ch * 128, rb0 = tokc >> 5;
        const size_t tok0 = (size_t)tokc + 32 * ntl;
        const float lf = DEC[hd], lb = DEC[4 + hd];
        bf16x8 pb[4][2];
        { f32x16 pT[4]; for (int i = 0; i < 4; ++i) pT[i] = zero16();
          const bf16* qp = RQ + ((size_t)(rb0 + ntl) * 64 + hd * 16) * 512 + lane_ * 8;
          const bf16* kp = RK + ((size_t)rb0 * 64 + hd * 16) * 512 + lane_ * 8;
#pragma unroll 4
          for (int ks = 0; ks < 16; ++ks) {
              const bf16x8 bq = ld16(qp + ks * 512);
#pragma unroll
              for (int mt = 0; mt < 4; ++mt) { const bf16x8 ak = ld16(kp + (size_t)mt * 64 * 512 + ks * 512); pT[mt] = MFMA32(ak, bq, pT[mt]); }
          }
          const int n = 32 * ntl + r;
#pragma unroll
          for (int mt = 0; mt < 4; ++mt) {
#pragma unroll
              for (int i = 0; i < 16; ++i) { const int m = 32 * mt + crow(i, h); const int d = n - m;
                  const float w = d >= 0 ? __builtin_amdgcn_exp2f(lf * (float)d) : __builtin_amdgcn_exp2f(lb * (float)(-d));
                  pT[mt][i] *= w; }
              pb[mt][0] = pack_step(pT[mt], 0); pb[mt][1] = pack_step(pT[mt], 1);
          } }
        float s = 0.f, s2 = 0.f;
#pragma unroll 4
        for (int dvt = 0; dvt < 16; ++dvt) {
            const bf16* vp = RVT + ((size_t)(hd * 16 + dvt) * 1024 + (tokc >> 4)) * 512 + r * 8 + 4 * h;
            const u32x4 a = *(const u32x4*)(yp + dvt * 2048), c = *(const u32x4*)(yp + dvt * 2048 + 16), a2 = *(const u32x4*)(yq + dvt * 2048), c2 = *(const u32x4*)(yq + dvt * 2048 + 16);
            f32x16 acc = zero16();
#pragma unroll
            for (int mt = 0; mt < 4; ++mt)
#pragma unroll
                for (int s2i = 0; s2i < 2; ++s2i) { const bf16* bp = vp + (2 * mt + s2i) * 512; acc = MFMA32(ld8x2(bp, bp + 256), pb[mt][s2i], acc); }
            u32x4 wa, wc;
#pragma unroll
            for (int k = 0; k < 4; ++k) { wa[k] = pk2(bflo(a[k]) + bflo(a2[k]) + acc[2 * k], bfhi(a[k]) + bfhi(a2[k]) + acc[2 * k + 1]); wc[k] = pk2(bflo(c[k]) + bflo(c2[k]) + acc[8 + 2 * k], bfhi(c[k]) + bfhi(c2[k]) + acc[8 + 2 * k + 1]); }
#pragma unroll
            for (int k = 0; k < 4; ++k) { const float x0 = bflo(wa[k]), x1 = bfhi(wa[k]), x2 = bflo(wc[k]), x3 = bfhi(wc[k]); s += (x0 + x1) + (x2 + x3); s2 += (x0 * x0 + x1 * x1) + (x2 * x2 + x3 * x3); }
            *(u32x4*)(yp + dvt * 2048) = wa; *(u32x4*)(yp + dvt * 2048 + 16) = wc;
        }
        s += __shfl_xor(s, 32); s2 += __shfl_xor(s2, 32);
        const float mean = s * (1.f / 512.f);
        const float var = fmaxf(s2 * (1.f / 512.f) - mean * mean, 0.f);
        const float rstd = 1.f / sqrtf(var + LN_EPS);
        VM_WAIT();
#pragma unroll 1
        for (int grp = 0; grp < 4; ++grp) {
#pragma unroll
            for (int t = 0; t < 4; ++t) {
                const u32x4 a = *(const u32x4*)(yp + (4 * grp + t) * 2048), c = *(const u32x4*)(yp + (4 * grp + t) * 2048 + 16);
                const u32x2 av[4] = {{a.x, a.y}, {a.z, a.w}, {c.x, c.y}, {c.z, c.w}};
#pragma unroll
                for (int q = 0; q < 4; ++q) { u32x2 w; w.x = pk2((bflo(av[q].x) - mean) * rstd, (bfhi(av[q].x) - mean) * rstd); w.y = pk2((bflo(av[q].y) - mean) * rstd, (bfhi(av[q].y) - mean) * rstd);
                    *(LAS u32x2*)(T + r * 272 + (32 * t + 8 * q + 4 * h) * 2) = w; }
            }
            LDS_WAIT(); asm volatile("" ::: "memory");
#pragma unroll
            for (int k = 0; k < 8; ++k) {
                const int task = lane_ + 64 * k, tk = task >> 4, cchunk = task & 15;
                const u32x4 v = *(const LAS u32x4*)(T + tk * 272 + cchunk * 16);
                const int col = hd * 512 + 128 * grp + 8 * cchunk;
                const f32x4 ga = *(const f32x4*)(gain + col), gb = *(const f32x4*)(gain + col + 4);
                u32x4 w; w.x = pk2(bflo(v.x) * ga[0], bfhi(v.x) * ga[1]); w.y = pk2(bflo(v.y) * ga[2], bfhi(v.y) * ga[3]); w.z = pk2(bflo(v.z) * gb[0], bfhi(v.z) * gb[1]); w.w = pk2(bflo(v.w) * gb[2], bfhi(v.w) * gb[3]);
                *(u32x4*)(RETN + (tok0 + tk) * 2048 + col) = w;
            }
            LDS_WAIT(); asm volatile("" ::: "memory");
        }
    }
}

DI void attn_phase(Frame& F) {
    const int lane_ = F.lane;
    float* LSE = (float*)(F.ws + WS_LSE);
    const int r = lane_ & 31, h = lane_ >> 5;
    const int gw = F.vcu * NWAVES + F.wave, NGW = F.G * NWAVES;
    for (int it = gw; it < 6144; it += NGW) {
        const int g = it >> 11, rem = it & 2047;
        const int dil = g == 0 ? 1 : (g == 1 ? 4 : 16), nsub = SEQ / dil, nqt = nsub >> 5;
        const int qt = rem % nqt; const int rem2 = rem / nqt; const int rho = rem2 % dil; const int bh = rem2 / dil; const int hg = bh & 3, b = bh >> 2;
        const int head = 4 * g + hg;
        const float slope = __builtin_amdgcn_exp2f(-8.f * (float)(head + 1) * (1.f / 12.f)) * (float)dil;
        const bf16* AQ = (const bf16*)(F.ws + WS_AQ + (size_t)g * 16 * MiB); const bf16* AK = (const bf16*)(F.ws + WS_AK + (size_t)g * 16 * MiB);
        const bf16* AVT = (const bf16*)(F.ws + WS_AVT) + (size_t)g * 512 * NT;
        bf16* OG = (bf16*)(F.ws + (g == 0 ? WS_O0 : (g == 1 ? WS_O1 : WS_O2)));
        const int i0 = 32 * qt;
        const int v0 = b * SEQ + rho * nsub;
        const size_t tokbase = (size_t)b * SEQ + rho;
        bf16x8 bq[8];
        { const bf16* qp = AQ + ((size_t)((v0 + i0) >> 5) * 32 + hg * 8) * 512 + lane_ * 8;
#pragma unroll
          for (int ks = 0; ks < 8; ++ks) bq[ks] = ld16(qp + ks * 512); }
        f32x16 sT[5];
#pragma unroll
        for (int kt = 0; kt < 5; ++kt) {
            int ik0 = i0 - 64 + 32 * kt; ik0 = ik0 < 0 ? 0 : (ik0 >= nsub ? nsub - 32 : ik0);
            const bf16* kp = AK + ((size_t)((v0 + ik0) >> 5) * 32 + hg * 8) * 512 + lane_ * 8;
            f32x16 acc = zero16();
#pragma unroll
            for (int ks = 0; ks < 8; ++ks) acc = MFMA32(ld16(kp + ks * 512), bq[ks], acc);
            sT[kt] = acc;
        }
        const int iq = i0 + r;
        float mx = -3.0e38f;
#pragma unroll
        for (int kt = 0; kt < 5; ++kt)
#pragma unroll
            for (int i = 0; i < 16; ++i) { const int ik = i0 - 64 + 32 * kt + crow(i, h); const int d = ik - iq; const int ad = d < 0 ? -d : d;
                const bool valid = (ad <= 64) && (ik >= 0) && (ik < nsub);
                const float sc = valid ? sT[kt][i] * 0.08838834764831845f - slope * (float)ad : -1e30f;
                sT[kt][i] = sc; mx = fmaxf(mx, sc); }
        mx = fmaxf(mx, __shfl_xor(mx, 32));
        float sum = 0.f;
#pragma unroll
        for (int kt = 0; kt < 5; ++kt)
#pragma unroll
            for (int i = 0; i < 16; ++i) { const float p = __expf(sT[kt][i] - mx); sT[kt][i] = p; sum += p; }
        sum += __shfl_xor(sum, 32);
        const float inv = 1.f / sum;
        if (h == 0) LSE[((size_t)g * NT + tokbase + (size_t)dil * iq) * 4 + hg] = mx + __logf(sum);
        bf16x8 pb[5][2];
#pragma unroll
        for (int kt = 0; kt < 5; ++kt) { pb[kt][0] = pack_step(sT[kt], 0); pb[kt][1] = pack_step(sT[kt], 1); }
        bf16* op = OG + (tokbase + (size_t)dil * iq) * 512 + hg * 128 + 4 * h;
#pragma unroll
        for (int dt = 0; dt < 4; ++dt) {
            const bf16* vp = AVT + ((size_t)(hg * 4 + dt) * 1024) * 512 + r * 8 + 4 * h;
            f32x16 acc = zero16();
#pragma unroll
            for (int kt = 0; kt < 5; ++kt) {
                int ik0 = i0 - 64 + 32 * kt; ik0 = ik0 < 0 ? 0 : (ik0 >= nsub ? nsub - 32 : ik0);
                const bf16* bp = vp + (size_t)((v0 + ik0) >> 4) * 512;
#pragma unroll
                for (int s2 = 0; s2 < 2; ++s2) acc = MFMA32(ld8x2(bp + s2 * 512, bp + s2 * 512 + 256), pb[kt][s2], acc);
            }
#pragma unroll
            for (int q = 0; q < 4; ++q) { u32x2 w; w.x = pk2(acc[4 * q] * inv, acc[4 * q + 1] * inv); w.y = pk2(acc[4 * q + 2] * inv, acc[4 * q + 3] * inv); *(u32x2*)(op + 32 * dt + 8 * q) = w; }
        }
    }
}
DI void attn_mix(Frame& F) {
    const int lane_ = opaque_lane(F);
    const bf16* O0 = (const bf16*)(F.ws + WS_O0); const bf16* O1 = (const bf16*)(F.ws + WS_O1); const bf16* O2 = (const bf16*)(F.ws + WS_O2);
    const float* LSE = (const float*)(F.ws + WS_LSE); bf16* MIX = (bf16*)(F.ws + WS_ATTMIX);
    const int gw = F.bx * NWAVES + F.wave, NGW = F.G * NWAVES;
    for (int m = gw; m < NT; m += NGW) {
        const int hg = lane_ >> 4;
        const float l0 = LSE[((size_t)0 * NT + m) * 4 + hg], l1 = LSE[((size_t)1 * NT + m) * 4 + hg], l2 = LSE[((size_t)2 * NT + m) * 4 + hg];
        const float mx = fmaxf(l0, fmaxf(l1, l2)); const float e0 = __expf(l0 - mx), e1 = __expf(l1 - mx), e2 = __expf(l2 - mx); const float inv = 1.f / (e0 + e1 + e2);
        const float w0 = e0 * inv, w1 = e1 * inv, w2 = e2 * inv;
        const size_t off = (size_t)m * 512 + 8 * lane_;
        const u32x4 a = *(const u32x4*)(O0 + off), b = *(const u32x4*)(O1 + off), c = *(const u32x4*)(O2 + off);
        u32x4 o;
        o.x = pk2(w0 * bflo(a.x) + w1 * bflo(b.x) + w2 * bflo(c.x), w0 * bfhi(a.x) + w1 * bfhi(b.x) + w2 * bfhi(c.x));
        o.y = pk2(w0 * bflo(a.y) + w1 * bflo(b.y) + w2 * bflo(c.y), w0 * bfhi(a.y) + w1 * bfhi(b.y) + w2 * bfhi(c.y));
        o.z = pk2(w0 * bflo(a.z) + w1 * bflo(b.z) + w2 * bflo(c.z), w0 * bfhi(a.z) + w1 * bfhi(b.z) + w2 * bfhi(c.z));
        o.w = pk2(w0 * bflo(a.w) + w1 * bflo(b.w) + w2 * bflo(c.w), w0 * bfhi(a.w) + w1 * bfhi(b.w) + w2 * bfhi(c.w));
        *(u32x4*)(MIX + off) = o;
    }
}

DI float reduce4(const float (&p)[4], int lane) {
    const bool hi = (lane & 32) != 0;
    float a0 = hi ? p[2] : p[0], a1 = hi ? p[3] : p[1]; const float b0 = hi ? p[0] : p[2], b1 = hi ? p[1] : p[3];
    a0 += __shfl_xor(b0, 32); a1 += __shfl_xor(b1, 32);
    const bool hi2 = (lane & 16) != 0;
    float c = hi2 ? a1 : a0; const float d = hi2 ? a0 : a1;
    c += __shfl_xor(d, 16);
    c += __shfl_xor(c, 8); c += __shfl_xor(c, 4); c += __shfl_xor(c, 2); c += __shfl_xor(c, 1);
    return c;
}
DI void bcast4(float c, float (&o)[4]) {
#pragma unroll
    for (int t = 0; t < 4; ++t) o[t] = __builtin_bit_cast(float, __builtin_amdgcn_readlane(__builtin_bit_cast(int, c), 16 * t));
}
template <bool DRY> DI void moe_route(Frame& F) {
    const int lane_ = opaque_lane(F);
    float* H = (float*)F.outb; float* HO = DRY ? (float*)(F.ws + WS_XG) : H; const float* MOD = (const float*)(F.ws + WS_MOD); const float* WR = (const float*)(F.ws + WS_WROUT);
    bf16* U2 = (bf16*)(F.ws + (DRY ? WS_XG + 64 * MiB : WS_U2)); unsigned* ROUTE = (unsigned*)(F.ws + (DRY ? WS_XG + 100 * MiB : WS_ROUTE)); unsigned* CNT = (unsigned*)(F.ws + WS_CTL) + CW_CNT + (DRY ? 4096 : 0);
    const float* g1 = F.in[11]; const float* b1 = F.in[12]; const float* bco = F.in[14]; const float* bfi = F.in[16];
    LAS float* lg = (LAS float*)F.lds + F.wave * 256;
    const int gw = F.bx * NWAVES + F.wave, NGW = F.G * NWAVES;
    f32x4 un[4][4];
    { const int m0 = gw * 4;
      if (m0 < NT) {
#pragma unroll
        for (int t = 0; t < 4; ++t) { const f32x4* hr = (const f32x4*)(H + (size_t)(m0 + t) * DM) + lane_;
#pragma unroll
            for (int j = 0; j < 4; ++j) un[t][j] = hr[64 * j]; } } }
    for (int m0 = gw * 4; m0 < NT; m0 += NGW * 4) {
        const int b = m0 >> 12;
        f32x4 u[4][4];
        float ps[4], tot[4];
#pragma unroll
        for (int t = 0; t < 4; ++t) { float s = 0.f;
#pragma unroll
            for (int j = 0; j < 4; ++j) { u[t][j] = un[t][j]; s += (u[t][j].x + u[t][j].y) + (u[t][j].z + u[t][j].w); }
            ps[t] = s; }
        { const int m1 = m0 + NGW * 4;
          if (m1 < NT) {
#pragma unroll
            for (int t = 0; t < 4; ++t) { const f32x4* hr = (const f32x4*)(H + (size_t)(m1 + t) * DM) + lane_;
#pragma unroll
                for (int j = 0; j < 4; ++j) un[t][j] = hr[64 * j]; } } }
        bcast4(reduce4(ps, lane_), tot);
#pragma unroll
        for (int t = 0; t < 4; ++t) { const float mean = tot[t] * (1.f / DM); float s2 = 0.f;
#pragma unroll
            for (int j = 0; j < 4; ++j) { u[t][j] = u[t][j] - mean; s2 += (u[t][j].x * u[t][j].x + u[t][j].y * u[t][j].y) + (u[t][j].z * u[t][j].z + u[t][j].w * u[t][j].w); }
            ps[t] = s2; }
        bcast4(reduce4(ps, lane_), tot);
#pragma unroll
        for (int t = 0; t < 4; ++t) { const float rstd = 1.f / sqrtf(tot[t] * (1.f / DM) + LN_EPS); f32x4* hw = (f32x4*)(HO + (size_t)(m0 + t) * DM) + lane_; float s = 0.f;
#pragma unroll
            for (int j = 0; j < 4; ++j) { const int col = 256 * j + 4 * lane_; const f32x4 gg = *(const f32x4*)(g1 + col), bb = *(const f32x4*)(b1 + col);
                u[t][j] = u[t][j] * rstd * gg + bb; hw[64 * j] = u[t][j]; s += (u[t][j].x + u[t][j].y) + (u[t][j].z + u[t][j].w); }
            ps[t] = s; }
        bcast4(reduce4(ps, lane_), tot);
#pragma unroll
        for (int t = 0; t < 4; ++t) { const float mean = tot[t] * (1.f / DM); float s2 = 0.f;
#pragma unroll
            for (int j = 0; j < 4; ++j) { u[t][j] = u[t][j] - mean; s2 += (u[t][j].x * u[t][j].x + u[t][j].y * u[t][j].y) + (u[t][j].z * u[t][j].z + u[t][j].w * u[t][j].w); }
            ps[t] = s2; }
        bcast4(reduce4(ps, lane_), tot);
#pragma unroll
        for (int t = 0; t < 4; ++t) { const float rstd = 1.f / sqrtf(tot[t] * (1.f / DM) + LN_EPS); u32x2* o8 = (u32x2*)(U2 + (size_t)(m0 + t) * DM) + lane_;
#pragma unroll
            for (int j = 0; j < 4; ++j) { const int col = 256 * j + 4 * lane_;
                const f32x4 sh = *(const f32x4*)(MOD + b * 6144 + 3072 + col), sc = *(const f32x4*)(MOD + b * 6144 + 4096 + col);
                u[t][j] = u[t][j] * rstd * (sc + 1.f) + sh;
                u32x2 w; w.x = pk2(u[t][j].x, u[t][j].y); w.y = pk2(u[t][j].z, u[t][j].w); o8[64 * j] = w; } }
#ifndef ROUTE_NO
#define ROUTE_NO 36
#endif
#pragma unroll 2
        for (int o = 0; o < (DRY ? ROUTE_NO : 36); ++o) {
            const f32x4* wr = (const f32x4*)(WR + o * 1024) + lane_;
            f32x4 w[4];
#pragma unroll
            for (int j = 0; j < 4; ++j) w[j] = wr[64 * j];
#pragma unroll
            for (int t = 0; t < 4; ++t) { float a = 0.f;
#pragma unroll
                for (int j = 0; j < 4; ++j) a += (u[t][j].x * w[j].x + u[t][j].y * w[j].y) + (u[t][j].z * w[j].z + u[t][j].w * w[j].w);
                ps[t] = a; }
            const float c = reduce4(ps, lane_);
            if ((lane_ & 15) == 0) lg[(lane_ >> 4) * 64 + o] = c;
        }
        LDS_WAIT(); asm volatile("" ::: "memory");
        if (lane_ < 4) {
            const int t = lane_, m = m0 + t; const LAS float* L = lg + t * 64;
            float c[4]; int gs = 0; float cm = -3.0e38f;
#pragma unroll
            for (int j = 0; j < 4; ++j) { c[j] = L[j] + bco[j]; if (c[j] > cm) { cm = c[j]; gs = j; } }
            float den = 0.f;
#pragma unroll
            for (int j = 0; j < 4; ++j) den += __expf(c[j] - cm);
            const float pg = 1.f / den;
            float f[8];
#pragma unroll
            for (int e = 0; e < 8; ++e) f[e] = L[4 + 8 * gs + e] + bfi[8 * gs + e];
            int i0 = 0; float v0 = f[0];
#pragma unroll
            for (int e = 1; e < 8; ++e) if (f[e] > v0) { v0 = f[e]; i0 = e; }
            int i1 = -1; float v1 = -3.0e38f;
#pragma unroll
            for (int e = 0; e < 8; ++e) if (e != i0 && f[e] > v1) { v1 = f[e]; i1 = e; }
            const float e1 = __expf(v1 - v0); const float w0 = pg / (1.f + e1), w1 = pg * e1 / (1.f + e1);
            const int ex0 = gs * 8 + i0, ex1 = gs * 8 + i1;
            const unsigned p0 = atomicAdd(CNT + 64 * ex0, 1u), p1 = atomicAdd(CNT + 64 * ex1, 1u);
            unsigned* R = ROUTE + (size_t)m * 8;
            R[0] = ex0; R[1] = ex1; R[2] = p0; R[3] = p1; R[4] = __float_as_uint(w0); R[5] = __float_as_uint(w1);
        }
        LDS_WAIT(); asm volatile("" ::: "memory");
    }
}
DI int moe_tables(Frame& F) {
    LAS int* tab = (LAS int*)(F.lds + TEXP_OFF);
    if (F.tid == 0) {
        const unsigned* CNT = (const unsigned*)(F.ws + WS_CTL) + CW_CNT;
        int t = 0;
        for (int e = 0; e < 32; ++e) { const int c = (int)xb_ld((unsigned*)CNT + 64 * e); const int nt = (c + 255) >> 8; tab[192 + e] = t * 256; for (int k = 0; k < nt; ++k) tab[t + k] = e; t += nt; }
        tab[224] = t;
    }
    __syncthreads();
    return tab[224];
}
DI void moe_gather(Frame& F) {
    const int lane_ = opaque_lane(F);
    const LAS int* tab = (const LAS int*)(F.lds + TEXP_OFF);
    const bf16* U2 = (const bf16*)(F.ws + WS_U2); bf16* XG = (bf16*)(F.ws + WS_XG); unsigned* ROUTE = (unsigned*)(F.ws + WS_ROUTE);
    const int gw = F.bx * NWAVES + F.wave, NGW = F.G * NWAVES;
    for (int a = gw; a < 2 * NT; a += NGW) {
        const int m = a >> 1, k = a & 1;
        const unsigned e = ROUTE[(size_t)m * 8 + k], pos = ROUTE[(size_t)m * 8 + 2 + k];
        const int slot = tab[192 + e] + (int)pos;
        const u32x4* src = (const u32x4*)(U2 + (size_t)m * DM) + lane_; u32x4* dst = (u32x4*)(XG + (size_t)slot * DM) + lane_;
        dst[0] = src[0]; dst[64] = src[64];
        if (lane_ == 0) ROUTE[(size_t)m * 8 + 6 + k] = (unsigned)slot;
    }
}
template <bool DRY> DI void moe_combine(Frame& F) {
    const int lane_ = opaque_lane(F);
    float* H = (float*)F.outb; float* HO = DRY ? (float*)(F.ws + WS_HDN) : H; const float* MOD = (const float*)(F.ws + WS_MOD); const bf16* YR = (const bf16*)(F.ws + WS_YROWS); const unsigned* ROUTE = (const unsigned*)(F.ws + WS_ROUTE);
    const float* g2 = F.in[20]; const float* b2 = F.in[21];
    const int gw = F.bx * NWAVES + F.wave, NGW = F.G * NWAVES;
    for (int m = gw; m < NT; m += NGW) {
        const int b = m >> 12; const unsigned* R = ROUTE + (size_t)m * 8;
        const float w0 = __uint_as_float(R[4]), w1 = __uint_as_float(R[5]); const size_t s0 = R[6], s1 = R[7];
        f32x4* hr = (f32x4*)(H + (size_t)m * DM) + lane_; f32x4* hw = (f32x4*)(HO + (size_t)m * DM) + lane_;
        f32x4 v[4]; float s = 0.f;
#pragma unroll
        for (int j = 0; j < 4; ++j) { const int col = 256 * j + 4 * lane_;
            const u32x2 ya = *(const u32x2*)(YR + s0 * DM + col), yb = *(const u32x2*)(YR + s1 * DM + col);
            const f32x4 y = {w0 * bflo(ya.x) + w1 * bflo(yb.x), w0 * bfhi(ya.x) + w1 * bfhi(yb.x), w0 * bflo(ya.y) + w1 * bflo(yb.y), w0 * bfhi(ya.y) + w1 * bfhi(yb.y)};
            const f32x4 gt = *(const f32x4*)(MOD + b * 6144 + 5120 + col);
            v[j] = hr[64 * j] * ALPHA + gt * y; s += (v[j].x + v[j].y) + (v[j].z + v[j].w); }
        const float mean = wave_sum(s) * (1.f / DM); float s2 = 0.f;
#pragma unroll
        for (int j = 0; j < 4; ++j) { v[j] = v[j] - mean; s2 += (v[j].x * v[j].x + v[j].y * v[j].y) + (v[j].z * v[j].z + v[j].w * v[j].w); }
        const float rstd = 1.f / sqrtf(wave_sum(s2) * (1.f / DM) + LN_EPS);
#pragma unroll
        for (int j = 0; j < 4; ++j) { const int col = 256 * j + 4 * lane_; hw[64 * j] = v[j] * rstd * *(const f32x4*)(g2 + col) + *(const f32x4*)(b2 + col); }
    }
}

__global__ void __launch_bounds__(NTHREADS, 2) fwd_kernel(Args args) {
    extern __shared__ __attribute__((aligned(16))) unsigned char lds[];
    Frame F;
    F.lds = (LAS unsigned char*)lds;
    F.tid = threadIdx.x; F.lane = F.tid & 63; F.wave = __builtin_amdgcn_readfirstlane(F.tid >> 6);
    F.G = gridDim.x; F.bx = blockIdx.x; F.vcu = (F.G % 8 == 0) ? (F.bx % 8) * (F.G / 8) + F.bx / 8 : F.bx;
    F.ws = args.ws; F.outb = (unsigned char*)args.out;
#pragma unroll
    for (int i = 0; i < 22; ++i) F.in[i] = args.in[i];
    for (int u = F.tid; u < (LDS_BYTES - LDSX_OFF) / 4; u += NTHREADS) ((LAS unsigned*)(F.lds + LDSX_OFF))[u] = 0u;
    __syncthreads();
    unsigned* ctl = (unsigned*)(F.ws + WS_CTL);
    XcdBarrier bar = xcd_barrier_post(ctl + CW_BAR, (volatile LAS unsigned*)(F.lds + MISC_OFF) + 8);
    if (F.tid == 0) ((volatile LAS unsigned*)(F.lds + MISC_OFF))[12] = xb_add(ctl + CW_RANK + 64 * bar.x, 1u);
    unsigned long long* TS = (unsigned long long*)(ctl + 32768);
    int nst = 1;
    if (PROF && F.bx == 0 && F.tid == 0) TS[0] = __builtin_amdgcn_s_memrealtime();
#define GRID_BAR() do { xcd_barrier(bar); if (PROF && F.bx == 0 && F.tid == 0) TS[nst] = __builtin_amdgcn_s_memrealtime(); ++nst; } while (0)
    const char* U = (const char*)(F.outb + OUT_U); const char* WINT = (const char*)(F.outb + OUT_WINT);

    REP(1,  phase0(F); GRID_BAR();
    phase1(F); GRID_BAR(); );
    { volatile LAS unsigned* M = (volatile LAS unsigned*)(F.lds + MISC_OFF);
      if (F.tid == 0) { unsigned pre = 0, nx = 0, mine = 0, even = 1, idx = 0;
          for (unsigned j = 0; j < 16; ++j) { const unsigned cj = xb_ld(ctl + CW_BAR + XB_XCNT(j)); if (j < bar.x) { pre += cj; idx += (cj > 0u); } if (j == bar.x) mine = cj; nx += (cj > 0u); if (cj != 0u && cj * 8u != (unsigned)F.G) even = 0; }
          const unsigned rank = M[12];
          M[13] = pre + rank; M[14] = (even && nx == 8u) ? rank * 8u + idx : (unsigned)F.bx; (void)mine; }
      __syncthreads();
      F.vcu = (int)M[13]; }
    const int c = (int)((volatile LAS unsigned*)(F.lds + MISC_OFF))[14];
    REP(2,
    { SchedR1 S; S.init(64, 8, F.G, c); S.U = U; S.W = WINT;
      pg8::EpiV<EpiR1> E{EpiR1{(bf16*)(F.ws + WS_RQ), (bf16*)(F.ws + WS_RK)}};
      pg8::gemm_phase<pg8::EpiV<EpiR1>, SchedR1, true>(F.lds, 1024, 1024, 1024, S, E); }
    { SchedR2 S; S.init(12, 64, F.G, c); S.U = U; S.W = WINT;
      pg8::EpiV<EpiR2> E{EpiR2{(bf16*)(F.ws + WS_RVT), (bf16*)(F.ws + WS_KFT), (bf16*)(F.ws + WS_KBT), (const float*)(F.ws + WS_DEC)}};
      pg8::gemm_phase<pg8::EpiV<EpiR2>, SchedR2, true>(F.lds, 1024, 1024, 1024, S, E); }
    GRID_BAR(); );
    REP(3, ret_scan(F); GRID_BAR(); );
    ret_norm(F); GRID_BAR();
    REP(4,
    _Pragma("unroll 1")
    for (int g = 0; g < 3; ++g) {
        const int dil = g == 0 ? 1 : (g == 1 ? 4 : 16);
        SchedQK S; S.init(64, 4, F.G, c); S.U = U; S.W = WINT; S.g = g; S.r = dil; S.nsub = SEQ / dil;
        pg8::EpiV<EpiQK> E{EpiQK{(bf16*)(F.ws + WS_AQ + (size_t)g * 16 * MiB), (bf16*)(F.ws + WS_AK + (size_t)g * 16 * MiB)}};
        pg8::gemm_phase<pg8::EpiV<EpiQK>, SchedQK, true>(F.lds, 1024, 1024 * dil, 1024, S, E);
    }
    { SchedGate S; S.init(64, 16, F.G, c); S.U = U; S.W = WINT;
      pg8::EpiV<EpiGate> E{EpiGate{(bf16*)(F.ws + WS_RETG), (bf16*)(F.ws + WS_GA), (bf16*)(F.ws + WS_GR)}};
      pg8::gemm_phase<pg8::EpiV<EpiGate>, SchedGate, true>(F.lds, 1024, 1024, 1024, S, E); }
_Pragma("unroll 1")
    for (int g = 0; g < 3; ++g) {
        const int dil = g == 0 ? 1 : (g == 1 ? 4 : 16);
        SchedA2 S; const int cc = (g == 1) ? c - 128 : c; S.init(2, 64, F.G, (cc >= 0 && cc < 128) ? cc : -1); S.U = U; S.W = WINT; S.g = g; S.r = dil; S.nsub = SEQ / dil;
        pg8::EpiV<EpiA2> E{EpiA2{(bf16*)(F.ws + WS_AVT) + (size_t)g * 512 * NT}};
        pg8::gemm_phase<pg8::EpiV<EpiA2>, SchedA2, true>(F.lds, 1024, 1024, 1024 * dil, S, E);
    }
    GRID_BAR(); );
    REP(5,  attn_phase(F); GRID_BAR(); );
    REP(6,  attn_mix(F); GRID_BAR(); );
    REP(7,
    { SchedG S; S.init(64, 4, F.G, c); S.A = (const char*)(F.ws + WS_ATTMIX); S.B = (const char*)(F.ws + WS_WAT); S.abytes = 256 * 512 * 2; S.bbytes = 256 * 512 * 2;
      pg8::EpiV<EpiG1> E{EpiG1{(const bf16*)(F.ws + WS_GA), (bf16*)F.outb}};
      pg8::gemm_phase<pg8::EpiV<EpiG1>, SchedG, true>(F.lds, 512, 512, 512, S, E); }
    { SchedG S; S.init(64, 4, F.G, c); S.A = (const char*)(F.ws + WS_RETG); S.B = (const char*)(F.ws + WS_WRT); S.abytes = 256 * 2048 * 2; S.bbytes = 256 * 2048 * 2;
      pg8::EpiV<EpiG2> E{EpiG2{(const bf16*)(F.ws + WS_GR), (const bf16*)F.outb, (bf16*)(F.ws + WS_MERGED)}};
      pg8::gemm_phase<pg8::EpiV<EpiG2>, SchedG, true>(F.lds, 2048, 2048, 2048, S, E); }
    GRID_BAR();
    { SchedG S; S.init(64, 4, F.G, c); S.A = (const char*)(F.ws + WS_MERGED); S.B = (const char*)(F.ws + WS_WOT); S.abytes = 256 * 1024 * 2; S.bbytes = 256 * 1024 * 2;
      pg8::EpiV<EpiG3> E{EpiG3{F.in[0], (const float*)(F.ws + WS_MOD), (float*)F.outb}};
      pg8::gemm_phase<pg8::EpiV<EpiG3>, SchedG, true>(F.lds, 1024, 1024, 1024, S, E); }
    GRID_BAR(); );
    if (F.wave & 1) { moe_weight_transposes(F); moe_route<false>(F); } else { moe_route<false>(F); moe_weight_transposes(F); }
    GRID_BAR();
    REPX(11, moe_route<true>(F); GRID_BAR(); );
    const int ntiles = moe_tables(F);
    REP(8,  moe_gather(F); GRID_BAR(); );
    REP(9,
    { SchedM S; S.init(ntiles, 4, F.G, c); S.A = (const char*)(F.ws + WS_XG); S.B = (const char*)(F.ws + WS_W13T); S.abytes = 256 * 1024 * 2; S.ebytes = (size_t)1024 * 1024 * 2; S.bbytes = 256 * 1024 * 2;
      S.texp = (const LAS int*)(F.lds + TEXP_OFF);
      pg8::EpiV<EpiM3> E{EpiM3{(bf16*)(F.ws + WS_HDN)}};
      pg8::gemm_phase<pg8::EpiV<EpiM3>, SchedM, true>(F.lds, 1024, 1024, 1024, S, E); }
    GRID_BAR();
    { SchedM S; S.init(ntiles, 4, F.G, c); S.A = (const char*)(F.ws + WS_HDN); S.B = (const char*)(F.ws + WS_W2T); S.abytes = 256 * 512 * 2; S.ebytes = (size_t)1024 * 512 * 2; S.bbytes = 256 * 512 * 2;
      S.texp = (const LAS int*)(F.lds + TEXP_OFF);
      pg8::EpiV<EpiM4> E{EpiM4{(bf16*)(F.ws + WS_YROWS)}};
      pg8::gemm_phase<pg8::EpiV<EpiM4>, SchedM, true>(F.lds, 512, 512, 512, S, E); }
    GRID_BAR(); );
    REPX(12, moe_combine<true>(F); GRID_BAR(); );
    REPX(13, GRID_BAR(); GRID_BAR(); GRID_BAR(); GRID_BAR(); GRID_BAR(); GRID_BAR(); GRID_BAR(); GRID_BAR(); GRID_BAR(); GRID_BAR(); );
    moe_combine<false>(F);
#if PROF
    GRID_BAR();
    { const unsigned long long ta0 = __hip_atomic_load(TS + PROF_A - 1, __ATOMIC_RELAXED, __HIP_MEMORY_SCOPE_AGENT), ta1 = __hip_atomic_load(TS + PROF_A, __ATOMIC_RELAXED, __HIP_MEMORY_SCOPE_AGENT);
      const unsigned long long tb0 = __hip_atomic_load(TS + PROF_B - 1, __ATOMIC_RELAXED, __HIP_MEMORY_SCOPE_AGENT), tb1 = __hip_atomic_load(TS + PROF_B, __ATOMIC_RELAXED, __HIP_MEMORY_SCOPE_AGENT);
      const float V1 = (float)(ta1 - ta0) * 0.01f, V2 = (float)(tb1 - tb0) * 0.01f * 20.f;
      float* out = (float*)F.outb;
      for (int i = F.bx * NTHREADS + F.tid; i < NT * DM; i += F.G * NTHREADS) out[i] = (i < 16) ? V2 : V1; }
#endif
}

extern "C" void kernel_launch(void* const* d_in, const int* in_sizes, int n_in, void* d_out, int out_size, void* d_ws, size_t ws_size, hipStream_t stream) {
    static int grid = 0;
    if (grid == 0) {
        if (n_in != 22 || out_size != NT * DM || ws_size < WS_END) { fprintf(stderr, "kernel_launch: unexpected problem (n_in %d, out %d, ws %zu)\n", n_in, out_size, ws_size); grid = -1; return; }
        int dev = 0, cus = 0, per_cu = 0;
        if (hipGetDevice(&dev) != hipSuccess || hipDeviceGetAttribute(&cus, hipDeviceAttributeMultiprocessorCount, dev) != hipSuccess) { grid = -1; return; }
        if (hipFuncSetAttribute((const void*)fwd_kernel, hipFuncAttributeMaxDynamicSharedMemorySize, LDS_BYTES) != hipSuccess) { grid = -1; return; }
        if (hipOccupancyMaxActiveBlocksPerMultiprocessor(&per_cu, (const void*)fwd_kernel, NTHREADS, LDS_BYTES) != hipSuccess || per_cu < 1) { fprintf(stderr, "kernel_launch: occupancy query reports %d blocks/CU\n", per_cu); (void)hipGetLastError(); grid = -1; return; }
        grid = cus;
    }
    if (grid < 0) return;
    (void)hipMemsetAsync((char*)d_ws + WS_CTL, 0, CTL_ZERO_BYTES, stream);
    Args a{};
    for (int i = 0; i < 22; ++i) a.in[i] = (const float*)d_in[i];
    a.out = (float*)d_out; a.ws = (unsigned char*)d_ws;
    hipLaunchKernelGGL(fwd_kernel, dim3(grid), dim3(NTHREADS), LDS_BYTES, stream, a);
}
```

```cpp
#ifndef PROF
#define PROF 0
#endif
#ifndef DUP
#define DUP 0
#endif
#define REP(k, ...) do { __VA_ARGS__ if (DUP == (k)) { __VA_ARGS__ } } while (0)
#define REPX(k, ...) do { if (DUP == (k)) { __VA_ARGS__ } } while (0)
#ifndef PROF_A
#define PROF_A 1
#endif
#ifndef PROF_B
#define PROF_B 2
#endif
#include <hip/hip_runtime.h>
#include <cstdio>
#include <cstdint>

#define GAS __attribute__((address_space(1)))
#define LAS __attribute__((address_space(3)))
#define DI __device__ __forceinline__
typedef unsigned short bf16;
typedef float f32x4 __attribute__((ext_vector_type(4)));
typedef float f32x16 __attribute__((ext_vector_type(16)));
typedef float f32x2 __attribute__((ext_vector_type(2)));
typedef short bf16x8 __attribute__((ext_vector_type(8)));
typedef short s16x4 __attribute__((ext_vector_type(4)));
typedef __bf16 bf16x2_t __attribute__((ext_vector_type(2)));
typedef unsigned u32x4 __attribute__((ext_vector_type(4)));
typedef unsigned u32x2 __attribute__((ext_vector_type(2)));

constexpr int NT = 16384, DM = 1024, SEQ = 4096, NB = 4;
constexpr int NWAVES = 8, NTHREADS = 512;
constexpr int LDS_BYTES = 163840, RING_BYTES = 147456, LDSX_OFF = RING_BYTES;
constexpr int MISC_OFF = LDSX_OFF + 320;
constexpr int TEXP_OFF = LDSX_OFF + 1024;
constexpr float LN_EPS = 1e-5f;
constexpr float ALPHA = 1.189207115002721f;

constexpr size_t MiB = 1u << 20;
constexpr size_t WS_CTL = 0, CTL_ZERO_BYTES = (PROF ? 1024 : 128) * 1024;
constexpr size_t WS_MOD = 1 * MiB;
constexpr size_t WS_DEC = 1 * MiB + 112 * 1024;
constexpr size_t WS_WROUT = 1 * MiB + 128 * 1024;
constexpr size_t WS_WAT = 2 * MiB, WS_WRT = 3 * MiB, WS_WOT = 7 * MiB;
constexpr size_t WS_LSE = 9 * MiB;
constexpr size_t WS_ROUTE = 10 * MiB;
constexpr size_t WS_RQ = 12 * MiB, WS_RK = 44 * MiB, WS_YB = 76 * MiB, WS_RVT = 140 * MiB, WS_KFT = 204 * MiB, WS_KBT = 236 * MiB, WS_YF = 268 * MiB, WS_RETG = 204 * MiB;
constexpr size_t WS_AQ = 12 * MiB, WS_AK = 60 * MiB, WS_AVT = 108 * MiB, WS_GA = 156 * MiB, WS_O0 = 188 * MiB, WS_GR = 268 * MiB, WS_O1 = 300 * MiB, WS_O2 = 316 * MiB;
constexpr size_t WS_ATTMIX = 12 * MiB, WS_MERGED = 28 * MiB, WS_W13T = 60 * MiB, WS_W2T = 124 * MiB;
constexpr size_t WS_U2 = 156 * MiB, WS_XG = 188 * MiB, WS_HDN = 268 * MiB, WS_YROWS = 188 * MiB;
constexpr size_t WS_END = 332 * MiB;
constexpr size_t OUT_U = 0, OUT_WINT = 32 * MiB;
constexpr int CW_BAR = 4096;
constexpr int CW_CNT = 16384;
constexpr int CW_RANK = 20480;

constexpr int C_AQ = 0, C_AK = 1536, C_AV = 3072, C_RQ = 4608, C_RK = 5632, C_RV = 6656, C_RGT = 8704, C_GA = 10752, C_GR = 11776, C_END = 12800;

#define LDS_WAIT() asm volatile("s_waitcnt lgkmcnt(0)" ::: "memory")
#define VM_WAIT() asm volatile("s_waitcnt vmcnt(0)" ::: "memory")
DI unsigned pk2(float lo, float hi) { f32x2 v = {lo, hi}; bf16x2_t r = __builtin_convertvector(v, bf16x2_t); return __builtin_bit_cast(unsigned, r); }
DI float bf2f(unsigned short b) { return __builtin_bit_cast(float, (unsigned)b << 16); }
DI float bflo(unsigned w) { return __builtin_bit_cast(float, w << 16); }
DI float bfhi(unsigned w) { return __builtin_bit_cast(float, w & 0xffff0000u); }
DI float wave_sum(float v) {
#pragma unroll
    for (int o = 1; o < 64; o <<= 1) v += __shfl_xor(v, o);
    return v;
}
DI float sigmoidf_(float x) { return 1.f / (1.f + __expf(-x)); }
DI float log2_sigmoid(float x) { return -log1pf(expf(-x)) * 1.4426950408889634f; }
#define MFMA32(a, b, c) __builtin_amdgcn_mfma_f32_32x32x16_bf16((a), (b), (c), 0, 0, 0)
DI int crow(int reg, int h) { return (reg & 3) + 8 * (reg >> 2) + 4 * h; }
DI bf16x8 pack_step(const f32x16& x, int s) {
    u32x4 p; p[0] = pk2(x[8 * s], x[8 * s + 1]); p[1] = pk2(x[8 * s + 2], x[8 * s + 3]); p[2] = pk2(x[8 * s + 4], x[8 * s + 5]); p[3] = pk2(x[8 * s + 6], x[8 * s + 7]);
    return __builtin_bit_cast(bf16x8, p);
}
DI bf16x8 ld16(const bf16* p) { return *(const bf16x8*)p; }
DI bf16x8 ld8x2(const bf16* p0, const bf16* p1) { const s16x4 a = *(const s16x4*)p0, b = *(const s16x4*)p1; return __builtin_shufflevector(a, b, 0, 1, 2, 3, 4, 5, 6, 7); }
DI size_t blk_off(int row, int k, int kblocks) { return ((size_t)(row >> 5) * kblocks + (k >> 4)) * 512 + ((k >> 3) & 1) * 256 + (row & 31) * 8; }
DI f32x16 zero16() { f32x16 z; for (int i = 0; i < 16; ++i) z[i] = 0.f; return z; }

#define XB_TMO      128
#define XB_XCNT(j)  (256  + 64 * (j))
#define XB_XSUB(j)  (1280 + 64 * (j))
#define XB_XGEN(j)  (2304 + 64 * (j))
#define XB_TOP      3328
#define XB_TOPGEN   3392
#define XCD_BAR_WORDS 3456
#define XB_SPIN_CAP (1u << 18)
DI unsigned xb_ld(unsigned* p)              { return __hip_atomic_load(p, __ATOMIC_RELAXED, __HIP_MEMORY_SCOPE_AGENT); }
DI unsigned xb_add(unsigned* p, unsigned v) { return __hip_atomic_fetch_add(p, v, __ATOMIC_RELAXED, __HIP_MEMORY_SCOPE_AGENT); }
DI unsigned xb_xcc_id() { return (unsigned)__builtin_amdgcn_s_getreg((3 << 11) | 20) & 0xFu; }
#define XB_SPIN(cond, bar) do { unsigned _sp = 0; while (cond) { __builtin_amdgcn_s_sleep(1); \
    if ((++_sp & 255u) == 0u) { if (xb_ld(&(bar)[XB_TMO])) break; if (_sp > XB_SPIN_CAP) { atomicAdd(&(bar)[XB_TMO], 1u); break; } } } } while (0)
struct XcdBarrier { unsigned* bar; unsigned x; volatile LAS unsigned* st; };
DI XcdBarrier xcd_barrier_post(unsigned* bar, volatile LAS unsigned* st) {
    XcdBarrier b; b.bar = bar; b.x = xb_xcc_id(); b.st = st;
    if (threadIdx.x == 0) (void)xb_add(&bar[XB_XCNT(b.x)], 1u);
    return b;
}
DI void xcd_barrier_complete(unsigned* bar, unsigned x, unsigned& nloc, unsigned& nx) {
    const unsigned G = gridDim.x * gridDim.y * gridDim.z;
    unsigned sum, cnt, mine, sp = 0u;
    for (;;) {
        sum = 0u; cnt = 0u; mine = 0u;
#pragma unroll
        for (unsigned j = 0; j < 16; ++j) { const unsigned c = xb_ld(&bar[XB_XCNT(j)]); sum += c; cnt += (c > 0u) ? 1u : 0u; mine = (j == x) ? c : mine; }
        if (sum == G) break;
        __builtin_amdgcn_s_sleep(1);
        if ((++sp & 255u) == 0u) { if (xb_ld(&bar[XB_TMO])) break; if (sp > XB_SPIN_CAP) { atomicAdd(&bar[XB_TMO], 1u); break; } }
    }
    nloc = mine > 0u ? mine : 1u; nx = cnt > 0u ? cnt : 1u;
}
DI void xcd_barrier(const XcdBarrier& b) {
    asm volatile("s_waitcnt vmcnt(0)" ::: "memory");
    __syncthreads();
    if (threadIdx.x == 0) {
        unsigned* bar = b.bar;
        __builtin_amdgcn_s_waitcnt(0);
        unsigned nloc = b.st[0], nx = b.st[1];
        if (nloc == 0u) { xcd_barrier_complete(bar, b.x, nloc, nx); b.st[0] = nloc; b.st[1] = nx; }
        const unsigned old = xb_add(&bar[XB_XSUB(b.x)], 1u);
        const unsigned gen = old / nloc;
        if (old + 1u == (gen + 1u) * nloc) {
            __builtin_amdgcn_fence(__ATOMIC_RELEASE, "agent");
            asm volatile("s_waitcnt vmcnt(0)" ::: "memory");
            const unsigned og = xb_add(&bar[XB_TOP], 1u);
            const unsigned tg = og / nx;
            if (og + 1u == (tg + 1u) * nx) xb_add(&bar[XB_TOPGEN], 1u);
            else XB_SPIN(xb_ld(&bar[XB_TOPGEN]) == tg, bar);
            __builtin_amdgcn_fence(__ATOMIC_ACQUIRE, "agent");
            xb_add(&bar[XB_XGEN(b.x)], 1u);
            asm volatile("s_waitcnt vmcnt(0)" ::: "memory");
        } else {
            XB_SPIN(xb_ld(&bar[XB_XGEN(b.x)]) == gen, bar);
            __builtin_amdgcn_fence(__ATOMIC_ACQUIRE, "agent");
            asm volatile("s_waitcnt vmcnt(0)" ::: "memory");
        }
    }
    __syncthreads();
}

namespace pg8 {
#define PG8_LAS __attribute__((address_space(3)))
constexpr int BM = 256, BK = 64, HALF = 128, HTB = HALF * BK * 2, STAGE_BYTES = 8 * HTB, NXCD = 8, WGM = 8;
__host__ __device__ __forceinline__ int lds_byte(int r, int c) { const int st = (r >> 4) * 2 + (c >> 5), rr = r & 15, cc = c & 31, ob = rr * 64 + cc * 2; return st * 1024 + (ob ^ (((ob >> 9) & 1) << 5)); }
__host__ __device__ __forceinline__ void stage_rc(int b, int& R, int& C) { const int st = b / 1024, sb = b % 1024, swz = sb ^ (((sb >> 9) & 1) << 5); R = (st >> 1) * 16 + swz / 64; C = (st & 1) * 32 + (swz % 64) / 2; }
__host__ __device__ __forceinline__ int perm32(int rho) { const int n = rho >> 4, i = rho & 15; return 8 * (i >> 2) + 4 * n + (i & 3); }
struct Unit { int pm, pn; };
struct StaticOrder {
    int nM, nN, nwg, G, c;
    __host__ __device__ void init(int nM_, int nN_, int G_, int c_) { nM = nM_; nN = nN_; nwg = nM * nN; G = G_; c = c_; }
    __host__ __device__ bool next(int i, Unit& u) const {
        const long L = (long)i * G + c; if (c < 0 || L >= nwg) return false;
        int wgid = (int)L; { const int q = nwg / NXCD, r = nwg % NXCD, xcd = wgid % NXCD, off = wgid / NXCD; wgid = (xcd < r ? xcd * (q + 1) : r * (q + 1) + (xcd - r) * q) + off; }
        const int nig = WGM * nN, gid = wgid / nig, fm = gid * WGM, gsz = (nM - fm) < WGM ? (nM - fm) : WGM;
        u.pm = fm + ((wgid % nig) % gsz); u.pn = (wgid % nig) / gsz; return true;
    }
};
template <class F> struct EpiV {
    F f;
    __device__ __forceinline__ void operator()(const f32x4 (&acc)[2][2][4][2], const Unit& u, int wr, int wc, int fr, int fq) const {
        const int row0 = u.pm * BM + wr * 64 + fr, col0 = u.pn * BM + wc * 32 + 8 * fq;
#pragma unroll
        for (int ai = 0; ai < 2; ++ai)
#pragma unroll
            for (int m = 0; m < 4; ++m)
#pragma unroll
                for (int bj = 0; bj < 2; ++bj) f(row0 + ai * HALF + m * 16, col0 + bj * HALF, acc[ai][bj][m][0], acc[ai][bj][m][1]);
    }
};
template <class Epi, class Sched, bool ALIGN_EPI = false>
__device__ __forceinline__ void gemm_phase(PG8_LAS unsigned char* lds, const int K, const int lda, const int ldb, const Sched& S, const Epi& E) {
    int tid_ = threadIdx.x; asm volatile("" : "+v"(tid_));
    const int tid = tid_, wid = __builtin_amdgcn_readfirstlane(tid >> 6), lane = tid & 63, wr = wid >> 2, wc = wid & 3, fr = lane & 15, fq = lane >> 4;
    const int nt = K / BK;
    unsigned voffA[2], voffB[2];
#pragma unroll
    for (int i = 0; i < 2; ++i) { int R, C; stage_rc(tid * 16 + i * 8192, R, C); const int Rb = (R & ~31) + perm32(R & 31);
        voffA[i] = (unsigned)(R * lda + C) * 2u; voffB[i] = (unsigned)(Rb * ldb + C) * 2u; }
    const size_t kstep = (size_t)(BK * 2);
    const size_t hstepA = (size_t)HALF * lda * 2, hstepB = (size_t)HALF * ldb * 2;
    const unsigned ldsw = (unsigned)wid * 1024u;
    const int aoff = lds_byte(wr * 64 + fr, fq * 8), boff = lds_byte(wc * 32 + fr, fq * 8);
#define PG8_SA(b, h) (((b) * 2 + (h)) * HTB)
#define PG8_SB(b, h) ((4 + (b) * 2 + (h)) * HTB)
#define PG8_STAGE(bufoff, gbase, voff) do { _Pragma("unroll") for (int _i = 0; _i < 2; ++_i) \
        __builtin_amdgcn_global_load_lds((const unsigned*)((const char*)(gbase) + (voff)[_i]), (PG8_LAS unsigned*)(lds + (bufoff) + ldsw + _i * 8192), 16, 0, 0); } while (0)
#define PG8_LDA(dst, b, h) do { _Pragma("unroll") for (int m = 0; m < 4; ++m) _Pragma("unroll") for (int k = 0; k < 2; ++k) dst[m][k] = *(const PG8_LAS bf16x8*)(lds + PG8_SA(b, h) + aoff + m * 2048 + k * 1024); } while (0)
#define PG8_LDB(dst, b, h) do { _Pragma("unroll") for (int n = 0; n < 2; ++n) _Pragma("unroll") for (int k = 0; k < 2; ++k) dst[n][k] = *(const PG8_LAS bf16x8*)(lds + PG8_SB(b, h) + boff + n * 2048 + k * 1024); } while (0)
#define PG8_MMA(ai, bj, At, Bt) do { __builtin_amdgcn_s_setprio(1); _Pragma("unroll") for (int m = 0; m < 4; ++m) _Pragma("unroll") for (int n = 0; n < 2; ++n) _Pragma("unroll") for (int k = 0; k < 2; ++k) \
        acc[ai][bj][m][n] = __builtin_amdgcn_mfma_f32_16x16x32_bf16(Bt[n][k], At[m][k], acc[ai][bj][m][n], 0, 0, 0); __builtin_amdgcn_s_setprio(0); } while (0)
#define PG8_WAIT_V(n) asm volatile("s_waitcnt vmcnt(" #n ")" ::: "memory")
#define PG8_WAIT_L(n) asm volatile("s_waitcnt lgkmcnt(" #n ")" ::: "memory")
#define PG8_BAR __builtin_amdgcn_s_barrier()
#define PG8_SCHED __builtin_amdgcn_sched_barrier(0)
    Unit cur, nxt; int ui = 0;
    if (!S.next(0, cur)) return;
    f32x4 acc[2][2][4][2];
#pragma unroll
    for (int a = 0; a < 2; ++a)
#pragma unroll
        for (int b = 0; b < 2; ++b)
#pragma unroll
            for (int m = 0; m < 4; ++m)
#pragma unroll
                for (int n = 0; n < 2; ++n) acc[a][b][m][n] = (f32x4){0.f, 0.f, 0.f, 0.f};
    bf16x8 At[4][2], B0[2][2], B1[2][2];
    const char* cA = S.a_base(cur); const char* cB = S.b_base(cur);
    PG8_STAGE(PG8_SB(0, 0), cB, voffB); PG8_STAGE(PG8_SB(0, 1), cB + hstepB, voffB); PG8_STAGE(PG8_SA(0, 0), cA, voffA); PG8_STAGE(PG8_SA(0, 1), cA + hstepA, voffA);
    if (wr == 1) PG8_BAR;
    PG8_WAIT_V(2); PG8_BAR;
    PG8_STAGE(PG8_SB(1, 0), cB + kstep, voffB); PG8_STAGE(PG8_SA(1, 0), cA + kstep, voffA); PG8_STAGE(PG8_SB(1, 1), cB + hstepB + kstep, voffB);
    PG8_WAIT_V(6); PG8_BAR;
    for (;;) {
        const bool has_next = S.next(ui + 1, nxt);
        const char* nA = has_next ? S.a_base(nxt) : cA; const char* nB = has_next ? S.b_base(nxt) : cB;
        for (int t = 0; t < nt; t += 2) {
            const bool last = (t == nt - 2);
            const char* a1 = cA + (size_t)(t + 1) * kstep;
            const char* a2 = last ? nA : cA + (size_t)(t + 2) * kstep; const char* b2 = last ? nB : cB + (size_t)(t + 2) * kstep;
            const char* a3 = a2 + kstep; const char* b3 = b2 + kstep;
            PG8_LDB(B0, 0, 0); PG8_LDB(B1, 0, 1); PG8_SCHED; PG8_LDA(At, 0, 0); PG8_STAGE(PG8_SA(1, 1), a1 + hstepA, voffA);
            PG8_WAIT_V(8); PG8_WAIT_L(0); PG8_BAR; PG8_MMA(0, 0, At, B0); PG8_MMA(0, 1, At, B1); PG8_BAR; PG8_SCHED;
            PG8_LDA(At, 0, 1); PG8_STAGE(PG8_SB(0, 0), b2, voffB); PG8_STAGE(PG8_SB(0, 1), b2 + hstepB, voffB); PG8_STAGE(PG8_SA(0, 0), a2, voffA);
            PG8_WAIT_V(8); PG8_WAIT_L(0); PG8_BAR; PG8_MMA(1, 0, At, B0); PG8_MMA(1, 1, At, B1); PG8_BAR; PG8_SCHED;
            PG8_LDB(B0, 1, 0); PG8_LDB(B1, 1, 1); PG8_SCHED; PG8_LDA(At, 1, 0); PG8_STAGE(PG8_SA(0, 1), a2 + hstepA, voffA);
            PG8_WAIT_V(8); PG8_WAIT_L(0); PG8_BAR; PG8_MMA(0, 0, At, B0); PG8_MMA(0, 1, At, B1); PG8_BAR; PG8_SCHED;
            PG8_LDA(At, 1, 1); PG8_STAGE(PG8_SB(1, 0), b3, voffB); PG8_STAGE(PG8_SB(1, 1), b3 + hstepB, voffB); PG8_STAGE(PG8_SA(1, 0), a3, voffA);
            PG8_WAIT_V(8); PG8_WAIT_L(0); PG8_BAR; PG8_MMA(1, 0, At, B0); PG8_MMA(1, 1, At, B1); PG8_BAR; PG8_SCHED;
        }
        if constexpr (ALIGN_EPI) { if (wr == 0) PG8_BAR; }
        E(acc, cur, wr, wc, fr, fq);
        if (!has_next) break;
#pragma unroll
        for (int a = 0; a < 2; ++a)
#pragma unroll
            for (int b = 0; b < 2; ++b)
#pragma unroll
                for (int m = 0; m < 4; ++m)
#pragma unroll
                    for (int n = 0; n < 2; ++n) acc[a][b][m][n] = (f32x4){0.f, 0.f, 0.f, 0.f};
        cur = nxt; cA = nA; cB = nB; ++ui;
        if constexpr (ALIGN_EPI) { if (wr == 1) PG8_BAR; }
    }
    PG8_WAIT_V(0);
    if constexpr (!ALIGN_EPI) { if (wr == 0) PG8_BAR; }
    PG8_BAR;
#undef PG8_SA
#undef PG8_SB
#undef PG8_STAGE
#undef PG8_LDA
#undef PG8_LDB
#undef PG8_MMA
#undef PG8_WAIT_V
#undef PG8_WAIT_L
#undef PG8_BAR
#undef PG8_SCHED
}
}

struct Frame {
    LAS unsigned char* lds;
    int tid, lane, wave, G, vcu, bx;
    unsigned char* ws; unsigned char* outb;
    const float* in[22];
};
struct Args { const float* in[22]; float* out; unsigned char* ws; };
DI int opaque_lane(const Frame& F) { int l = F.lane; asm volatile("" : "+v"(l)); return l; }

template <class RowMap>
DI void transpose_item(const float* W, int K, int N, bf16* WT, RowMap orow, LAS float* scr, int item, int lane) {
    const int nblk = N / 32, kb = item / nblk, nb = item % nblk, k0 = 64 * kb, n0 = 32 * nb;
#pragma unroll 8
    for (int i = 0; i < 32; ++i) { const int kk = 2 * i + (lane >> 5); scr[kk * 33 + (lane & 31)] = W[(size_t)(k0 + kk) * N + n0 + (lane & 31)]; }
    LDS_WAIT(); asm volatile("" ::: "memory");
    const int c = lane & 7;
#pragma unroll
    for (int j = 0; j < 4; ++j) { const int n = (lane >> 3) + 8 * j; const LAS float* s = scr + (8 * c) * 33 + n;
        u32x4 o; o.x = pk2(s[0 * 33], s[1 * 33]); o.y = pk2(s[2 * 33], s[3 * 33]); o.z = pk2(s[4 * 33], s[5 * 33]); o.w = pk2(s[6 * 33], s[7 * 33]);
        *(u32x4*)(WT + (size_t)orow(n0 + n) * K + k0 + 8 * c) = o; }
    LDS_WAIT(); asm volatile("" ::: "memory");
}
struct RowId { int off; DI int operator()(int n) const { return off + n; } };
struct RowW13 { int add; DI int operator()(int n) const { return ((n >> 2) << 3) + (n & 3) + add; } };

DI void phase0(Frame& F) {
    const int lane_ = F.lane;
    const float* c = F.in[1]; const float* w_ada = F.in[2]; const float* b_ada = F.in[3];
    float* MOD = (float*)(F.ws + WS_MOD);
    if (F.bx < 96) {
        const int j = F.bx * 64 + lane_;
        float a0 = 0.f, a1 = 0.f, a2 = 0.f, a3 = 0.f;
        const int k0 = F.wave * 128;
#pragma unroll 8
        for (int k = k0; k < k0 + 128; ++k) { const float w = w_ada[(size_t)k * 6144 + j]; a0 += c[k] * w; a1 += c[1024 + k] * w; a2 += c[2048 + k] * w; a3 += c[3072 + k] * w; }
        LAS float* red = (LAS float*)F.lds;
        red[(F.wave * 4 + 0) * 64 + lane_] = a0; red[(F.wave * 4 + 1) * 64 + lane_] = a1; red[(F.wave * 4 + 2) * 64 + lane_] = a2; red[(F.wave * 4 + 3) * 64 + lane_] = a3;
        __syncthreads();
        if (F.tid < 256) { const int b = F.tid >> 6, l = F.tid & 63; float s = b_ada[F.bx * 64 + l];
#pragma unroll
            for (int w = 0; w < 8; ++w) s += red[(w * 4 + b) * 64 + l];
            MOD[b * 6144 + F.bx * 64 + l] = s; }
        __syncthreads();
    }
    if (F.bx == 0 && F.tid < 8) ((float*)(F.ws + WS_DEC))[F.tid] = log2_sigmoid(F.tid < 4 ? F.in[6][F.tid] : F.in[7][F.tid - 4]);
    { const int gid = F.bx * NTHREADS + F.tid;
      if (gid < 36 * 1024) { const int o = gid >> 10, k = gid & 1023; float v;
          if (o < 4) v = F.in[13][k * 4 + o]; else { const int g = (o - 4) >> 3, e = (o - 4) & 7; v = F.in[15][((size_t)g * 1024 + k) * 8 + e]; }
          ((float*)(F.ws + WS_WROUT))[gid] = v; } }
    LAS float* scr = (LAS float*)(F.lds + 16384 + F.wave * 12288);
    const int gw = F.bx * NWAVES + F.wave, NGW = F.G * NWAVES;
    constexpr int I_IN = 16 * 400, I_A = 8 * 32, I_R = 32 * 32, I_O = 16 * 32;
    for (int it = gw; it < I_IN + I_A + I_R + I_O; it += NGW) {
        int r = it;
        if (r < I_IN) { transpose_item(F.in[4], 1024, C_END, (bf16*)(F.outb + OUT_WINT), RowId{0}, scr, r, lane_); continue; } r -= I_IN;
        if (r < I_A) { transpose_item(F.in[5], 512, 1024, (bf16*)(F.ws + WS_WAT), RowId{0}, scr, r, lane_); continue; } r -= I_A;
        if (r < I_R) { transpose_item(F.in[9], 2048, 1024, (bf16*)(F.ws + WS_WRT), RowId{0}, scr, r, lane_); continue; } r -= I_R;
        transpose_item(F.in[10], 1024, 1024, (bf16*)(F.ws + WS_WOT), RowId{0}, scr, r, lane_);
    }
}
DI void moe_weight_transposes(Frame& F) {
    const int lane_ = F.lane;
    LAS float* scr = (LAS float*)(F.lds + 16384 + F.wave * 12288);
    const int gw = F.bx * NWAVES + F.wave, NGW = F.G * NWAVES;
    bf16* W13T = (bf16*)(F.ws + WS_W13T); bf16* W2T = (bf16*)(F.ws + WS_W2T);
    for (int it = gw; it < 3 * 8192; it += NGW) {
        const int which = it >> 13, r = it & 8191, e = r >> 8, item = r & 255;
        if (which == 0) transpose_item(F.in[17] + (size_t)e * 1024 * 512, 1024, 512, W13T + (size_t)e * 1024 * 1024, RowW13{0}, scr, item, lane_);
        else if (which == 1) transpose_item(F.in[18] + (size_t)e * 1024 * 512, 1024, 512, W13T + (size_t)e * 1024 * 1024, RowW13{4}, scr, item, lane_);
        else transpose_item(F.in[19] + (size_t)e * 512 * 1024, 512, 1024, W2T + (size_t)e * 1024 * 512, RowId{0}, scr, item, lane_);
    }
}

DI void phase1(Frame& F) {
    const int lane_ = opaque_lane(F);
    const float* x = F.in[0]; const float* MOD = (const float*)(F.ws + WS_MOD); bf16* U = (bf16*)(F.outb + OUT_U);
    const int gw = F.bx * NWAVES + F.wave, NGW = F.G * NWAVES;
    for (int m = gw; m < NT; m += NGW) {
        const f32x4* xr = (const f32x4*)(x + (size_t)m * DM) + lane_; const int b = m >> 12;
        f32x4 v[4]; float s = 0.f;
#pragma unroll
        for (int j = 0; j < 4; ++j) { v[j] = xr[64 * j]; s += (v[j].x + v[j].y) + (v[j].z + v[j].w); }
        const float mean = wave_sum(s) * (1.f / DM); float s2 = 0.f;
#pragma unroll
        for (int j = 0; j < 4; ++j) { v[j] = v[j] - mean; s2 += (v[j].x * v[j].x + v[j].y * v[j].y) + (v[j].z * v[j].z + v[j].w * v[j].w); }
        const float rstd = 1.f / sqrtf(wave_sum(s2) * (1.f / DM) + LN_EPS);
        u32x2* o8 = (u32x2*)(U + (size_t)m * DM) + lane_;
#pragma unroll
        for (int j = 0; j < 4; ++j) { const int col = 256 * j + 4 * lane_;
            const f32x4 sh = *(const f32x4*)(MOD + b * 6144 + col), sc = *(const f32x4*)(MOD + b * 6144 + 1024 + col);
            const f32x4 u = v[j] * rstd * (sc + 1.f) + sh;
            u32x2 w; w.x = pk2(u.x, u.y); w.y = pk2(u.z, u.w); o8[64 * j] = w; }
    }
}

DI u32x4 pack8(f32x4 v0, f32x4 v1) { u32x4 w; w.x = pk2(v0[0], v0[1]); w.y = pk2(v0[2], v0[3]); w.z = pk2(v1[0], v1[1]); w.w = pk2(v1[2], v1[3]); return w; }

struct SchedR1 : pg8::StaticOrder { const char* U; const char* W;
    DI const char* a_base(const pg8::Unit& u) const { return U + (size_t)u.pm * 256 * 2048; }
    DI const char* b_base(const pg8::Unit& u) const { return W + (size_t)(C_RQ + 256 * u.pn) * 2048; } };
struct EpiR1 { bf16 *RQ, *RK;
    DI void operator()(int row, int col, f32x4 v0, f32x4 v1) const {
        if (col < 1024) *(u32x4*)(RQ + blk_off(row, col, 64)) = pack8(v0, v1);
        else *(u32x4*)(RK + blk_off(row, col - 1024, 64)) = pack8(v0 * 0.0625f, v1 * 0.0625f); } };
struct SchedR2 : pg8::StaticOrder { const char* U; const char* W;
    DI const char* a_base(const pg8::Unit& u) const { const int r = u.pm < 8 ? C_RV + 256 * u.pm : C_RK + 256 * (u.pm - 8); return W + (size_t)r * 2048; }
    DI const char* b_base(const pg8::Unit& u) const { return U + (size_t)u.pn * 256 * 2048; } };
struct EpiR2 { bf16 *RVT, *KFT, *KBT; const float* DEC;
    DI void operator()(int row, int col, f32x4 v0, f32x4 v1) const {
        if (row < 2048) { *(u32x4*)(RVT + blk_off(row, col, 1024)) = pack8(v0, v1); return; }
        const int f = row - 2048, h = f >> 8; const float p0 = (float)(col & 127);
        const float a = DEC[h], b = DEC[4 + h];
        f32x4 kf0, kf1, kb0, kb1;
#pragma unroll
        for (int e = 0; e < 4; ++e) {
            const float pa = p0 + (float)e, pb = p0 + (float)(e + 4);
            kf0[e] = v0[e] * 0.0625f * __builtin_amdgcn_exp2f(a * (127.f - pa)); kf1[e] = v1[e] * 0.0625f * __builtin_amdgcn_exp2f(a * (127.f - pb));
            kb0[e] = v0[e] * 0.0625f * __builtin_amdgcn_exp2f(b * pa);           kb1[e] = v1[e] * 0.0625f * __builtin_amdgcn_exp2f(b * pb); }
        *(u32x4*)(KFT + blk_off(f, col, 1024)) = pack8(kf0, kf1);
        *(u32x4*)(KBT + blk_off(f, col, 1024)) = pack8(kb0, kb1); } };
struct SchedQK : pg8::StaticOrder { const char* U; const char* W; int g, r, nsub;
    DI const char* a_base(const pg8::Unit& u) const { const int b = u.pm >> 4, v0 = (u.pm & 15) * 256, rho = v0 / nsub, i0 = v0 % nsub; return U + (size_t)(b * SEQ + rho + r * i0) * 2048; }
    DI const char* b_base(const pg8::Unit& u) const { const int rw = (u.pn < 2 ? C_AQ : C_AK) + 512 * g + 256 * (u.pn & 1); return W + (size_t)rw * 2048; } };
struct EpiQK { bf16 *AQ, *AK;
    DI void operator()(int row, int col, f32x4 v0, f32x4 v1) const {
        if (col < 512) *(u32x4*)(AQ + blk_off(row, col, 32)) = pack8(v0, v1);
        else *(u32x4*)(AK + blk_off(row, col - 512, 32)) = pack8(v0, v1); } };
struct SchedGate : pg8::StaticOrder { const char* U; const char* W;
    DI const char* a_base(const pg8::Unit& u) const { return U + (size_t)u.pm * 256 * 2048; }
    DI const char* b_base(const pg8::Unit& u) const { return W + (size_t)(C_RGT + 256 * u.pn) * 2048; } };
struct EpiGate { bf16 *RETG, *GA, *GR;
    DI void operator()(int row, int col, f32x4 v0, f32x4 v1) const {
        if (col < 2048) { bf16* p = RETG + (size_t)row * 2048 + col; const u32x4 n = *(const u32x4*)p;
            f32x4 o0 = {v0[0] * sigmoidf_(v0[0]) * bflo(n.x), v0[1] * sigmoidf_(v0[1]) * bfhi(n.x), v0[2] * sigmoidf_(v0[2]) * bflo(n.y), v0[3] * sigmoidf_(v0[3]) * bfhi(n.y)};
            f32x4 o1 = {v1[0] * sigmoidf_(v1[0]) * bflo(n.z), v1[1] * sigmoidf_(v1[1]) * bfhi(n.z), v1[2] * sigmoidf_(v1[2]) * bflo(n.w), v1[3] * sigmoidf_(v1[3]) * bfhi(n.w)};
            *(u32x4*)p = pack8(o0, o1); return; }
        f32x4 s0, s1;
#pragma unroll
        for (int e = 0; e < 4; ++e) { s0[e] = sigmoidf_(v0[e]); s1[e] = sigmoidf_(v1[e]); }
        bf16* dst = col < 3072 ? GA + (size_t)row * 1024 + col - 2048 : GR + (size_t)row * 1024 + col - 3072;
        *(u32x4*)dst = pack8(s0, s1); } };
struct SchedA2 : pg8::StaticOrder { const char* U; const char* W; int g, r, nsub;
    DI const char* a_base(const pg8::Unit& u) const { return W + (size_t)(C_AV + 512 * g + 256 * u.pm) * 2048; }
    DI const char* b_base(const pg8::Unit& u) const { const int b = u.pn >> 4, v0 = (u.pn & 15) * 256, rho = v0 / nsub, i0 = v0 % nsub; return U + (size_t)(b * SEQ + rho + r * i0) * 2048; } };
struct EpiA2 { bf16* AVT;
    DI void operator()(int row, int col, f32x4 v0, f32x4 v1) const { *(u32x4*)(AVT + blk_off(row, col, 1024)) = pack8(v0, v1); } };
struct SchedG : pg8::StaticOrder { const char* A; const char* B; size_t abytes, bbytes;
    DI const char* a_base(const pg8::Unit& u) const { return A + (size_t)u.pm * abytes; }
    DI const char* b_base(const pg8::Unit& u) const { return B + (size_t)u.pn * bbytes; } };
struct EpiG1 { const bf16* GA; bf16* P1;
    DI void operator()(int row, int col, f32x4 v0, f32x4 v1) const {
        const u32x4 g = *(const u32x4*)(GA + (size_t)row * 1024 + col);
        f32x4 o0 = {v0[0] * bflo(g.x), v0[1] * bfhi(g.x), v0[2] * bflo(g.y), v0[3] * bfhi(g.y)}, o1 = {v1[0] * bflo(g.z), v1[1] * bfhi(g.z), v1[2] * bflo(g.w), v1[3] * bfhi(g.w)};
        *(u32x4*)(P1 + (size_t)row * 1024 + col) = pack8(o0, o1); } };
struct EpiG2 { const bf16* GR; const bf16* P1; bf16* MERGED;
    DI void operator()(int row, int col, f32x4 v0, f32x4 v1) const {
        const u32x4 g = *(const u32x4*)(GR + (size_t)row * 1024 + col);
        const u32x4 p = *(const u32x4*)(P1 + (size_t)row * 1024 + col);
        f32x4 o0 = {bflo(p.x) + v0[0] * bflo(g.x), bfhi(p.x) + v0[1] * bfhi(g.x), bflo(p.y) + v0[2] * bflo(g.y), bfhi(p.y) + v0[3] * bfhi(g.y)};
        f32x4 o1 = {bflo(p.z) + v1[0] * bflo(g.z), bfhi(p.z) + v1[1] * bfhi(g.z), bflo(p.w) + v1[2] * bflo(g.w), bfhi(p.w) + v1[3] * bfhi(g.w)};
        *(u32x4*)(MERGED + (size_t)row * 1024 + col) = pack8(o0, o1); } };
struct EpiG3 { const float* x; const float* MOD; float* H;
    DI void operator()(int row, int col, f32x4 v0, f32x4 v1) const {
        const int b = row >> 12; const float* gp = MOD + b * 6144 + 2048 + col; const float* xp = x + (size_t)row * 1024 + col;
        const f32x4 g0 = *(const f32x4*)gp, g1 = *(const f32x4*)(gp + 4), x0 = *(const f32x4*)xp, x1 = *(const f32x4*)(xp + 4);
        *(f32x4*)(H + (size_t)row * 1024 + col) = x0 * ALPHA + g0 * v0; *(f32x4*)(H + (size_t)row * 1024 + col + 4) = x1 * ALPHA + g1 * v1; } };
struct SchedM : pg8::StaticOrder { const char* A; const char* B; size_t abytes, ebytes, bbytes; const LAS int* texp;
    DI const char* a_base(const pg8::Unit& u) const { return A + (size_t)u.pm * abytes; }
    DI const char* b_base(const pg8::Unit& u) const { return B + (size_t)texp[u.pm] * ebytes + (size_t)u.pn * bbytes; } };
struct EpiM3 { bf16* HDN;
    DI void operator()(int row, int col, f32x4 a, f32x4 b) const {
        f32x4 o;
#pragma unroll
        for (int e = 0; e < 4; ++e) o[e] = a[e] * sigmoidf_(a[e]) * b[e];
        u32x2 w; w.x = pk2(o[0], o[1]); w.y = pk2(o[2], o[3]);
        *(u32x2*)(HDN + (size_t)row * 512 + (col >> 1)) = w; } };
struct EpiM4 { bf16* Y;
    DI void operator()(int row, int col, f32x4 v0, f32x4 v1) const { *(u32x4*)(Y + (size_t)row * 1024 + col) = pack8(v0, v1); } };

#define SBAR_ __builtin_amdgcn_sched_barrier(0)
typedef __amdgpu_buffer_rsrc_t rsrc_t;
DI bf16x8 bld16(rsrc_t rs, unsigned voff, unsigned soff) { return __builtin_bit_cast(bf16x8, __builtin_amdgcn_raw_buffer_load_b128(rs, voff, soff, 0)); }
DI void bst16(u32x4 v, rsrc_t rs, unsigned voff, unsigned soff) { __builtin_amdgcn_raw_buffer_store_b128(v, rs, voff, soff, 0); }
constexpr int ST_BYTES = 32 * 1024, VT_BYTES = 16 * 1024, VT_BASE = 2 * ST_BYTES;
DI void ret_scan(Frame& F) {
    const int lane_ = F.lane;
    const int r = lane_ & 31, h = lane_ >> 5;
    const int role = F.wave >> 2, wq = F.wave & 3;
    const rsrc_t rs = __builtin_amdgcn_make_buffer_rsrc((void*)F.ws, 0, (unsigned)WS_END, 0x00020000);
    const unsigned loff = (unsigned)lane_ * 16u, yoff = (unsigned)lane_ * 32u;
    LAS char* L = (LAS char*)F.lds;
    for (int unit = __builtin_amdgcn_readfirstlane(F.vcu); unit < 256; unit += F.G) {
        const int sl = unit & 7, dir = (unit >> 3) & 1, hd = (unit >> 4) & 3, b = unit >> 6;
        const float lg = ((const float*)(F.ws + WS_DEC))[4 * dir + hd];
        const int c0 = dir ? 31 : 0, cstep = dir ? -1 : 1;
        if (role == 0) {
            const float p = (float)(32 * wq + r);
            const float qd = dir ? __builtin_amdgcn_exp2f(lg * (128.f - p)) : __builtin_amdgcn_exp2f(lg * (p + 1.f));
            const unsigned qb = (unsigned)WS_RQ + (unsigned)((((b * 128 + wq) * 64) + hd * 16) * 1024);
            const unsigned yb = (unsigned)(dir ? WS_YB : WS_YF) + (unsigned)((((b * 4 + hd) * 32 * 4 + wq) * 16 + 2 * sl) * 2048);
            bf16x8 Qf[16];
#pragma unroll
            for (int ks = 0; ks < 16; ++ks) Qf[ks] = bld16(rs, loff, qb + (unsigned)(c0 + cstep) * 4 * 65536 + 1024 * ks);
            { const u32x4 z = {0u, 0u, 0u, 0u}; const unsigned yp = yb + (unsigned)c0 * 4 * 16 * 2048;
              bst16(z, rs, yoff, yp); bst16(z, rs, yoff + 16, yp); bst16(z, rs, yoff, yp + 2048); bst16(z, rs, yoff + 16, yp + 2048); }
            asm volatile("s_waitcnt lgkmcnt(0)" ::: "memory"); __builtin_amdgcn_s_barrier(); asm volatile("" ::: "memory");
#pragma unroll
            for (int step = 0; step < 32; ++step) {
                const int ch = c0 + cstep * step;
                int chn = ch + cstep; chn = chn < 0 ? 0 : (chn > 31 ? 31 : chn);
                if (step > 0) {
                    const LAS char* sp = L + (step & 1) * ST_BYTES + loff;
                    const unsigned qn = qb + (unsigned)chn * 4 * 65536;
                    f32x16 a0 = zero16(), a1 = zero16();
#pragma unroll
                    for (int kg = 0; kg < 8; ++kg) {
                        bf16x8 s0[2], s1[2];
#pragma unroll
                        for (int k = 0; k < 2; ++k) { s0[k] = *(const LAS bf16x8*)(sp + 1024 * (2 * kg + k)); s1[k] = *(const LAS bf16x8*)(sp + 16384 + 1024 * (2 * kg + k)); }
#pragma unroll
                        for (int k = 0; k < 2; ++k) { a0 = MFMA32(s0[k], Qf[2 * kg + k], a0); a1 = MFMA32(s1[k], Qf[2 * kg + k], a1); }
                        SBAR_;
#pragma unroll
                        for (int k = 0; k < 2; ++k) Qf[2 * kg + k] = bld16(rs, loff, qn + 1024 * (2 * kg + k));
                        SBAR_;
                    }
                    const unsigned yp = yb + (unsigned)ch * 4 * 16 * 2048;
                    u32x4 w0, w1, w2, w3;
#pragma unroll
                    for (int k = 0; k < 4; ++k) { w0[k] = pk2(a0[2 * k] * qd, a0[2 * k + 1] * qd); w1[k] = pk2(a0[8 + 2 * k] * qd, a0[8 + 2 * k + 1] * qd);
                                                  w2[k] = pk2(a1[2 * k] * qd, a1[2 * k + 1] * qd); w3[k] = pk2(a1[8 + 2 * k] * qd, a1[8 + 2 * k + 1] * qd); }
                    bst16(w0, rs, yoff, yp); bst16(w1, rs, yoff + 16, yp); bst16(w2, rs, yoff, yp + 2048); bst16(w3, rs, yoff + 16, yp + 2048);
                }
                asm volatile("s_waitcnt lgkmcnt(0)" ::: "memory"); __builtin_amdgcn_s_barrier(); asm volatile("" ::: "memory");
            }
        } else {
            const float cd = __builtin_amdgcn_exp2f(lg * 128.f);
            const unsigned kb = (unsigned)(dir ? WS_KBT : WS_KFT) + (unsigned)(((hd * 8 + 2 * wq) * 1024 + b * 256) * 1024);
            const unsigned vb = (unsigned)WS_RVT + (unsigned)(((hd * 16 + 2 * sl) * 1024 + b * 256) * 1024);
            const unsigned vo = (unsigned)(wq * 64 + lane_) * 64u;
            const unsigned vsrc = (vo >> 13) * (1024u * 1024u) + (vo & 8191u);
            bf16x8 Kf0[8], Kf1[8];
#pragma unroll
            for (int ks = 0; ks < 8; ++ks) { Kf0[ks] = bld16(rs, loff, kb + (unsigned)c0 * 8192 + 1024 * ks); Kf1[ks] = bld16(rs, loff, kb + 1024 * 1024 + (unsigned)c0 * 8192 + 1024 * ks); }
            { bf16x8 v[4];
#pragma unroll
              for (int k = 0; k < 4; ++k) v[k] = bld16(rs, vsrc + 16 * k, vb + (unsigned)c0 * 8192);
#pragma unroll
              for (int k = 0; k < 4; ++k) *(LAS bf16x8*)(L + VT_BASE + vo + 16 * k) = v[k]; }
            asm volatile("s_waitcnt lgkmcnt(0)" ::: "memory"); __builtin_amdgcn_s_barrier(); asm volatile("" ::: "memory");
            f32x16 S00 = zero16(), S01 = zero16(), S10 = zero16(), S11 = zero16();
#pragma unroll
            for (int step = 0; step < 32; ++step) {
                const int ch = c0 + cstep * step;
                int chn = ch + cstep; chn = chn < 0 ? 0 : (chn > 31 ? 31 : chn);
                if (step < 31) {
                    const int cur = step & 1;
                    bf16x8 vn[4];
#pragma unroll
                    for (int k = 0; k < 4; ++k) vn[k] = bld16(rs, vsrc + 16 * k, vb + (unsigned)chn * 8192);
#pragma unroll
                    for (int i = 0; i < 16; ++i) { S00[i] *= cd; S01[i] *= cd; S10[i] *= cd; S11[i] *= cd; }
                    const LAS char* vp = L + VT_BASE + cur * VT_BYTES + loff;
                    const unsigned kn = kb + (unsigned)chn * 8192;
#pragma unroll
                    for (int kg = 0; kg < 4; ++kg) {
                        bf16x8 b0[2], b1[2];
#pragma unroll
                        for (int k = 0; k < 2; ++k) { b0[k] = *(const LAS bf16x8*)(vp + 1024 * (2 * kg + k)); b1[k] = *(const LAS bf16x8*)(vp + 8192 + 1024 * (2 * kg + k)); }
#pragma unroll
                        for (int k = 0; k < 2; ++k) { S00 = MFMA32(Kf0[2 * kg + k], b0[k], S00); S01 = MFMA32(Kf0[2 * kg + k], b1[k], S01); S10 = MFMA32(Kf1[2 * kg + k], b0[k], S10); S11 = MFMA32(Kf1[2 * kg + k], b1[k], S11); }
                        SBAR_;
#pragma unroll
                        for (int k = 0; k < 2; ++k) { Kf0[2 * kg + k] = bld16(rs, loff, kn + 1024 * (2 * kg + k)); Kf1[2 * kg + k] = bld16(rs, loff, kn + 1024 * 1024 + 1024 * (2 * kg + k)); }
                        SBAR_;
                    }
                    LAS char* wp = L + (cur ^ 1) * ST_BYTES + (4 * wq) * 1024 + (r * 8 + 4 * h) * 2;
#pragma unroll
                    for (int g = 0; g < 4; ++g) {
                        const int o = ((g >> 1) * 512 + (g & 1) * 256) * 2;
                        u32x2 w; w.x = pk2(S00[4 * g], S00[4 * g + 1]); w.y = pk2(S00[4 * g + 2], S00[4 * g + 3]); *(LAS u32x2*)(wp + o) = w;
                        w.x = pk2(S10[4 * g], S10[4 * g + 1]); w.y = pk2(S10[4 * g + 2], S10[4 * g + 3]); *(LAS u32x2*)(wp + 2048 + o) = w;
                        w.x = pk2(S01[4 * g], S01[4 * g + 1]); w.y = pk2(S01[4 * g + 2], S01[4 * g + 3]); *(LAS u32x2*)(wp + 16384 + o) = w;
                        w.x = pk2(S11[4 * g], S11[4 * g + 1]); w.y = pk2(S11[4 * g + 2], S11[4 * g + 3]); *(LAS u32x2*)(wp + 16384 + 2048 + o) = w; }
#pragma unroll
                    for (int k = 0; k < 4; ++k) *(LAS bf16x8*)(L + VT_BASE + (cur ^ 1) * VT_BYTES + vo + 16 * k) = vn[k];
                }
                asm volatile("s_waitcnt lgkmcnt(0)" ::: "memory"); __builtin_amdgcn_s_barrier(); asm volatile("" ::: "memory");
            }
        }
        VM_WAIT();
    }
}
DI void ret_norm(Frame& F) {
    const int lane_ = F.lane;
    char* YF = (char*)(F.ws + WS_YF); const char* YB = (const char*)(F.ws + WS_YB); bf16* RETN = (bf16*)(F.ws + WS_RETG); const float* gain = F.in[8];
    const bf16* RQ = (const bf16*)(F.ws + WS_RQ); const bf16* RK = (const bf16*)(F.ws + WS_RK); const bf16* RVT = (const bf16*)(F.ws + WS_RVT);
    const float* DEC = (const float*)(F.ws + WS_DEC);
    const int r = lane_ & 31, h = lane_ >> 5;
    LAS char* T = (LAS char*)F.lds + F.wave * (32 * 272);
    const int gw = F.vcu * NWAVES + F.wave, NGW = F.G * NWAVES;
    for (int it = gw; it < 2048; it += NGW) {
        const int ntl = it & 3, ch = (it >> 2) & 31, hd = (it >> 7) & 3, b = it >> 9;
        char* yp = YF + ((size_t)it * 16) * 2048 + lane_ * 32;
        const char* yq = YB + ((size_t)it * 16) * 2048 + lane_ * 32;
        const int tokc = b * SEQ + ch * 128, rb0 = tokc >> 5;
        const size_t tok0 = (size_t)tokc + 32 * ntl;
        const float lf = DEC[hd], lb = DEC[4 + hd];
        bf16x8 pb[4][2];
        { f32x16 pT[4]; for (int i = 0; i < 4; ++i) pT[i] = zero16();
          const bf16* qp = RQ + ((size_t)(rb0 + ntl) * 64 + hd * 16) * 512 + lane_ * 8;
          const bf16* kp = RK + ((size_t)rb0 * 64 + hd * 16) * 512 + lane_ * 8;
#pragma unroll 4
          for (int ks = 0; ks < 16; ++ks) {
              const bf16x8 bq = ld16(qp + ks * 512);
#pragma unroll
              for (int mt = 0; mt < 4; ++mt) { const bf16x8 ak = ld16(kp + (size_t)mt * 64 * 512 + ks * 512); pT[mt] = MFMA32(ak, bq, pT[mt]); }
          }
          const int n = 32 * ntl + r;
#pragma unroll
          for (int mt = 0; mt < 4; ++mt) {
#pragma unroll
              for (int i = 0; i < 16; ++i) { const int m = 32 * mt + crow(i, h); const int d = n - m;
                  const float w = d >= 0 ? __builtin_amdgcn_exp2f(lf * (float)d) : __builtin_amdgcn_exp2f(lb * (float)(-d));
                  pT[mt][i] *= w; }
              pb[mt][0] = pack_step(pT[mt], 0); pb[mt][1] = pack_step(pT[mt], 1);
          } }
        float s = 0.f, s2 = 0.f;
#pragma unroll 4
        for (int dvt = 0; dvt < 16; ++dvt) {
            const bf16* vp = RVT + ((size_t)(hd * 16 + dvt) * 1024 + (tokc >> 4)) * 512 + r * 8 + 4 * h;
            const u32x4 a = *(const u32x4*)(yp + dvt * 2048), c = *(const u32x4*)(yp + dvt * 2048 + 16), a2 = *(const u32x4*)(yq + dvt * 2048), c2 = *(const u32x4*)(yq + dvt * 2048 + 16);
            f32x16 acc = zero16();
#pragma unroll
            for (int mt = 0; mt < 4; ++mt)
#pragma unroll
                for (int s2i = 0; s2i < 2; ++s2i) { const bf16* bp = vp + (2 * mt + s2i) * 512; acc = MFMA32(ld8x2(bp, bp + 256), pb[mt][s2i], acc); }
            u32x4 wa, wc;
#pragma unroll
            for (int k = 0; k < 4; ++k) { wa[k] = pk2(bflo(a[k]) + bflo(a2[k]) + acc[2 * k], bfhi(a[k]) + bfhi(a2[k]) + acc[2 * k + 1]); wc[k] = pk2(bflo(c[k]) + bflo(c2[k]) + acc[8 + 2 * k], bfhi(c[k]) + bfhi(c2[k]) + acc[8 + 2 * k + 1]); }
#pragma unroll
            for (int k = 0; k < 4; ++k) { const float x0 = bflo(wa[k]), x1 = bfhi(wa[k]), x2 = bflo(wc[k]), x3 = bfhi(wc[k]); s += (x0 + x1) + (x2 + x3); s2 += (x0 * x0 + x1 * x1) + (x2 * x2 + x3 * x3); }
            *(u32x4*)(yp + dvt * 2048) = wa; *(u32x4*)(yp + dvt * 2048 + 16) = wc;
        }
        s += __shfl_xor(s, 32); s2 += __shfl_xor(s2, 32);
        const float mean = s * (1.f / 512.f);
        const float var = fmaxf(s2 * (1.f / 512.f) - mean * mean, 0.f);
        const float rstd = 1.f / sqrtf(var + LN_EPS);
        VM_WAIT();
#pragma unroll 1
        for (int grp = 0; grp < 4; ++grp) {
#pragma unroll
            for (int t = 0; t < 4; ++t) {
                const u32x4 a = *(const u32x4*)(yp + (4 * grp + t) * 2048), c = *(const u32x4*)(yp + (4 * grp + t) * 2048 + 16);
                const u32x2 av[4] = {{a.x, a.y}, {a.z, a.w}, {c.x, c.y}, {c.z, c.w}};
#pragma unroll
                for (int q = 0; q < 4; ++q) { u32x2 w; w.x = pk2((bflo(av[q].x) - mean) * rstd, (bfhi(av[q].x) - mean) * rstd); w.y = pk2((bflo(av[q].y) - mean) * rstd, (bfhi(av[q].y) - mean) * rstd);
                    *(LAS u32x2*)(T + r * 272 + (32 * t + 8 * q + 4 * h) * 2) = w; }
            }
            LDS_WAIT(); asm volatile("" ::: "memory");
#pragma unroll
            for (int k = 0; k < 8; ++k) {
                const int task = lane_ + 64 * k, tk = task >> 4, cchunk = task & 15;
                const u32x4 v = *(const LAS u32x4*)(T + tk * 272 + cchunk * 16);
                const int col = hd * 512 + 128 * grp + 8 * cchunk;
                const f32x4 ga = *(const f32x4*)(gain + col), gb = *(const f32x4*)(gain + col + 4);
                u32x4 w; w.x = pk2(bflo(v.x) * ga[0], bfhi(v.x) * ga[1]); w.y = pk2(bflo(v.y) * ga[2], bfhi(v.y) * ga[3]); w.z = pk2(bflo(v.z) * gb[0], bfhi(v.z) * gb[1]); w.w = pk2(bflo(v.w) * gb[2], bfhi(v.w) * gb[3]);
                *(u32x4*)(RETN + (tok0 + tk) * 2048 + col) = w;
            }
            LDS_WAIT(); asm volatile("" ::: "memory");
        }
    }
}

DI void glds1k(const bf16* gblock, LAS char* ldst, int lane) {
    __builtin_amdgcn_global_load_lds((const unsigned*)((const char*)gblock + lane * 16), (LAS unsigned*)ldst, 16, 0, 0);
}
DI void attn_phase(Frame& F) {
    const int lane_ = F.lane;
    float* LSE = (float*)(F.ws + WS_LSE);
    const int r = lane_ & 31, h = lane_ >> 5, w = F.wave;
    LAS char* LA = (LAS char*)F.lds; LAS char* LB = LA + 96 * 1024;
    for (int it = F.vcu; it < 768; it += F.G) {
        const int g = it >> 8, rem = it & 255;
        const int dil = g == 0 ? 1 : (g == 1 ? 4 : 16), nsub = SEQ / dil, nqb = nsub >> 8, ntile = nsub >> 5;
        const int qb = rem % nqb; const int rem2 = rem / nqb; const int rho = rem2 % dil; const int bh = rem2 / dil; const int hg = bh & 3, b = bh >> 2;
        const int head = 4 * g + hg;
        const float slope = __builtin_amdgcn_exp2f(-8.f * (float)(head + 1) * (1.f / 12.f)) * (float)dil;
        const bf16* AQ = (const bf16*)(F.ws + WS_AQ + (size_t)g * 16 * MiB); const bf16* AK = (const bf16*)(F.ws + WS_AK + (size_t)g * 16 * MiB);
        const bf16* AVT = (const bf16*)(F.ws + WS_AVT) + (size_t)g * 512 * NT;
        bf16* OG = (bf16*)(F.ws + (g == 0 ? WS_O0 : (g == 1 ? WS_O1 : WS_O2)));
        const int v0 = b * SEQ + rho * nsub;
        const int t0 = 8 * qb - 2;
        const size_t tokbase = (size_t)b * SEQ + rho;
        __syncthreads();
#pragma unroll
        for (int i = 0; i < 12; ++i) { const int t = w * 12 + i, j = t >> 3, ks = t & 7; int ta = t0 + j; ta = ta < 0 ? 0 : (ta >= ntile ? ntile - 1 : ta);
            glds1k(AK + ((size_t)((v0 >> 5) + ta) * 32 + hg * 8 + ks) * 512, LA + t * 1024, lane_); }
#pragma unroll
        for (int i = 0; i < 6; ++i) { const int t = w * 6 + i, dt = t / 24, kb = t % 24; int ta = t0 + (kb >> 1); ta = ta < 0 ? 0 : (ta >= ntile ? ntile - 1 : ta);
            glds1k(AVT + ((size_t)(hg * 4 + dt) * 1024 + (v0 >> 4) + 2 * ta + (kb & 1)) * 512, LB + t * 1024, lane_); }
        const int i0 = 256 * qb + 32 * w;
        bf16x8 bq[8];
        { const bf16* qp = AQ + ((size_t)((v0 + i0) >> 5) * 32 + hg * 8) * 512 + lane_ * 8;
#pragma unroll
          for (int ks = 0; ks < 8; ++ks) bq[ks] = ld16(qp + ks * 512); }
        __syncthreads();
        f32x16 sT[5];
#pragma unroll
        for (int kt = 0; kt < 5; ++kt) {
            const LAS char* kp = LA + (w + kt) * 8192 + lane_ * 16;
            f32x16 acc = zero16();
#pragma unroll
            for (int ks = 0; ks < 8; ++ks) acc = MFMA32(*(const LAS bf16x8*)(kp + ks * 1024), bq[ks], acc);
            sT[kt] = acc;
        }
        __syncthreads();
#pragma unroll
        for (int i = 0; i < 6; ++i) { const int t = w * 6 + i, dt = t / 24, kb = t % 24; int ta = t0 + (kb >> 1); ta = ta < 0 ? 0 : (ta >= ntile ? ntile - 1 : ta);
            glds1k(AVT + ((size_t)(hg * 4 + 2 + dt) * 1024 + (v0 >> 4) + 2 * ta + (kb & 1)) * 512, LA + t * 1024, lane_); }
        const int iq = i0 + r;
        float mx = -3.0e38f;
#pragma unroll
        for (int kt = 0; kt < 5; ++kt)
#pragma unroll
            for (int i = 0; i < 16; ++i) { const int ik = i0 - 64 + 32 * kt + crow(i, h); const int d = ik - iq; const int ad = d < 0 ? -d : d;
                const bool valid = (ad <= 64) && (ik >= 0) && (ik < nsub);
                const float sc = valid ? sT[kt][i] * 0.08838834764831845f - slope * (float)ad : -1e30f;
                sT[kt][i] = sc; mx = fmaxf(mx, sc); }
        mx = fmaxf(mx, __shfl_xor(mx, 32));
        float sum = 0.f;
#pragma unroll
        for (int kt = 0; kt < 5; ++kt)
#pragma unroll
            for (int i = 0; i < 16; ++i) { const float p = __expf(sT[kt][i] - mx); sT[kt][i] = p; sum += p; }
        sum += __shfl_xor(sum, 32);
        const float inv = 1.f / sum;
        if (h == 0) LSE[((size_t)g * NT + tokbase + (size_t)dil * iq) * 4 + hg] = mx + __logf(sum);
        bf16x8 pb[5][2];
#pragma unroll
        for (int kt = 0; kt < 5; ++kt) { pb[kt][0] = pack_step(sT[kt], 0); pb[kt][1] = pack_step(sT[kt], 1); }
        bf16* op = OG + (tokbase + (size_t)dil * iq) * 512 + hg * 128 + 4 * h;
#pragma unroll
        for (int half = 0; half < 2; ++half) {
            if (half == 1) __syncthreads();
            const LAS char* vbase = (half ? LA : LB) + (r * 8 + 4 * h) * 2;
#pragma unroll
            for (int dtl = 0; dtl < 2; ++dtl) {
                f32x16 acc = zero16();
#pragma unroll
                for (int kt = 0; kt < 5; ++kt)
#pragma unroll
                    for (int s2 = 0; s2 < 2; ++s2) { const LAS char* bp = vbase + (dtl * 24 + 2 * (w + kt) + s2) * 1024;
                        const s16x4 lo = *(const LAS s16x4*)bp, hi = *(const LAS s16x4*)(bp + 512);
                        acc = MFMA32(__builtin_shufflevector(lo, hi, 0, 1, 2, 3, 4, 5, 6, 7), pb[kt][s2], acc); }
                const int dt = 2 * half + dtl;
#pragma unroll
                for (int q = 0; q < 4; ++q) { u32x2 wv; wv.x = pk2(acc[4 * q] * inv, acc[4 * q + 1] * inv); wv.y = pk2(acc[4 * q + 2] * inv, acc[4 * q + 3] * inv); *(u32x2*)(op + 32 * dt + 8 * q) = wv; }
            }
        }
    }
    __syncthreads();
}
DI void attn_mix(Frame& F) {
    const int lane_ = opaque_lane(F);
    const bf16* O0 = (const bf16*)(F.ws + WS_O0); const bf16* O1 = (const bf16*)(F.ws + WS_O1); const bf16* O2 = (const bf16*)(F.ws + WS_O2);
    const float* LSE = (const float*)(F.ws + WS_LSE); bf16* MIX = (bf16*)(F.ws + WS_ATTMIX);
    const int gw = F.bx * NWAVES + F.wave, NGW = F.G * NWAVES;
    for (int m = gw; m < NT; m += NGW) {
        const int hg = lane_ >> 4;
        const float l0 = LSE[((size_t)0 * NT + m) * 4 + hg], l1 = LSE[((size_t)1 * NT + m) * 4 + hg], l2 = LSE[((size_t)2 * NT + m) * 4 + hg];
        const float mx = fmaxf(l0, fmaxf(l1, l2)); const float e0 = __expf(l0 - mx), e1 = __expf(l1 - mx), e2 = __expf(l2 - mx); const float inv = 1.f / (e0 + e1 + e2);
        const float w0 = e0 * inv, w1 = e1 * inv, w2 = e2 * inv;
        const size_t off = (size_t)m * 512 + 8 * lane_;
        const u32x4 a = *(const u32x4*)(O0 + off), b = *(const u32x4*)(O1 + off), c = *(const u32x4*)(O2 + off);
        u32x4 o;
        o.x = pk2(w0 * bflo(a.x) + w1 * bflo(b.x) + w2 * bflo(c.x), w0 * bfhi(a.x) + w1 * bfhi(b.x) + w2 * bfhi(c.x));
        o.y = pk2(w0 * bflo(a.y) + w1 * bflo(b.y) + w2 * bflo(c.y), w0 * bfhi(a.y) + w1 * bfhi(b.y) + w2 * bfhi(c.y));
        o.z = pk2(w0 * bflo(a.z) + w1 * bflo(b.z) + w2 * bflo(c.z), w0 * bfhi(a.z) + w1 * bfhi(b.z) + w2 * bfhi(c.z));
        o.w = pk2(w0 * bflo(a.w) + w1 * bflo(b.w) + w2 * bflo(c.w), w0 * bfhi(a.w) + w1 * bfhi(b.w) + w2 * bfhi(c.w));
        *(u32x4*)(MIX + off) = o;
    }
}

DI float reduce4(const float (&p)[4], int lane) {
    const bool hi = (lane & 32) != 0;
    float a0 = hi ? p[2] : p[0], a1 = hi ? p[3] : p[1]; const float b0 = hi ? p[0] : p[2], b1 = hi ? p[1] : p[3];
    a0 += __shfl_xor(b0, 32); a1 += __shfl_xor(b1, 32);
    const bool hi2 = (lane & 16) != 0;
    float c = hi2 ? a1 : a0; const float d = hi2 ? a0 : a1;
    c += __shfl_xor(d, 16);
    c += __shfl_xor(c, 8); c += __shfl_xor(c, 4); c += __shfl_xor(c, 2); c += __shfl_xor(c, 1);
    return c;
}
DI void bcast4(float c, float (&o)[4]) {
#pragma unroll
    for (int t = 0; t < 4; ++t) o[t] = __builtin_bit_cast(float, __builtin_amdgcn_readlane(__builtin_bit_cast(int, c), 16 * t));
}
template <bool DRY> DI void moe_route(Frame& F) {
    const int lane_ = opaque_lane(F);
    float* H = (float*)F.outb; float* HO = DRY ? (float*)(F.ws + WS_XG) : H; const float* MOD = (const float*)(F.ws + WS_MOD); const float* WR = (const float*)(F.ws + WS_WROUT);
    bf16* U2 = (bf16*)(F.ws + (DRY ? WS_XG + 64 * MiB : WS_U2)); unsigned* ROUTE = (unsigned*)(F.ws + (DRY ? WS_XG + 100 * MiB : WS_ROUTE)); unsigned* CNT = (unsigned*)(F.ws + WS_CTL) + CW_CNT + (DRY ? 4096 : 0);
    const float* g1 = F.in[11]; const float* b1 = F.in[12]; const float* bco = F.in[14]; const float* bfi = F.in[16];
    LAS float* lg = (LAS float*)F.lds + F.wave * 256;
    const int gw = F.bx * NWAVES + F.wave, NGW = F.G * NWAVES;
    f32x4 un[4][4];
    { const int m0 = gw * 4;
      if (m0 < NT) {
#pragma unroll
        for (int t = 0; t < 4; ++t) { const f32x4* hr = (const f32x4*)(H + (size_t)(m0 + t) * DM) + lane_;
#pragma unroll
            for (int j = 0; j < 4; ++j) un[t][j] = hr[64 * j]; } } }
    for (int m0 = gw * 4; m0 < NT; m0 += NGW * 4) {
        const int b = m0 >> 12;
        f32x4 u[4][4];
        float ps[4], tot[4];
#pragma unroll
        for (int t = 0; t < 4; ++t) { float s = 0.f;
#pragma unroll
            for (int j = 0; j < 4; ++j) { u[t][j] = un[t][j]; s += (u[t][j].x + u[t][j].y) + (u[t][j].z + u[t][j].w); }
            ps[t] = s; }
        { const int m1 = m0 + NGW * 4;
          if (m1 < NT) {
#pragma unroll
            for (int t = 0; t < 4; ++t) { const f32x4* hr = (const f32x4*)(H + (size_t)(m1 + t) * DM) + lane_;
#pragma unroll
                for (int j = 0; j < 4; ++j) un[t][j] = hr[64 * j]; } } }
        bcast4(reduce4(ps, lane_), tot);
#pragma unroll
        for (int t = 0; t < 4; ++t) { const float mean = tot[t] * (1.f / DM); float s2 = 0.f;
#pragma unroll
            for (int j = 0; j < 4; ++j) { u[t][j] = u[t][j] - mean; s2 += (u[t][j].x * u[t][j].x + u[t][j].y * u[t][j].y) + (u[t][j].z * u[t][j].z + u[t][j].w * u[t][j].w); }
            ps[t] = s2; }
        bcast4(reduce4(ps, lane_), tot);
#pragma unroll
        for (int t = 0; t < 4; ++t) { const float rstd = 1.f / sqrtf(tot[t] * (1.f / DM) + LN_EPS); f32x4* hw = (f32x4*)(HO + (size_t)(m0 + t) * DM) + lane_; float s = 0.f;
#pragma unroll
            for (int j = 0; j < 4; ++j) { const int col = 256 * j + 4 * lane_; const f32x4 gg = *(const f32x4*)(g1 + col), bb = *(const f32x4*)(b1 + col);
                u[t][j] = u[t][j] * rstd * gg + bb; hw[64 * j] = u[t][j]; s += (u[t][j].x + u[t][j].y) + (u[t][j].z + u[t][j].w); }
            ps[t] = s; }
        bcast4(reduce4(ps, lane_), tot);
#pragma unroll
        for (int t = 0; t < 4; ++t) { const float mean = tot[t] * (1.f / DM); float s2 = 0.f;
#pragma unroll
            for (int j = 0; j < 4; ++j) { u[t][j] = u[t][j] - mean; s2 += (u[t][j].x * u[t][j].x + u[t][j].y * u[t][j].y) + (u[t][j].z * u[t][j].z + u[t][j].w * u[t][j].w); }
            ps[t] = s2; }
        bcast4(reduce4(ps, lane_), tot);
#pragma unroll
        for (int t = 0; t < 4; ++t) { const float rstd = 1.f / sqrtf(tot[t] * (1.f / DM) + LN_EPS); u32x2* o8 = (u32x2*)(U2 + (size_t)(m0 + t) * DM) + lane_;
#pragma unroll
            for (int j = 0; j < 4; ++j) { const int col = 256 * j + 4 * lane_;
                const f32x4 sh = *(const f32x4*)(MOD + b * 6144 + 3072 + col), sc = *(const f32x4*)(MOD + b * 6144 + 4096 + col);
                u[t][j] = u[t][j] * rstd * (sc + 1.f) + sh;
                u32x2 w; w.x = pk2(u[t][j].x, u[t][j].y); w.y = pk2(u[t][j].z, u[t][j].w); o8[64 * j] = w; } }
#ifndef ROUTE_NO
#define ROUTE_NO 36
#endif
#pragma unroll 2
        for (int o = 0; o < (DRY ? ROUTE_NO : 36); ++o) {
            const f32x4* wr = (const f32x4*)(WR + o * 1024) + lane_;
            f32x4 w[4];
#pragma unroll
            for (int j = 0; j < 4; ++j) w[j] = wr[64 * j];
#pragma unroll
            for (int t = 0; t < 4; ++t) { float a = 0.f;
#pragma unroll
                for (int j = 0; j < 4; ++j) a += (u[t][j].x * w[j].x + u[t][j].y * w[j].y) + (u[t][j].z * w[j].z + u[t][j].w * w[j].w);
                ps[t] = a; }
            const float c = reduce4(ps, lane_);
            if ((lane_ & 15) == 0) lg[(lane_ >> 4) * 64 + o] = c;
        }
        LDS_WAIT(); asm volatile("" ::: "memory");
        if (lane_ < 4) {
            const int t = lane_, m = m0 + t; const LAS float* L = lg + t * 64;
            float c[4]; int gs = 0; float cm = -3.0e38f;
#pragma unroll
            for (int j = 0; j < 4; ++j) { c[j] = L[j] + bco[j]; if (c[j] > cm) { cm = c[j]; gs = j; } }
            float den = 0.f;
#pragma unroll
            for (int j = 0; j < 4; ++j) den += __expf(c[j] - cm);
            const float pg = 1.f / den;
            float f[8];
#pragma unroll
            for (int e = 0; e < 8; ++e) f[e] = L[4 + 8 * gs + e] + bfi[8 * gs + e];
            int i0 = 0; float v0 = f[0];
#pragma unroll
            for (int e = 1; e < 8; ++e) if (f[e] > v0) { v0 = f[e]; i0 = e; }
            int i1 = -1; float v1 = -3.0e38f;
#pragma unroll
            for (int e = 0; e < 8; ++e) if (e != i0 && f[e] > v1) { v1 = f[e]; i1 = e; }
            const float e1 = __expf(v1 - v0); const float w0 = pg / (1.f + e1), w1 = pg * e1 / (1.f + e1);
            const int ex0 = gs * 8 + i0, ex1 = gs * 8 + i1;
            const unsigned p0 = atomicAdd(CNT + 64 * ex0, 1u), p1 = atomicAdd(CNT + 64 * ex1, 1u);
            unsigned* R = ROUTE + (size_t)m * 8;
            R[0] = ex0; R[1] = ex1; R[2] = p0; R[3] = p1; R[4] = __float_as_uint(w0); R[5] = __float_as_uint(w1);
        }
        LDS_WAIT(); asm volatile("" ::: "memory");
    }
}
DI int moe_tables(Frame& F) {
    LAS int* tab = (LAS int*)(F.lds + TEXP_OFF);
    if (F.tid == 0) {
        const unsigned* CNT = (const unsigned*)(F.ws + WS_CTL) + CW_CNT;
        int t = 0;
        for (int e = 0; e < 32; ++e) { const int c = (int)xb_ld((unsigned*)CNT + 64 * e); const int nt = (c + 255) >> 8; tab[192 + e] = t * 256; for (int k = 0; k < nt; ++k) tab[t + k] = e; t += nt; }
        tab[224] = t;
    }
    __syncthreads();
    return tab[224];
}
DI void moe_gather(Frame& F) {
    const int lane_ = opaque_lane(F);
    const LAS int* tab = (const LAS int*)(F.lds + TEXP_OFF);
    const bf16* U2 = (const bf16*)(F.ws + WS_U2); bf16* XG = (bf16*)(F.ws + WS_XG); unsigned* ROUTE = (unsigned*)(F.ws + WS_ROUTE);
    const int gw = F.bx * NWAVES + F.wave, NGW = F.G * NWAVES;
    for (int a = gw; a < 2 * NT; a += NGW) {
        const int m = a >> 1, k = a & 1;
        const unsigned e = ROUTE[(size_t)m * 8 + k], pos = ROUTE[(size_t)m * 8 + 2 + k];
        const int slot = tab[192 + e] + (int)pos;
        const u32x4* src = (const u32x4*)(U2 + (size_t)m * DM) + lane_; u32x4* dst = (u32x4*)(XG + (size_t)slot * DM) + lane_;
        dst[0] = src[0]; dst[64] = src[64];
        if (lane_ == 0) ROUTE[(size_t)m * 8 + 6 + k] = (unsigned)slot;
    }
}
template <bool DRY> DI void moe_combine(Frame& F) {
    const int lane_ = opaque_lane(F);
    float* H = (float*)F.outb; float* HO = DRY ? (float*)(F.ws + WS_HDN) : H; const float* MOD = (const float*)(F.ws + WS_MOD); const bf16* YR = (const bf16*)(F.ws + WS_YROWS); const unsigned* ROUTE = (const unsigned*)(F.ws + WS_ROUTE);
    const float* g2 = F.in[20]; const float* b2 = F.in[21];
    const int gw = F.bx * NWAVES + F.wave, NGW = F.G * NWAVES;
    for (int m = gw; m < NT; m += NGW) {
        const int b = m >> 12; const unsigned* R = ROUTE + (size_t)m * 8;
        const float w0 = __uint_as_float(R[4]), w1 = __uint_as_float(R[5]); const size_t s0 = R[6], s1 = R[7];
        f32x4* hr = (f32x4*)(H + (size_t)m * DM) + lane_; f32x4* hw = (f32x4*)(HO + (size_t)m * DM) + lane_;
        f32x4 v[4]; float s = 0.f;
#pragma unroll
        for (int j = 0; j < 4; ++j) { const int col = 256 * j + 4 * lane_;
            const u32x2 ya = *(const u32x2*)(YR + s0 * DM + col), yb = *(const u32x2*)(YR + s1 * DM + col);
            const f32x4 y = {w0 * bflo(ya.x) + w1 * bflo(yb.x), w0 * bfhi(ya.x) + w1 * bfhi(yb.x), w0 * bflo(ya.y) + w1 * bflo(yb.y), w0 * bfhi(ya.y) + w1 * bfhi(yb.y)};
            const f32x4 gt = *(const f32x4*)(MOD + b * 6144 + 5120 + col);
            v[j] = hr[64 * j] * ALPHA + gt * y; s += (v[j].x + v[j].y) + (v[j].z + v[j].w); }
        const float mean = wave_sum(s) * (1.f / DM); float s2 = 0.f;
#pragma unroll
        for (int j = 0; j < 4; ++j) { v[j] = v[j] - mean; s2 += (v[j].x * v[j].x + v[j].y * v[j].y) + (v[j].z * v[j].z + v[j].w * v[j].w); }
        const float rstd = 1.f / sqrtf(wave_sum(s2) * (1.f / DM) + LN_EPS);
#pragma unroll
        for (int j = 0; j < 4; ++j) { const int col = 256 * j + 4 * lane_; hw[64 * j] = v[j] * rstd * *(const f32x4*)(g2 + col) + *(const f32x4*)(b2 + col); }
    }
}

__global__ void __launch_bounds__(NTHREADS, 2) fwd_kernel(Args args) {
    extern __shared__ __attribute__((aligned(16))) unsigned char lds[];
    Frame F;
    F.lds = (LAS unsigned char*)lds;
    F.tid = threadIdx.x; F.lane = F.tid & 63; F.wave = __builtin_amdgcn_readfirstlane(F.tid >> 6);
    F.G = gridDim.x; F.bx = blockIdx.x; F.vcu = (F.G % 8 == 0) ? (F.bx % 8) * (F.G / 8) + F.bx / 8 : F.bx;
    F.ws = args.ws; F.outb = (unsigned char*)args.out;
#pragma unroll
    for (int i = 0; i < 22; ++i) F.in[i] = args.in[i];
    for (int u = F.tid; u < (LDS_BYTES - LDSX_OFF) / 4; u += NTHREADS) ((LAS unsigned*)(F.lds + LDSX_OFF))[u] = 0u;
    __syncthreads();
    unsigned* ctl = (unsigned*)(F.ws + WS_CTL);
    XcdBarrier bar = xcd_barrier_post(ctl + CW_BAR, (volatile LAS unsigned*)(F.lds + MISC_OFF) + 8);
    if (F.tid == 0) ((volatile LAS unsigned*)(F.lds + MISC_OFF))[12] = xb_add(ctl + CW_RANK + 64 * bar.x, 1u);
    unsigned long long* TS = (unsigned long long*)(ctl + 32768);
    int nst = 1;
    if (PROF && F.bx == 0 && F.tid == 0) TS[0] = __builtin_amdgcn_s_memrealtime();
#define GRID_BAR() do { xcd_barrier(bar); if (PROF && F.bx == 0 && F.tid == 0) TS[nst] = __builtin_amdgcn_s_memrealtime(); ++nst; } while (0)
    const char* U = (const char*)(F.outb + OUT_U); const char* WINT = (const char*)(F.outb + OUT_WINT);

    REP(1,  phase0(F); GRID_BAR();
    phase1(F); GRID_BAR(); );
    { volatile LAS unsigned* M = (volatile LAS unsigned*)(F.lds + MISC_OFF);
      if (F.tid == 0) { unsigned pre = 0, nx = 0, mine = 0, even = 1, idx = 0;
          for (unsigned j = 0; j < 16; ++j) { const unsigned cj = xb_ld(ctl + CW_BAR + XB_XCNT(j)); if (j < bar.x) { pre += cj; idx += (cj > 0u); } if (j == bar.x) mine = cj; nx += (cj > 0u); if (cj != 0u && cj * 8u != (unsigned)F.G) even = 0; }
          const unsigned rank = M[12];
          M[13] = pre + rank; M[14] = (even && nx == 8u) ? rank * 8u + idx : (unsigned)F.bx; (void)mine; }
      __syncthreads();
      F.vcu = (int)M[13]; }
    const int c = (int)((volatile LAS unsigned*)(F.lds + MISC_OFF))[14];
    REP(2,
    { SchedR1 S; S.init(64, 8, F.G, c); S.U = U; S.W = WINT;
      pg8::EpiV<EpiR1> E{EpiR1{(bf16*)(F.ws + WS_RQ), (bf16*)(F.ws + WS_RK)}};
      pg8::gemm_phase<pg8::EpiV<EpiR1>, SchedR1, true>(F.lds, 1024, 1024, 1024, S, E); }
    { SchedR2 S; S.init(12, 64, F.G, c); S.U = U; S.W = WINT;
      pg8::EpiV<EpiR2> E{EpiR2{(bf16*)(F.ws + WS_RVT), (bf16*)(F.ws + WS_KFT), (bf16*)(F.ws + WS_KBT), (const float*)(F.ws + WS_DEC)}};
      pg8::gemm_phase<pg8::EpiV<EpiR2>, SchedR2, true>(F.lds, 1024, 1024, 1024, S, E); }
    GRID_BAR(); );
    REP(3, ret_scan(F); GRID_BAR(); );
    ret_norm(F); GRID_BAR();
    REP(4,
    _Pragma("unroll 1")
    for (int g = 0; g < 3; ++g) {
        const int dil = g == 0 ? 1 : (g == 1 ? 4 : 16);
        SchedQK S; S.init(64, 4, F.G, c); S.U = U; S.W = WINT; S.g = g; S.r = dil; S.nsub = SEQ / dil;
        pg8::EpiV<EpiQK> E{EpiQK{(bf16*)(F.ws + WS_AQ + (size_t)g * 16 * MiB), (bf16*)(F.ws + WS_AK + (size_t)g * 16 * MiB)}};
        pg8::gemm_phase<pg8::EpiV<EpiQK>, SchedQK, true>(F.lds, 1024, 1024 * dil, 1024, S, E);
    }
    { SchedGate S; S.init(64, 16, F.G, c); S.U = U; S.W = WINT;
      pg8::EpiV<EpiGate> E{EpiGate{(bf16*)(F.ws + WS_RETG), (bf16*)(F.ws + WS_GA), (bf16*)(F.ws + WS_GR)}};
      pg8::gemm_phase<pg8::EpiV<EpiGate>, SchedGate, true>(F.lds, 1024, 1024, 1024, S, E); }
_Pragma("unroll 1")
    for (int g = 0; g < 3; ++g) {
        const int dil = g == 0 ? 1 : (g == 1 ? 4 : 16);
        SchedA2 S; const int cc = (g == 1) ? c - 128 : c; S.init(2, 64, F.G, (cc >= 0 && cc < 128) ? cc : -1); S.U = U; S.W = WINT; S.g = g; S.r = dil; S.nsub = SEQ / dil;
        pg8::EpiV<EpiA2> E{EpiA2{(bf16*)(F.ws + WS_AVT) + (size_t)g * 512 * NT}};
        pg8::gemm_phase<pg8::EpiV<EpiA2>, SchedA2, true>(F.lds, 1024, 1024, 1024 * dil, S, E);
    }
    GRID_BAR(); );
    REP(5,  attn_phase(F); GRID_BAR(); );
    REP(6,  attn_mix(F); GRID_BAR(); );
    REP(7,
    { SchedG S; S.init(64, 4, F.G, c); S.A = (const char*)(F.ws + WS_ATTMIX); S.B = (const char*)(F.ws + WS_WAT); S.abytes = 256 * 512 * 2; S.bbytes = 256 * 512 * 2;
      pg8::EpiV<EpiG1> E{EpiG1{(const bf16*)(F.ws + WS_GA), (bf16*)F.outb}};
      pg8::gemm_phase<pg8::EpiV<EpiG1>, SchedG, true>(F.lds, 512, 512, 512, S, E); }
    { SchedG S; S.init(64, 4, F.G, c); S.A = (const char*)(F.ws + WS_RETG); S.B = (const char*)(F.ws + WS_WRT); S.abytes = 256 * 2048 * 2; S.bbytes = 256 * 2048 * 2;
      pg8::EpiV<EpiG2> E{EpiG2{(const bf16*)(F.ws + WS_GR), (const bf16*)F.outb, (bf16*)(F.ws + WS_MERGED)}};
      pg8::gemm_phase<pg8::EpiV<EpiG2>, SchedG, true>(F.lds, 2048, 2048, 2048, S, E); }
    GRID_BAR();
    { SchedG S; S.init(64, 4, F.G, c); S.A = (const char*)(F.ws + WS_MERGED); S.B = (const char*)(F.ws + WS_WOT); S.abytes = 256 * 1024 * 2; S.bbytes = 256 * 1024 * 2;
      pg8::EpiV<EpiG3> E{EpiG3{F.in[0], (const float*)(F.ws + WS_MOD), (float*)F.outb}};
      pg8::gemm_phase<pg8::EpiV<EpiG3>, SchedG, true>(F.lds, 1024, 1024, 1024, S, E); }
    GRID_BAR(); );
    if (F.wave & 1) { moe_weight_transposes(F); moe_route<false>(F); } else { moe_route<false>(F); moe_weight_transposes(F); }
    GRID_BAR();
    REPX(11, moe_route<true>(F); GRID_BAR(); );
    const int ntiles = moe_tables(F);
    REP(8,  moe_gather(F); GRID_BAR(); );
    REP(9,
    { SchedM S; S.init(ntiles, 4, F.G, c); S.A = (const char*)(F.ws + WS_XG); S.B = (const char*)(F.ws + WS_W13T); S.abytes = 256 * 1024 * 2; S.ebytes = (size_t)1024 * 1024 * 2; S.bbytes = 256 * 1024 * 2;
      S.texp = (const LAS int*)(F.lds + TEXP_OFF);
      pg8::EpiV<EpiM3> E{EpiM3{(bf16*)(F.ws + WS_HDN)}};
      pg8::gemm_phase<pg8::EpiV<EpiM3>, SchedM, true>(F.lds, 1024, 1024, 1024, S, E); }
    GRID_BAR();
    { SchedM S; S.init(ntiles, 4, F.G, c); S.A = (const char*)(F.ws + WS_HDN); S.B = (const char*)(F.ws + WS_W2T); S.abytes = 256 * 512 * 2; S.ebytes = (size_t)1024 * 512 * 2; S.bbytes = 256 * 512 * 2;
      S.texp = (const LAS int*)(F.lds + TEXP_OFF);
      pg8::EpiV<EpiM4> E{EpiM4{(bf16*)(F.ws + WS_YROWS)}};
      pg8::gemm_phase<pg8::EpiV<EpiM4>, SchedM, true>(F.lds, 512, 512, 512, S, E); }
    GRID_BAR(); );
    REPX(12, moe_combine<true>(F); GRID_BAR(); );
    REPX(13, GRID_BAR(); GRID_BAR(); GRID_BAR(); GRID_BAR(); GRID_BAR(); GRID_BAR(); GRID_BAR(); GRID_BAR(); GRID_BAR(); GRID_BAR(); );
    moe_combine<false>(F);
#if PROF
    GRID_BAR();
    { const unsigned long long ta0 = __hip_atomic_load(TS + PROF_A - 1, __ATOMIC_RELAXED, __HIP_MEMORY_SCOPE_AGENT), ta1 = __hip_atomic_load(TS + PROF_A, __ATOMIC_RELAXED, __HIP_MEMORY_SCOPE_AGENT);
      const unsigned long long tb0 = __hip_atomic_load(TS + PROF_B - 1, __ATOMIC_RELAXED, __HIP_MEMORY_SCOPE_AGENT), tb1 = __hip_atomic_load(TS + PROF_B, __ATOMIC_RELAXED, __HIP_MEMORY_SCOPE_AGENT);
      const float V1 = (float)(ta1 - ta0) * 0.01f, V2 = (float)(tb1 - tb0) * 0.01f * 20.f;
      float* out = (float*)F.outb;
      for (int i = F.bx * NTHREADS + F.tid; i < NT * DM; i += F.G * NTHREADS) out[i] = (i < 16) ? V2 : V1; }
#endif
}

extern "C" void kernel_launch(void* const* d_in, const int* in_sizes, int n_in, void* d_out, int out_size, void* d_ws, size_t ws_size, hipStream_t stream) {
    static int grid = 0;
    if (grid == 0) {
        if (n_in != 22 || out_size != NT * DM || ws_size < WS_END) { fprintf(stderr, "kernel_launch: unexpected problem (n_in %d, out %d, ws %zu)\n", n_in, out_size, ws_size); grid = -1; return; }
        int dev = 0, cus = 0, per_cu = 0;
        if (hipGetDevice(&dev) != hipSuccess || hipDeviceGetAttribute(&cus, hipDeviceAttributeMultiprocessorCount, dev) != hipSuccess) { grid = -1; return; }
        if (hipFuncSetAttribute((const void*)fwd_kernel, hipFuncAttributeMaxDynamicSharedMemorySize, LDS_BYTES) != hipSuccess) { grid = -1; return; }
        if (hipOccupancyMaxActiveBlocksPerMultiprocessor(&per_cu, (const void*)fwd_kernel, NTHREADS, LDS_BYTES) != hipSuccess || per_cu < 1) { fprintf(stderr, "kernel_launch: occupancy query reports %d blocks/CU\n", per_cu); (void)hipGetLastError(); grid = -1; return; }
        grid = cus;
    }
    if (grid < 0) return;
    (void)hipMemsetAsync((char*)d_ws + WS_CTL, 0, CTL_ZERO_BYTES, stream);
    Args a{};
    for (int i = 0; i < 22; ++i) a.in[i] = (const float*)d_in[i];
    a.out = (float*)d_out; a.ws = (unsigned char*)d_ws;
    hipLaunchKernelGGL(fwd_kernel, dim3(grid), dim3(NTHREADS), LDS_BYTES, stream, a);
}
```
